# Optimizing an MI355X kernel written in HIP

```python
import math
import jax, jax.numpy as jnp
from jax import lax
import numpy as np

D_MODEL = 1024
BATCH = 32
SEQ = 2048
DEPTH = 1

ATTN_WIDTH = D_MODEL // 2
POOL_WIDTH = D_MODEL - ATTN_WIDTH
DIFF_HEADS = 4
DIFF_HEAD_DIM = ATTN_WIDTH // DIFF_HEADS
DIFF_QK_DIM = DIFF_HEAD_DIM // 2
ROT_DIM = DIFF_QK_DIM // 4
ROPE_THETA = 500000.0
POOL_WINDOWS = (2, 4, 8, 16)
POOL_GROUPS = len(POOL_WINDOWS)
POOL_GROUP_DIM = POOL_WIDTH // POOL_GROUPS
IN_WIDTH = 3 * ATTN_WIDTH + POOL_WIDTH
N_EXPERTS = 32
TOP_K = 4
D_FF = D_MODEL
SWIGLU_ALPHA = 1.702
SWIGLU_LIMIT = 7.0
Q_BLOCK = 128
MOE_BLOCK = 128
EPS = 1e-5

kernel_name = "hymba_diffattn_pool_moe_block"


def rms_norm(x, w):
    xf = x.astype(jnp.float32)
    y = xf * lax.rsqrt(jnp.mean(xf * xf, axis=-1, keepdims=True) + EPS)
    return (y * w.astype(jnp.float32)).astype(x.dtype)


def rope_tables(positions):
    inv_freq = ROPE_THETA ** (-jnp.arange(0, ROT_DIM, 2, dtype=jnp.float32) / ROT_DIM)
    ang = positions.astype(jnp.float32)[..., None] * inv_freq
    return jnp.cos(ang)[:, :, None, None, :], jnp.sin(ang)[:, :, None, None, :]


def apply_partial_rope(t, cos, sin):
    half = ROT_DIM // 2
    tr = t[..., :ROT_DIM].astype(jnp.float32)
    t1, t2 = tr[..., :half], tr[..., half:]
    rot = jnp.concatenate([t1 * cos - t2 * sin, t2 * cos + t1 * sin], axis=-1)
    return jnp.concatenate([rot.astype(t.dtype), t[..., ROT_DIM:]], axis=-1)


def diff_attention(q, k, v, lam, lam_init, subln_w):
    B, H, _, S, dk = q.shape
    dv = v.shape[-1]
    n_blocks = S // Q_BLOCK
    scale = dk ** -0.5
    kf = k.astype(jnp.float32)
    vf = v.astype(jnp.float32)
    k_idx = jnp.arange(S)

    def one_block(i):
        q0 = i * Q_BLOCK
        qb = lax.dynamic_slice_in_dim(q, q0, Q_BLOCK, axis=3).astype(jnp.float32)
        s = jnp.einsum('bhmqd,bhmkd->bhmqk', qb, kf) * scale
        q_idx = q0 + jnp.arange(Q_BLOCK)
        mask = k_idx[None, :] <= q_idx[:, None]
        p = jax.nn.softmax(jnp.where(mask, s, -jnp.inf), axis=-1)
        a = p[:, :, 0] - lam * p[:, :, 1]
        return jnp.einsum('bhqk,bhkd->bhqd', a, vf)

    o = lax.map(one_block, jnp.arange(n_blocks))
    o = o.transpose(1, 0, 3, 2, 4).reshape(B, S, H, dv)
    o = rms_norm(o, subln_w) * (1.0 - lam_init)
    return o.reshape(B, S, H * dv).astype(v.dtype)


def multiscale_pool(u, pool_w, pool_scale):
    B, S, C = u.shape
    uf = u.astype(jnp.float32).reshape(B, S, POOL_GROUPS, POOL_GROUP_DIM)
    c = jnp.cumsum(uf, axis=1)
    t = jnp.arange(1, S + 1, dtype=jnp.float32)
    pooled = []
    for g, w in enumerate(POOL_WINDOWS):
        cg = c[:, :, g]
        lower = jnp.pad(cg, ((0, 0), (w, 0), (0, 0)))[:, :S]
        count = jnp.minimum(t, float(w))[None, :, None]
        pooled.append((cg - lower) / count)
    pooled = jnp.stack(pooled, axis=2)
    y = jnp.einsum('bsgc,gcd->bsgd', pooled - uf, pool_w.astype(jnp.float32))
    y = y.reshape(B, S, C) * pool_scale.astype(jnp.float32)
    return y.astype(u.dtype)


def moe_ffn(h, router_w, router_b, w_gu, b_gu, w_down, b_down):
    B, S, D = h.shape
    T = B * S
    A = T * TOP_K
    hf = h.reshape(T, D)
    logits = (hf @ router_w + router_b).astype(jnp.float32)
    top_vals, top_idx = lax.top_k(logits, TOP_K)
    gates = jax.nn.softmax(top_vals, axis=-1)
    e_flat = top_idx.reshape(A)
    g_flat = gates.reshape(A)
    tok_flat = jnp.arange(A, dtype=jnp.int32) // TOP_K
    order = jnp.argsort(e_flat, stable=True)
    e_sorted, tok_sorted, g_sorted = e_flat[order], tok_flat[order], g_flat[order]
    counts = jax.ops.segment_sum(jnp.ones((A,), jnp.int32), e_flat, num_segments=N_EXPERTS)
    padded = (counts + MOE_BLOCK - 1) // MOE_BLOCK * MOE_BLOCK
    starts = jnp.cumsum(counts) - counts
    pad_ends = jnp.cumsum(padded)
    pad_starts = pad_ends - padded
    dest = pad_starts[e_sorted] + (jnp.arange(A, dtype=jnp.int32) - starts[e_sorted])
    P = A + N_EXPERTS * MOE_BLOCK
    n_blocks = P // MOE_BLOCK
    row_tok = jnp.zeros((P,), jnp.int32).at[dest].set(tok_sorted)
    row_gate = jnp.zeros((P,), jnp.float32).at[dest].set(g_sorted)
    block_start = jnp.arange(n_blocks, dtype=jnp.int32) * MOE_BLOCK
    block_expert = jnp.minimum(jnp.searchsorted(pad_ends, block_start, side='right'),
                               N_EXPERTS - 1)

    def step(acc, blk):
        rows, rgate, e = blk
        xs = hf[rows]
        gu = xs @ w_gu[e] + b_gu[e]
        gate = jnp.minimum(gu[:, :D_FF], SWIGLU_LIMIT)
        up = jnp.clip(gu[:, D_FF:], -SWIGLU_LIMIT, SWIGLU_LIMIT)
        glu = gate * jax.nn.sigmoid(SWIGLU_ALPHA * gate)
        y = ((up + 1.0) * glu) @ w_down[e] + b_down[e]
        acc = acc.at[rows].add(y.astype(jnp.float32) * rgate[:, None])
        return acc, None

    out, _ = lax.scan(step, jnp.zeros((T, D), jnp.float32),
                      (row_tok.reshape(n_blocks, MOE_BLOCK),
                       row_gate.reshape(n_blocks, MOE_BLOCK), block_expert))
    return out.reshape(B, S, D).astype(h.dtype)


def setup_inputs(seed: int = 0) -> dict:
    key = jax.random.key(seed)
    ks = jax.random.split(key, 20)
    f32 = jnp.float32
    L = DEPTH
    nrm = lambda k, shape, s: jax.random.normal(k, shape, f32) * s
    x = jax.random.normal(ks[0], (BATCH, SEQ, D_MODEL), f32)
    start = jax.random.randint(ks[1], (BATCH, 1), 0, 4096, dtype=jnp.int32)
    positions = start + jnp.arange(SEQ, dtype=jnp.int32)[None, :]
    return {
        "x": x,
        "positions": positions,
        "attn_norm_w": 1.0 + nrm(ks[2], (L, D_MODEL), 0.02),
        "w_in": nrm(ks[3], (L, D_MODEL, IN_WIDTH), D_MODEL ** -0.5),
        "lambda_q1": nrm(ks[4], (L, DIFF_QK_DIM), 0.1),
        "lambda_k1": nrm(ks[5], (L, DIFF_QK_DIM), 0.1),
        "lambda_q2": nrm(ks[6], (L, DIFF_QK_DIM), 0.1),
        "lambda_k2": nrm(ks[7], (L, DIFF_QK_DIM), 0.1),
        "subln_w": 1.0 + nrm(ks[8], (L, DIFF_HEAD_DIM), 0.02),
        "pool_w": nrm(ks[9], (L, POOL_GROUPS, POOL_GROUP_DIM, POOL_GROUP_DIM), POOL_GROUP_DIM ** -0.5),
        "pool_scale": 1.0 + nrm(ks[10], (L, POOL_WIDTH), 0.02),
        "w_out": nrm(ks[11], (L, D_MODEL, D_MODEL), D_MODEL ** -0.5),
        "ffn_norm_w": 1.0 + nrm(ks[12], (L, D_MODEL), 0.02),
        "router_w": nrm(ks[13], (L, D_MODEL, N_EXPERTS), D_MODEL ** -0.5),
        "router_b": nrm(ks[14], (L, N_EXPERTS), 0.01),
        "w_gate_up": nrm(ks[15], (L, N_EXPERTS, D_MODEL, 2 * D_FF), D_MODEL ** -0.5),
        "b_gate_up": nrm(ks[16], (L, N_EXPERTS, 2 * D_FF), 0.01),
        "w_down": nrm(ks[17], (L, N_EXPERTS, D_FF, D_MODEL), D_FF ** -0.5),
        "b_down": nrm(ks[18], (L, N_EXPERTS, D_MODEL), 0.01),
        "final_norm_w": 1.0 + nrm(ks[19], (D_MODEL,), 0.02),
    }


def reference(x, positions, attn_norm_w, w_in, lambda_q1, lambda_k1, lambda_q2, lambda_k2,
              subln_w, pool_w, pool_scale, w_out, ffn_norm_w, router_w, router_b,
              w_gate_up, b_gate_up, w_down, b_down, final_norm_w):
    B, S, _ = x.shape
    cos, sin = rope_tables(positions)
    for l in range(DEPTH):
        lam_init = 0.8 - 0.6 * math.exp(-0.3 * l)
        h = rms_norm(x, attn_norm_w[l])
        proj = h @ w_in[l]
        q, k, v, u = jnp.split(proj, [ATTN_WIDTH, 2 * ATTN_WIDTH, 3 * ATTN_WIDTH], axis=-1)
        q = apply_partial_rope(q.reshape(B, S, DIFF_HEADS, 2, DIFF_QK_DIM), cos, sin)
        k = apply_partial_rope(k.reshape(B, S, DIFF_HEADS, 2, DIFF_QK_DIM), cos, sin)
        q = q.transpose(0, 2, 3, 1, 4)
        k = k.transpose(0, 2, 3, 1, 4)
        v = v.reshape(B, S, DIFF_HEADS, DIFF_HEAD_DIM).transpose(0, 2, 1, 3)
        lam = (jnp.exp(jnp.sum(lambda_q1[l].astype(jnp.float32) * lambda_k1[l].astype(jnp.float32)))
               - jnp.exp(jnp.sum(lambda_q2[l].astype(jnp.float32) * lambda_k2[l].astype(jnp.float32)))
               + lam_init)
        attn = diff_attention(q, k, v, lam, lam_init, subln_w[l])
        pool = multiscale_pool(u, pool_w[l], pool_scale[l])
        x = x + jnp.concatenate([attn, pool], axis=-1) @ w_out[l]
        x = x + moe_ffn(rms_norm(x, ffn_norm_w[l]), router_w[l], router_b[l],
                        w_gate_up[l], b_gate_up[l], w_down[l], b_down[l])
    return rms_norm(x, final_norm_w)
```

```cpp
#include <hip/hip_runtime.h>
#include <cstdint>
#include <cstdio>

typedef unsigned short bf16_t;
typedef short bf16x8 __attribute__((ext_vector_type(8)));
typedef float f32x4 __attribute__((ext_vector_type(4)));
typedef unsigned u32x4 __attribute__((ext_vector_type(4)));

constexpr int T = 65536, D = 1024, SEQ = 2048, INW = 2048, NE = 32, FF = 1024, TOPK = 4;
constexpr int NCHUNK = 2, TC = T / NCHUNK;
constexpr int TM = 128;
constexpr int PC = TC * TOPK + NE * TM;
constexpr float EPS = 1e-5f;

constexpr size_t MiB = 1u << 20;
constexpr size_t WS_CTL = 0;
constexpr size_t WS_LTOK = 1 * MiB;
constexpr size_t WS_LGATE = 9 * MiB;
constexpr size_t WS_SLOT = 17 * MiB;
constexpr size_t WS_ROPE = 18 * MiB;
constexpr size_t WS_WIN = 22 * MiB;
constexpr size_t WS_WO = 26 * MiB;
constexpr size_t WS_WD = 28 * MiB;
constexpr size_t WS_WGU = 92 * MiB;
constexpr size_t WS_XN = 220 * MiB;
constexpr size_t WS_PROJ = 348 * MiB;
constexpr size_t WS_CAT = 604 * MiB;
constexpr size_t WS_HM = 348 * MiB;
constexpr size_t WS_YP = 640 * MiB;
constexpr size_t WS_END = 920 * MiB;
static_assert(WS_HM + (size_t)PC * 1024 * 2 <= WS_YP && WS_YP + (size_t)PC * 1024 * 2 <= WS_END, "ws map");

__device__ __forceinline__ unsigned f2bf(float f) { unsigned u = __float_as_uint(f); return (u + 0x7fffu + ((u >> 16) & 1u)) >> 16; }
__device__ __forceinline__ float bf2f(unsigned h) { return __uint_as_float(h << 16); }
__device__ __forceinline__ float wave_sum(float v) {
#pragma unroll
    for (int o = 1; o < 64; o <<= 1) v += __shfl_xor(v, o);
    return v;
}
__device__ __forceinline__ float wave_max(float v) {
#pragma unroll
    for (int o = 1; o < 64; o <<= 1) v = fmaxf(v, __shfl_xor(v, o));
    return v;
}

template <int MODE>
__global__ __launch_bounds__(256) void k_transpose(const float* __restrict__ W, bf16_t* __restrict__ WT, int K, int N, int ldk  ) {
    __shared__ float tile[32][33];
    const int tx = threadIdx.x & 31, ty = threadIdx.x >> 5;
    const int n0 = blockIdx.x * 32, k0 = blockIdx.y * 32;
    const float* Wb = W + (size_t)blockIdx.z * K * N;
    bf16_t* WTb = WT + (size_t)blockIdx.z * N * ldk;
#pragma unroll
    for (int i = 0; i < 4; ++i) tile[ty + 8 * i][tx] = Wb[(size_t)(k0 + ty + 8 * i) * N + n0 + tx];
    __syncthreads();
#pragma unroll
    for (int i = 0; i < 4; ++i) {
        const int n = n0 + ty + 8 * i, k = k0 + tx;
        int row = n;
        if (MODE == 1) { const int f = n & 1023, up = n >> 10; row = (f >> 5) * 64 + up * 32 + (f & 31); }
        WTb[(size_t)row * ldk + k] = (bf16_t)f2bf(tile[tx][ty + 8 * i]);
    }
}
__global__ __launch_bounds__(256) void k_fold_pool(const float* __restrict__ pool_w, const float* __restrict__ pool_scale, const float* __restrict__ w_out, bf16_t* __restrict__ Wo_t) {
    const int idx = blockIdx.x * 256 + threadIdx.x;
    const int n = idx & 1023, gc = idx >> 10, g = gc >> 7;
    float acc = 0.f;
    for (int d = 0; d < 128; ++d) acc += pool_w[(size_t)gc * 128 + d] * pool_scale[g * 128 + d] * w_out[(size_t)(512 + g * 128 + d) * 1024 + n];
    Wo_t[(size_t)n * 1024 + 512 + gc] = (bf16_t)f2bf(acc);
}
__global__ __launch_bounds__(256) void k_rope_table(const int* __restrict__ positions, float* __restrict__ rope) {
    const int idx = blockIdx.x * 256 + threadIdx.x; const int t = idx >> 3, j = idx & 7;
    const double inv = exp(-(double)(2 * j) / 16.0 * log(500000.0));
    const double ang = (double)positions[t] * inv;
    rope[(size_t)t * 16 + j] = (float)cos(ang); rope[(size_t)t * 16 + 8 + j] = (float)sin(ang);
}
__global__ __launch_bounds__(256) void k_rmsnorm(const float* __restrict__ x, const float* __restrict__ w, bf16_t* __restrict__ out) {
    const int row = blockIdx.x * 4 + (threadIdx.x >> 6), lane = threadIdx.x & 63;
    const f32x4* xr = (const f32x4*)(x + (size_t)row * D) + lane;
    f32x4 v[4]; float s = 0.f;
#pragma unroll
    for (int j = 0; j < 4; ++j) { v[j] = xr[64 * j]; s += v[j].x * v[j].x + v[j].y * v[j].y + v[j].z * v[j].z + v[j].w * v[j].w; }
    const float rstd = 1.0f / sqrtf(wave_sum(s) * (1.f / D) + EPS);
    unsigned long long* o8 = (unsigned long long*)(out + (size_t)row * D) + lane;
#pragma unroll
    for (int j = 0; j < 4; ++j) { const f32x4 ww = ((const f32x4*)w)[64 * j + lane];
        const unsigned lo = f2bf(v[j].x * rstd * ww.x) | (f2bf(v[j].y * rstd * ww.y) << 16), hi = f2bf(v[j].z * rstd * ww.z) | (f2bf(v[j].w * rstd * ww.w) << 16);
        o8[64 * j] = (unsigned long long)lo | ((unsigned long long)hi << 32); }
}

__device__ __forceinline__ void gemm128_core(const bf16_t* a0, const bf16_t* a1, const bf16_t* b0, const bf16_t* b1, int K, bf16_t* shm, f32x4 (&acc)[4][4]) {
    constexpr int BK = 32, HT = 128 * BK;
    bf16_t* SA = shm; bf16_t* SB = shm + HT;
    const int tid = threadIdx.x, wid = tid >> 6, lane = tid & 63, wr = wid >> 1, wc = wid & 1, fr = lane & 15, fq = lane >> 4;
#pragma unroll
    for (int m = 0; m < 4; ++m)
#pragma unroll
        for (int n = 0; n < 4; ++n) acc[m][n] = (f32x4){0.f, 0.f, 0.f, 0.f};
    for (int t = 0; t < K / BK; ++t) {
        __builtin_amdgcn_global_load_lds((const unsigned*)(a0 + t * BK), (unsigned*)((char*)SA + tid * 16), 16, 0, 0);
        __builtin_amdgcn_global_load_lds((const unsigned*)(b0 + t * BK), (unsigned*)((char*)SB + tid * 16), 16, 0, 0);
        __builtin_amdgcn_global_load_lds((const unsigned*)(a1 + t * BK), (unsigned*)((char*)SA + tid * 16 + 4096), 16, 0, 0);
        __builtin_amdgcn_global_load_lds((const unsigned*)(b1 + t * BK), (unsigned*)((char*)SB + tid * 16 + 4096), 16, 0, 0);
        asm volatile("s_waitcnt vmcnt(0)" ::: "memory"); __syncthreads();
        bf16x8 At[4], Bl[4];
#pragma unroll
        for (int m = 0; m < 4; ++m) At[m] = *reinterpret_cast<const bf16x8*>((char*)SA + (wr * 64 + m * 16 + fr) * BK * 2 + fq * 16);
#pragma unroll
        for (int m = 0; m < 4; ++m) Bl[m] = *reinterpret_cast<const bf16x8*>((char*)SB + (wc * 64 + m * 16 + fr) * BK * 2 + fq * 16);
        asm volatile("s_waitcnt lgkmcnt(0)" ::: "memory"); __builtin_amdgcn_sched_barrier(0);
#pragma unroll
        for (int m = 0; m < 4; ++m)
#pragma unroll
            for (int n = 0; n < 4; ++n) acc[m][n] = __builtin_amdgcn_mfma_f32_16x16x32_bf16(At[m], Bl[n], acc[m][n], 0, 0, 0);
        __syncthreads();
    }
}

template <int MODE>
__global__ __launch_bounds__(256, 2) void k_gemm_dense(const bf16_t* __restrict__ A, const bf16_t* __restrict__ Bt, int N, int K, void* outp, const float* __restrict__ resid) {
    __shared__ __attribute__((aligned(16))) bf16_t shm[2 * 128 * 32];
    const int ntn = N / 128, mt = blockIdx.x / ntn, nt = blockIdx.x % ntn;
    const int tid = threadIdx.x, r = tid >> 2, c = (tid & 3) * 8;
    const bf16_t* a0 = A + (size_t)(mt * 128 + r) * K + c; const bf16_t* a1 = a0 + (size_t)64 * K;
    const bf16_t* b0 = Bt + (size_t)(nt * 128 + r) * K + c; const bf16_t* b1 = b0 + (size_t)64 * K;
    f32x4 acc[4][4];
    gemm128_core(a0, a1, b0, b1, K, shm, acc);
    const int wid = tid >> 6, lane = tid & 63, wr = wid >> 1, wc = wid & 1, fr = lane & 15, fq = lane >> 4;
#pragma unroll
    for (int m = 0; m < 4; ++m)
#pragma unroll
        for (int n = 0; n < 4; ++n)
#pragma unroll
            for (int j = 0; j < 4; ++j) {
                const size_t row = (size_t)mt * 128 + wr * 64 + m * 16 + fq * 4 + j; const int col = nt * 128 + wc * 64 + n * 16 + fr;
                if (MODE == 0) ((bf16_t*)outp)[row * N + col] = (bf16_t)f2bf(acc[m][n][j]);
                else ((float*)outp)[row * N + col] = resid[row * N + col] + acc[m][n][j];
            }
}

__global__ __launch_bounds__(256) void k_rope(bf16_t* __restrict__ PROJ, const float* __restrict__ rope) {
    const int idx = blockIdx.x * 256 + threadIdx.x;
    const int t = idx >> 7, r = idx & 127, j = r & 7, comp = r >> 3;
    bf16_t* p = PROJ + (size_t)t * INW + comp * 64;
    const float cs = rope[(size_t)t * 16 + j], sn = rope[(size_t)t * 16 + 8 + j];
    const float a = bf2f(p[j]), b = bf2f(p[8 + j]);
    p[j] = (bf16_t)f2bf(a * cs - b * sn); p[8 + j] = (bf16_t)f2bf(b * cs + a * sn);
}

__global__ __launch_bounds__(256) void k_attn_simple(const bf16_t* __restrict__ PROJ, const float* __restrict__ subln_w, const float* __restrict__ lq1, const float* __restrict__ lk1,
                                                     const float* __restrict__ lq2, const float* __restrict__ lk2, bf16_t* __restrict__ CAT) {
    __shared__ float sq[4][128];
    __shared__ float sp[4][2][64];
    const int wid = threadIdx.x >> 6, lane = threadIdx.x & 63;
    const int t = blockIdx.x, h = wid, b = t / SEQ, s = t % SEQ;
    const float lam = expf(wave_sum(lq1[lane] * lk1[lane])) - expf(wave_sum(lq2[lane] * lk2[lane])) + 0.2f;
    const bf16_t* qrow = PROJ + (size_t)t * INW + h * 128;
    sq[wid][lane] = bf2f(qrow[lane]) * 0.125f; sq[wid][64 + lane] = bf2f(qrow[64 + lane]) * 0.125f;
    __syncthreads();
    float m0 = -INFINITY, m1 = -INFINITY, l0 = 0.f, l1 = 0.f, o00 = 0.f, o01 = 0.f, o10 = 0.f, o11 = 0.f;
    const int nt = s / 64 + 1;
    for (int kt = 0; kt < nt; ++kt) {
        const int key = kt * 64 + lane; const bool valid = key <= s;
        const bf16_t* krow = PROJ + (size_t)(b * SEQ + key) * INW + 512 + h * 128;
        float s0 = 0.f, s1 = 0.f;
#pragma unroll
        for (int ch = 0; ch < 8; ++ch) {
            const u32x4 k0 = *(const u32x4*)(krow + ch * 8); const u32x4 k1 = *(const u32x4*)(krow + 64 + ch * 8);
#pragma unroll
            for (int e = 0; e < 4; ++e) {
                s0 += sq[wid][ch * 8 + 2 * e] * __uint_as_float(k0[e] << 16) + sq[wid][ch * 8 + 2 * e + 1] * __uint_as_float(k0[e] & 0xffff0000u);
                s1 += sq[wid][64 + ch * 8 + 2 * e] * __uint_as_float(k1[e] << 16) + sq[wid][64 + ch * 8 + 2 * e + 1] * __uint_as_float(k1[e] & 0xffff0000u);
            }
        }
        if (!valid) { s0 = -INFINITY; s1 = -INFINITY; }
        const float mn0 = fmaxf(m0, wave_max(s0)), mn1 = fmaxf(m1, wave_max(s1));
        const float al0 = expf(m0 - mn0), al1 = expf(m1 - mn1);
        const float p0 = valid ? expf(s0 - mn0) : 0.f, p1 = valid ? expf(s1 - mn1) : 0.f;
        l0 = l0 * al0 + wave_sum(p0); l1 = l1 * al1 + wave_sum(p1);
        o00 *= al0; o01 *= al0; o10 *= al1; o11 *= al1; m0 = mn0; m1 = mn1;
        __syncthreads();
        sp[wid][0][lane] = p0; sp[wid][1][lane] = p1;
        __syncthreads();
        const bf16_t* vbase = PROJ + (size_t)(b * SEQ + kt * 64) * INW + 1024 + h * 128;
#pragma unroll 8
        for (int j = 0; j < 64; ++j) {
            const float va = bf2f(vbase[(size_t)j * INW + lane]), vb = bf2f(vbase[(size_t)j * INW + 64 + lane]);
            const float pj0 = sp[wid][0][j], pj1 = sp[wid][1][j];
            o00 += pj0 * va; o01 += pj0 * vb; o10 += pj1 * va; o11 += pj1 * vb;
        }
    }
    const float oa = o00 / l0 - lam * (o10 / l1), ob = o01 / l0 - lam * (o11 / l1);
    const float ss = wave_sum(oa * oa + ob * ob) * (1.f / 128.f);
    const float rs = 1.0f / sqrtf(ss + EPS) * 0.8f;
    CAT[(size_t)t * D + h * 128 + lane] = (bf16_t)f2bf(oa * rs * subln_w[lane]);
    CAT[(size_t)t * D + h * 128 + 64 + lane] = (bf16_t)f2bf(ob * rs * subln_w[64 + lane]);
}

__global__ __launch_bounds__(256) void k_pool(const bf16_t* __restrict__ PROJ, bf16_t* __restrict__ CAT) {
    const int idx = blockIdx.x * 256 + threadIdx.x; const int t = idx >> 9, c = idx & 511, g = c >> 7, w = 2 << g, s = t % SEQ;
    const int n = (s + 1 < w) ? s + 1 : w;
    float sum = 0.f;
    for (int i = 0; i < n; ++i) sum += bf2f(PROJ[(size_t)(t - i) * INW + 1536 + c]);
    const float u = bf2f(PROJ[(size_t)t * INW + 1536 + c]);
    CAT[(size_t)t * D + 512 + c] = (bf16_t)f2bf(sum / (float)n - u);
}

__global__ __launch_bounds__(256) void k_router(const float* __restrict__ x1, const float* __restrict__ fw, const float* __restrict__ rw, const float* __restrict__ rb,
                                                bf16_t* __restrict__ XN2, int* __restrict__ cnt, int* __restrict__ ltok, float* __restrict__ lgate, int* __restrict__ slot) {
    const int t = blockIdx.x * 4 + (threadIdx.x >> 6), lane = threadIdx.x & 63;
    float v[16]; float s = 0.f;
#pragma unroll
    for (int i = 0; i < 16; ++i) { v[i] = x1[(size_t)t * D + i * 64 + lane]; s += v[i] * v[i]; }
    const float rstd = 1.0f / sqrtf(wave_sum(s) * (1.f / D) + EPS);
    float acc[32];
#pragma unroll
    for (int e = 0; e < 32; ++e) acc[e] = 0.f;
#pragma unroll
    for (int i = 0; i < 16; ++i) {
        const int k = i * 64 + lane; const float hv = v[i] * rstd * fw[k];
        XN2[(size_t)t * D + k] = (bf16_t)f2bf(hv);
        const f32x4* wr = (const f32x4*)(rw + (size_t)k * 32);
#pragma unroll
        for (int q = 0; q < 8; ++q) { const f32x4 w4 = wr[q]; acc[4 * q] += hv * w4.x; acc[4 * q + 1] += hv * w4.y; acc[4 * q + 2] += hv * w4.z; acc[4 * q + 3] += hv * w4.w; }
    }
#pragma unroll
    for (int e = 0; e < 32; ++e) acc[e] = wave_sum(acc[e]) + rb[e];
    unsigned used = 0u; float tv[4]; int ti[4];
#pragma unroll
    for (int k = 0; k < 4; ++k) {
        float best = -INFINITY; int bi = 0;
#pragma unroll
        for (int e = 0; e < 32; ++e) { const bool take = !((used >> e) & 1u) && (acc[e] > best); best = take ? acc[e] : best; bi = take ? e : bi; }
        tv[k] = best; ti[k] = bi; used |= 1u << bi;
    }
    const float e1 = expf(tv[1] - tv[0]), e2 = expf(tv[2] - tv[0]), e3 = expf(tv[3] - tv[0]); const float inv = 1.f / (1.f + e1 + e2 + e3);
    const float g[4] = {inv, e1 * inv, e2 * inv, e3 * inv};
    if (lane == 0) {
        const int ch = t / TC;
#pragma unroll
        for (int k = 0; k < 4; ++k) {
            const int pos = atomicAdd(&cnt[ch * 32 + ti[k]], 1);
            ltok[((size_t)ch * 32 + ti[k]) * TC + pos] = t; lgate[((size_t)ch * 32 + ti[k]) * TC + pos] = g[k];
            slot[t * 4 + k] = (ti[k] << 16) | pos;
        }
    }
}

__device__ __forceinline__ bool moe_locate(const int* cnt, int mt, int& e, int& lt, int& n_e) {
    int base = 0; e = -1;
    for (int i = 0; i < 32; ++i) { const int c = cnt[i], nt = (c + TM - 1) / TM; if (e < 0 && mt < base + nt) { e = i; lt = mt - base; n_e = c; } base += nt; }
    return e >= 0;
}
__global__ __launch_bounds__(256, 2) void k_moe_gu(const bf16_t* __restrict__ XN2, const bf16_t* __restrict__ Wgu_t, const float* __restrict__ b_gu, const int* __restrict__ cnt,
                                                   const int* __restrict__ ltok, bf16_t* __restrict__ HM) {
    __shared__ __attribute__((aligned(16))) bf16_t shm[2 * 128 * 32];
    const int mt = blockIdx.x >> 4, nt = blockIdx.x & 15;
    int e, lt, n_e; if (!moe_locate(cnt, mt, e, lt, n_e)) return;
    const int tid = threadIdx.x, r = tid >> 2, c = (tid & 3) * 8;
    const int p0 = lt * TM + r, p1 = p0 + 64;
    const int tok0 = p0 < n_e ? ltok[(size_t)e * TC + p0] : 0, tok1 = p1 < n_e ? ltok[(size_t)e * TC + p1] : 0;
    const bf16_t* a0 = XN2 + (size_t)tok0 * D + c; const bf16_t* a1 = XN2 + (size_t)tok1 * D + c;
    const bf16_t* b0 = Wgu_t + ((size_t)e * 2048 + nt * 128 + r) * D + c; const bf16_t* b1 = b0 + (size_t)64 * D;
    f32x4 acc[4][4];
    gemm128_core(a0, a1, b0, b1, D, shm, acc);
    const int wid = tid >> 6, lane = tid & 63, wr = wid >> 1, wc = wid & 1, fr = lane & 15, fq = lane >> 4;
    const float* bg = b_gu + (size_t)e * 2048;
#pragma unroll
    for (int n = 0; n < 2; ++n) {
        const int f = (nt * 2 + wc) * 32 + n * 16 + fr; const float bgate = bg[f], bup = bg[1024 + f];
#pragma unroll
        for (int m = 0; m < 4; ++m)
#pragma unroll
            for (int j = 0; j < 4; ++j) {
                const float gv = fminf(acc[m][n][j] + bgate, 7.0f), uv = fminf(fmaxf(acc[m][n + 2][j] + bup, -7.0f), 7.0f);
                const float glu = gv / (1.0f + expf(-1.702f * gv));
                const size_t row = (size_t)mt * TM + wr * 64 + m * 16 + fq * 4 + j;
                HM[row * FF + f] = (bf16_t)f2bf((uv + 1.0f) * glu);
            }
    }
}
__global__ __launch_bounds__(256, 2) void k_moe_down(const bf16_t* __restrict__ HM, const bf16_t* __restrict__ Wd_t, const float* __restrict__ b_d, const int* __restrict__ cnt,
                                                     const float* __restrict__ lgate, bf16_t* __restrict__ YP) {
    __shared__ __attribute__((aligned(16))) bf16_t shm[2 * 128 * 32];
    const int mt = blockIdx.x >> 3, nt = blockIdx.x & 7;
    int e, lt, n_e; if (!moe_locate(cnt, mt, e, lt, n_e)) return;
    const int tid = threadIdx.x, r = tid >> 2, c = (tid & 3) * 8;
    const bf16_t* a0 = HM + ((size_t)mt * TM + r) * FF + c; const bf16_t* a1 = a0 + (size_t)64 * FF;
    const bf16_t* b0 = Wd_t + ((size_t)e * 1024 + nt * 128 + r) * FF + c; const bf16_t* b1 = b0 + (size_t)64 * FF;
    f32x4 acc[4][4];
    gemm128_core(a0, a1, b0, b1, FF, shm, acc);
    const int wid = tid >> 6, lane = tid & 63, wr = wid >> 1, wc = wid & 1, fr = lane & 15, fq = lane >> 4;
#pragma unroll
    for (int m = 0; m < 4; ++m)
#pragma unroll
        for (int j = 0; j < 4; ++j) {
            const int rl = wr * 64 + m * 16 + fq * 4 + j, p = lt * TM + rl;
            const float g = p < n_e ? lgate[(size_t)e * TC + p] : 0.f;
#pragma unroll
            for (int n = 0; n < 4; ++n) { const int col = nt * 128 + wc * 64 + n * 16 + fr;
                YP[((size_t)mt * TM + rl) * D + col] = (bf16_t)f2bf((acc[m][n][j] + b_d[e * 1024 + col]) * g); }
        }
}
__global__ __launch_bounds__(256) void k_final(float* __restrict__ xo, const bf16_t* __restrict__ YP, const int* __restrict__ cnt, const int* __restrict__ slot, const float* __restrict__ w, int t0) {
    const int t = t0 + blockIdx.x * 4 + (threadIdx.x >> 6), lane = threadIdx.x & 63;
    int rows[4];
#pragma unroll
    for (int k = 0; k < 4; ++k) { const int sl = slot[t * 4 + k], e = sl >> 16, pos = sl & 0xffff; int base = 0;
        for (int i = 0; i < 32; ++i) { const int nt = (cnt[i] + TM - 1) / TM; base += (i < e) ? nt : 0; }
        rows[k] = base * TM + pos; }
    f32x4* xr = (f32x4*)(xo + (size_t)t * D) + lane;
    f32x4 v[4]; float s = 0.f;
#pragma unroll
    for (int j = 0; j < 4; ++j) {
        v[j] = xr[64 * j];
#pragma unroll
        for (int k = 0; k < 4; ++k) { const unsigned long long y = *((const unsigned long long*)(YP + (size_t)rows[k] * D) + 64 * j + lane);
            v[j].x += bf2f((unsigned)(y & 0xffff)); v[j].y += bf2f((unsigned)((y >> 16) & 0xffff)); v[j].z += bf2f((unsigned)((y >> 32) & 0xffff)); v[j].w += bf2f((unsigned)(y >> 48)); }
        s += v[j].x * v[j].x + v[j].y * v[j].y + v[j].z * v[j].z + v[j].w * v[j].w;
    }
    const float rstd = 1.0f / sqrtf(wave_sum(s) * (1.f / D) + EPS);
#pragma unroll
    for (int j = 0; j < 4; ++j) { const f32x4 ww = ((const f32x4*)w)[64 * j + lane]; xr[64 * j] = (f32x4){v[j].x * rstd * ww.x, v[j].y * rstd * ww.y, v[j].z * rstd * ww.z, v[j].w * rstd * ww.w}; }
}

extern "C" void kernel_launch(void* const* d_in, const int* in_sizes, int n_in, void* d_out, int out_size, void* d_ws, size_t ws_size, hipStream_t stream) {
    if (n_in != 20 || in_sizes[0] != T * D || out_size != T * D || ws_size < WS_END) { fprintf(stderr, "kernel_launch: unexpected shapes / workspace (%d, %d, %d, %zu)\n", n_in, n_in > 0 ? in_sizes[0] : -1, out_size, ws_size); return; }
    const float* x = (const float*)d_in[0]; const int* positions = (const int*)d_in[1]; const float* attn_norm_w = (const float*)d_in[2]; const float* w_in = (const float*)d_in[3];
    const float* lq1 = (const float*)d_in[4]; const float* lk1 = (const float*)d_in[5]; const float* lq2 = (const float*)d_in[6]; const float* lk2 = (const float*)d_in[7];
    const float* subln_w = (const float*)d_in[8]; const float* pool_w = (const float*)d_in[9]; const float* pool_scale = (const float*)d_in[10]; const float* w_out = (const float*)d_in[11];
    const float* ffn_norm_w = (const float*)d_in[12]; const float* router_w = (const float*)d_in[13]; const float* router_b = (const float*)d_in[14];
    const float* w_gu = (const float*)d_in[15]; const float* b_gu = (const float*)d_in[16]; const float* w_down = (const float*)d_in[17]; const float* b_down = (const float*)d_in[18]; const float* final_w = (const float*)d_in[19];
    char* ws = (char*)d_ws; float* out = (float*)d_out;
    int* cnt = (int*)(ws + WS_CTL); int* ltok = (int*)(ws + WS_LTOK); float* lgate = (float*)(ws + WS_LGATE); int* slot = (int*)(ws + WS_SLOT); float* rope = (float*)(ws + WS_ROPE);
    bf16_t* Win_t = (bf16_t*)(ws + WS_WIN); bf16_t* Wo_t = (bf16_t*)(ws + WS_WO); bf16_t* Wd_t = (bf16_t*)(ws + WS_WD); bf16_t* Wgu_t = (bf16_t*)(ws + WS_WGU);
    bf16_t* XN = (bf16_t*)(ws + WS_XN); bf16_t* PROJ = (bf16_t*)(ws + WS_PROJ); bf16_t* CAT = (bf16_t*)(ws + WS_CAT); bf16_t* HM = (bf16_t*)(ws + WS_HM); bf16_t* YP = (bf16_t*)(ws + WS_YP);

    (void)hipMemsetAsync(cnt, 0, 4096, stream);
    k_transpose<0><<<dim3(INW / 32, D / 32, 1), 256, 0, stream>>>(w_in, Win_t, D, INW, D);
    k_transpose<0><<<dim3(D / 32, 512 / 32, 1), 256, 0, stream>>>(w_out, Wo_t, 512, D, D);
    k_fold_pool<<<512 * 1024 / 256, 256, 0, stream>>>(pool_w, pool_scale, w_out, Wo_t);
    k_transpose<1><<<dim3(2048 / 32, D / 32, NE), 256, 0, stream>>>(w_gu, Wgu_t, D, 2048, D);
    k_transpose<0><<<dim3(D / 32, FF / 32, NE), 256, 0, stream>>>(w_down, Wd_t, FF, D, FF);
    k_rope_table<<<T * 8 / 256, 256, 0, stream>>>(positions, rope);
    k_rmsnorm<<<T / 4, 256, 0, stream>>>(x, attn_norm_w, XN);
    k_gemm_dense<0><<<(T / 128) * (INW / 128), 256, 0, stream>>>(XN, Win_t, INW, D, PROJ, nullptr);
    k_rope<<<T * 128 / 256, 256, 0, stream>>>(PROJ, rope);
    k_attn_simple<<<T, 256, 0, stream>>>(PROJ, subln_w, lq1, lk1, lq2, lk2, CAT);
    k_pool<<<T * 512 / 256, 256, 0, stream>>>(PROJ, CAT);
    k_gemm_dense<1><<<(T / 128) * (D / 128), 256, 0, stream>>>(CAT, Wo_t, D, D, out, x);
    k_router<<<T / 4, 256, 0, stream>>>(out, ffn_norm_w, router_w, router_b, XN, cnt, ltok, lgate, slot);
    constexpr int MAXMT = PC / TM;
    for (int ch = 0; ch < NCHUNK; ++ch) {
        const int* cc = cnt + ch * 32; const int* lt = ltok + (size_t)ch * 32 * TC; const float* lg = lgate + (size_t)ch * 32 * TC;
        k_moe_gu<<<MAXMT * 16, 256, 0, stream>>>(XN, Wgu_t, b_gu, cc, lt, HM);
        k_moe_down<<<MAXMT * 8, 256, 0, stream>>>(HM, Wd_t, b_down, cc, lg, YP);
        k_final<<<TC / 4, 256, 0, stream>>>(out, YP, cc, slot, final_w, ch * TC);
    }
}
```

```cpp
#include <hip/hip_runtime.h>
#include <cstdint>
#include <cstdio>

typedef unsigned short bf16_t;
typedef short bf16x8 __attribute__((ext_vector_type(8)));
typedef float f32x4 __attribute__((ext_vector_type(4)));
typedef unsigned u32x4 __attribute__((ext_vector_type(4)));

constexpr int T = 65536, D = 1024, SEQ = 2048, INW = 2048, NE = 32, FF = 1024, TOPK = 4;
constexpr int NCHUNK = 2, TC = T / NCHUNK;
constexpr int TM = 256;
constexpr int PC = TC * TOPK + NE * TM;
constexpr float EPS = 1e-5f;

constexpr size_t MiB = 1u << 20;
constexpr size_t WS_CTL = 0;
constexpr size_t WS_LTOK = 1 * MiB;
constexpr size_t WS_LGATE = 9 * MiB;
constexpr size_t WS_SLOT = 17 * MiB;
constexpr size_t WS_ROPE = 18 * MiB;
constexpr size_t WS_WIN = 22 * MiB;
constexpr size_t WS_WO = 26 * MiB;
constexpr size_t WS_WD = 28 * MiB;
constexpr size_t WS_WGU = 92 * MiB;
constexpr size_t WS_XN = 220 * MiB;
constexpr size_t WS_PROJ = 348 * MiB;
constexpr size_t WS_CAT = 604 * MiB;
constexpr size_t WS_HM = 348 * MiB;
constexpr size_t WS_YP = 640 * MiB;
constexpr size_t WS_END = 920 * MiB;
static_assert(WS_HM + (size_t)PC * 1024 * 2 <= WS_YP && WS_YP + (size_t)PC * 1024 * 2 <= WS_END, "ws map");

__device__ __forceinline__ unsigned f2bf(float f) { unsigned u = __float_as_uint(f); return (u + 0x7fffu + ((u >> 16) & 1u)) >> 16; }
__device__ __forceinline__ float bf2f(unsigned h) { return __uint_as_float(h << 16); }
__device__ __forceinline__ float wave_sum(float v) {
#pragma unroll
    for (int o = 1; o < 64; o <<= 1) v += __shfl_xor(v, o);
    return v;
}
__device__ __forceinline__ float wave_max(float v) {
#pragma unroll
    for (int o = 1; o < 64; o <<= 1) v = fmaxf(v, __shfl_xor(v, o));
    return v;
}

template <int MODE>
__global__ __launch_bounds__(256) void k_transpose(const float* __restrict__ W, bf16_t* __restrict__ WT, int K, int N, int ldk  ) {
    __shared__ float tile[32][33];
    const int tx = threadIdx.x & 31, ty = threadIdx.x >> 5;
    const int n0 = blockIdx.x * 32, k0 = blockIdx.y * 32;
    const float* Wb = W + (size_t)blockIdx.z * K * N;
    bf16_t* WTb = WT + (size_t)blockIdx.z * N * ldk;
#pragma unroll
    for (int i = 0; i < 4; ++i) tile[ty + 8 * i][tx] = Wb[(size_t)(k0 + ty + 8 * i) * N + n0 + tx];
    __syncthreads();
#pragma unroll
    for (int i = 0; i < 4; ++i) {
        const int n = n0 + ty + 8 * i, k = k0 + tx;
        int row = n;
        if (MODE == 1) { const int f = n & 1023, up = n >> 10; row = (f >> 7) * 256 + up * 128 + (f & 127); }
        WTb[(size_t)row * ldk + k] = (bf16_t)f2bf(tile[tx][ty + 8 * i]);
    }
}
__global__ __launch_bounds__(256) void k_fold_pool(const float* __restrict__ pool_w, const float* __restrict__ pool_scale, const float* __restrict__ w_out, bf16_t* __restrict__ Wo_t) {
    const int idx = blockIdx.x * 256 + threadIdx.x;
    const int n = idx & 1023, gc = idx >> 10, g = gc >> 7;
    float acc = 0.f;
    for (int d = 0; d < 128; ++d) acc += pool_w[(size_t)gc * 128 + d] * pool_scale[g * 128 + d] * w_out[(size_t)(512 + g * 128 + d) * 1024 + n];
    Wo_t[(size_t)n * 1024 + 512 + gc] = (bf16_t)f2bf(acc);
}
__global__ __launch_bounds__(256) void k_rope_table(const int* __restrict__ positions, float* __restrict__ rope) {
    const int idx = blockIdx.x * 256 + threadIdx.x; const int t = idx >> 3, j = idx & 7;
    const double inv = exp(-(double)(2 * j) / 16.0 * log(500000.0));
    const double ang = (double)positions[t] * inv;
    rope[(size_t)t * 16 + j] = (float)cos(ang); rope[(size_t)t * 16 + 8 + j] = (float)sin(ang);
}
__global__ __launch_bounds__(256) void k_rmsnorm(const float* __restrict__ x, const float* __restrict__ w, bf16_t* __restrict__ out) {
    const int row = blockIdx.x * 4 + (threadIdx.x >> 6), lane = threadIdx.x & 63;
    const f32x4* xr = (const f32x4*)(x + (size_t)row * D) + lane;
    f32x4 v[4]; float s = 0.f;
#pragma unroll
    for (int j = 0; j < 4; ++j) { v[j] = xr[64 * j]; s += v[j].x * v[j].x + v[j].y * v[j].y + v[j].z * v[j].z + v[j].w * v[j].w; }
    const float rstd = 1.0f / sqrtf(wave_sum(s) * (1.f / D) + EPS);
    unsigned long long* o8 = (unsigned long long*)(out + (size_t)row * D) + lane;
#pragma unroll
    for (int j = 0; j < 4; ++j) { const f32x4 ww = ((const f32x4*)w)[64 * j + lane];
        const unsigned lo = f2bf(v[j].x * rstd * ww.x) | (f2bf(v[j].y * rstd * ww.y) << 16), hi = f2bf(v[j].z * rstd * ww.z) | (f2bf(v[j].w * rstd * ww.w) << 16);
        o8[64 * j] = (unsigned long long)lo | ((unsigned long long)hi << 32); }
}

__global__ __launch_bounds__(256) void k_rope(bf16_t* __restrict__ PROJ, const float* __restrict__ rope) {
    const int idx = blockIdx.x * 256 + threadIdx.x;
    const int t = idx >> 7, r = idx & 127, j = r & 7, comp = r >> 3;
    bf16_t* p = PROJ + (size_t)t * INW + comp * 64;
    const float cs = rope[(size_t)t * 16 + j], sn = rope[(size_t)t * 16 + 8 + j];
    const float a = bf2f(p[j]), b = bf2f(p[8 + j]);
    p[j] = (bf16_t)f2bf(a * cs - b * sn); p[8 + j] = (bf16_t)f2bf(b * cs + a * sn);
}

__global__ __launch_bounds__(256) void k_attn_simple(const bf16_t* __restrict__ PROJ, const float* __restrict__ subln_w, const float* __restrict__ lq1, const float* __restrict__ lk1,
                                                     const float* __restrict__ lq2, const float* __restrict__ lk2, bf16_t* __restrict__ CAT) {
    __shared__ float sq[4][128];
    __shared__ float sp[4][2][64];
    const int wid = threadIdx.x >> 6, lane = threadIdx.x & 63;
    const int t = blockIdx.x, h = wid, b = t / SEQ, s = t % SEQ;
    const float lam = expf(wave_sum(lq1[lane] * lk1[lane])) - expf(wave_sum(lq2[lane] * lk2[lane])) + 0.2f;
    const bf16_t* qrow = PROJ + (size_t)t * INW + h * 128;
    sq[wid][lane] = bf2f(qrow[lane]) * 0.125f; sq[wid][64 + lane] = bf2f(qrow[64 + lane]) * 0.125f;
    __syncthreads();
    float m0 = -INFINITY, m1 = -INFINITY, l0 = 0.f, l1 = 0.f, o00 = 0.f, o01 = 0.f, o10 = 0.f, o11 = 0.f;
    const int nt = s / 64 + 1;
    for (int kt = 0; kt < nt; ++kt) {
        const int key = kt * 64 + lane; const bool valid = key <= s;
        const bf16_t* krow = PROJ + (size_t)(b * SEQ + key) * INW + 512 + h * 128;
        float s0 = 0.f, s1 = 0.f;
#pragma unroll
        for (int ch = 0; ch < 8; ++ch) {
            const u32x4 k0 = *(const u32x4*)(krow + ch * 8); const u32x4 k1 = *(const u32x4*)(krow + 64 + ch * 8);
#pragma unroll
            for (int e = 0; e < 4; ++e) {
                s0 += sq[wid][ch * 8 + 2 * e] * __uint_as_float(k0[e] << 16) + sq[wid][ch * 8 + 2 * e + 1] * __uint_as_float(k0[e] & 0xffff0000u);
                s1 += sq[wid][64 + ch * 8 + 2 * e] * __uint_as_float(k1[e] << 16) + sq[wid][64 + ch * 8 + 2 * e + 1] * __uint_as_float(k1[e] & 0xffff0000u);
            }
        }
        if (!valid) { s0 = -INFINITY; s1 = -INFINITY; }
        const float mn0 = fmaxf(m0, wave_max(s0)), mn1 = fmaxf(m1, wave_max(s1));
        const float al0 = expf(m0 - mn0), al1 = expf(m1 - mn1);
        const float p0 = valid ? expf(s0 - mn0) : 0.f, p1 = valid ? expf(s1 - mn1) : 0.f;
        l0 = l0 * al0 + wave_sum(p0); l1 = l1 * al1 + wave_sum(p1);
        o00 *= al0; o01 *= al0; o10 *= al1; o11 *= al1; m0 = mn0; m1 = mn1;
        __syncthreads();
        sp[wid][0][lane] = p0; sp[wid][1][lane] = p1;
        __syncthreads();
        const bf16_t* vbase = PROJ + (size_t)(b * SEQ + kt * 64) * INW + 1024 + h * 128;
#pragma unroll 8
        for (int j = 0; j < 64; ++j) {
            const float va = bf2f(vbase[(size_t)j * INW + lane]), vb = bf2f(vbase[(size_t)j * INW + 64 + lane]);
            const float pj0 = sp[wid][0][j], pj1 = sp[wid][1][j];
            o00 += pj0 * va; o01 += pj0 * vb; o10 += pj1 * va; o11 += pj1 * vb;
        }
    }
    const float oa = o00 / l0 - lam * (o10 / l1), ob = o01 / l0 - lam * (o11 / l1);
    const float ss = wave_sum(oa * oa + ob * ob) * (1.f / 128.f);
    const float rs = 1.0f / sqrtf(ss + EPS) * 0.8f;
    CAT[(size_t)t * D + h * 128 + lane] = (bf16_t)f2bf(oa * rs * subln_w[lane]);
    CAT[(size_t)t * D + h * 128 + 64 + lane] = (bf16_t)f2bf(ob * rs * subln_w[64 + lane]);
}

__global__ __launch_bounds__(256) void k_pool(const bf16_t* __restrict__ PROJ, bf16_t* __restrict__ CAT) {
    const int idx = blockIdx.x * 256 + threadIdx.x; const int t = idx >> 9, c = idx & 511, g = c >> 7, w = 2 << g, s = t % SEQ;
    const int n = (s + 1 < w) ? s + 1 : w;
    float sum = 0.f;
    for (int i = 0; i < n; ++i) sum += bf2f(PROJ[(size_t)(t - i) * INW + 1536 + c]);
    const float u = bf2f(PROJ[(size_t)t * INW + 1536 + c]);
    CAT[(size_t)t * D + 512 + c] = (bf16_t)f2bf(sum / (float)n - u);
}

__global__ __launch_bounds__(256) void k_router(const float* __restrict__ x1, const float* __restrict__ fw, const float* __restrict__ rw, const float* __restrict__ rb,
                                                bf16_t* __restrict__ XN2, int* __restrict__ cnt, int* __restrict__ ltok, float* __restrict__ lgate, int* __restrict__ slot) {
    const int t = blockIdx.x * 4 + (threadIdx.x >> 6), lane = threadIdx.x & 63;
    float v[16]; float s = 0.f;
#pragma unroll
    for (int i = 0; i < 16; ++i) { v[i] = x1[(size_t)t * D + i * 64 + lane]; s += v[i] * v[i]; }
    const float rstd = 1.0f / sqrtf(wave_sum(s) * (1.f / D) + EPS);
    float acc[32];
#pragma unroll
    for (int e = 0; e < 32; ++e) acc[e] = 0.f;
#pragma unroll
    for (int i = 0; i < 16; ++i) {
        const int k = i * 64 + lane; const float hv = v[i] * rstd * fw[k];
        XN2[(size_t)t * D + k] = (bf16_t)f2bf(hv);
        const f32x4* wr = (const f32x4*)(rw + (size_t)k * 32);
#pragma unroll
        for (int q = 0; q < 8; ++q) { const f32x4 w4 = wr[q]; acc[4 * q] += hv * w4.x; acc[4 * q + 1] += hv * w4.y; acc[4 * q + 2] += hv * w4.z; acc[4 * q + 3] += hv * w4.w; }
    }
#pragma unroll
    for (int e = 0; e < 32; ++e) acc[e] = wave_sum(acc[e]) + rb[e];
    unsigned used = 0u; float tv[4]; int ti[4];
#pragma unroll
    for (int k = 0; k < 4; ++k) {
        float best = -INFINITY; int bi = 0;
#pragma unroll
        for (int e = 0; e < 32; ++e) { const bool take = !((used >> e) & 1u) && (acc[e] > best); best = take ? acc[e] : best; bi = take ? e : bi; }
        tv[k] = best; ti[k] = bi; used |= 1u << bi;
    }
    const float e1 = expf(tv[1] - tv[0]), e2 = expf(tv[2] - tv[0]), e3 = expf(tv[3] - tv[0]); const float inv = 1.f / (1.f + e1 + e2 + e3);
    const float g[4] = {inv, e1 * inv, e2 * inv, e3 * inv};
    if (lane == 0) {
        const int ch = t / TC;
#pragma unroll
        for (int k = 0; k < 4; ++k) {
            const int pos = atomicAdd(&cnt[ch * 32 + ti[k]], 1);
            ltok[((size_t)ch * 32 + ti[k]) * TC + pos] = t; lgate[((size_t)ch * 32 + ti[k]) * TC + pos] = g[k];
            slot[t * 4 + k] = (ti[k] << 16) | pos;
        }
    }
}

namespace pg8 {
#define PG8_LAS __attribute__((address_space(3)))
constexpr int BM = 256, BK = 64, HALF = 128, HTB = HALF * BK * 2  , STAGE_BYTES = 8 * HTB;
__host__ __device__ __forceinline__ int lds_byte(int r, int c) { const int st = (r >> 4) * 2 + (c >> 5), rr = r & 15, cc = c & 31, ob = rr * 64 + cc * 2; return st * 1024 + (ob ^ (((ob >> 9) & 1) << 5)); }
__host__ __device__ __forceinline__ void stage_rc(int b, int& R, int& C) { const int st = b / 1024, sb = b % 1024, swz = sb ^ (((sb >> 9) & 1) << 5); R = (st >> 1) * 16 + swz / 64; C = (st & 1) * 32 + (swz % 64) / 2; }
__host__ __device__ __forceinline__ int perm32(int rho) { const int n = rho >> 4, i = rho & 15; return 8 * (i >> 2) + 4 * n + (i & 3); }
__device__ __forceinline__ unsigned cvt_pk_bf16(float lo, float hi) { unsigned r; asm volatile("v_cvt_pk_bf16_f32 %0, %1, %2" : "=v"(r) : "v"(lo), "v"(hi)); return r; }

struct Unit { int pm, pn, e, lt, ne; };

template <int K, class Epi, class Plan>
__device__ __forceinline__ void gemm_phase(PG8_LAS unsigned char* lds, const bf16_t* gA_, const bf16_t* gBt_, const Plan& S, const Epi& E) {
    const int tid = threadIdx.x, wid = __builtin_amdgcn_readfirstlane(tid >> 6), lane = tid & 63, wr = wid >> 2, wc = wid & 3, fr = lane & 15, fq = lane >> 4;
    constexpr int nt = K / BK;
    unsigned voffB[2];
#pragma unroll
    for (int i = 0; i < 2; ++i) { int R, C; stage_rc(tid * 16 + i * 8192, R, C); const int Rb = Epi::PERM ? ((R & ~31) + perm32(R & 31)) : R; voffB[i] = (unsigned)(Rb * K + C) * 2u; }
    const size_t kstep = (size_t)(BK * 2);
    const size_t hstep = (size_t)HALF * K * 2;
    const size_t tstep = 2 * hstep;
    const unsigned ldsw = (unsigned)wid * 1024u;
    const int aoff = lds_byte(wr * 64 + fr, fq * 8), boff = lds_byte(wc * 32 + fr, fq * 8);
#define PG8_SA(b, h) (((b) * 2 + (h)) * HTB)
#define PG8_SB(b, h) ((4 + (b) * 2 + (h)) * HTB)
#define PG8_STAGE(bufoff, gbase, voff) do { _Pragma("unroll") for (int _i = 0; _i < 2; ++_i) \
        __builtin_amdgcn_global_load_lds((const unsigned*)((const char*)(gbase) + (voff)[_i]), (PG8_LAS unsigned*)(lds + (bufoff) + ldsw + _i * 8192), 16, 0, 0); } while (0)
#define PG8_LDA(dst, b, h) do { _Pragma("unroll") for (int m = 0; m < 4; ++m) _Pragma("unroll") for (int k = 0; k < 2; ++k) dst[m][k] = *(const PG8_LAS bf16x8*)(lds + PG8_SA(b, h) + aoff + m * 2048 + k * 1024); } while (0)
#define PG8_LDB(dst, b, h) do { _Pragma("unroll") for (int n = 0; n < 2; ++n) _Pragma("unroll") for (int k = 0; k < 2; ++k) dst[n][k] = *(const PG8_LAS bf16x8*)(lds + PG8_SB(b, h) + boff + n * 2048 + k * 1024); } while (0)
#define PG8_MMA(ai, bj, At, Bt) do { __builtin_amdgcn_s_setprio(1); _Pragma("unroll") for (int m = 0; m < 4; ++m) _Pragma("unroll") for (int n = 0; n < 2; ++n) _Pragma("unroll") for (int k = 0; k < 2; ++k) \
        acc[ai][bj][m][n] = __builtin_amdgcn_mfma_f32_16x16x32_bf16(Bt[n][k], At[m][k], acc[ai][bj][m][n], 0, 0, 0); __builtin_amdgcn_s_setprio(0); } while (0)
#define PG8_WAIT_V(n) asm volatile("s_waitcnt vmcnt(" #n ")" ::: "memory")
#define PG8_WAIT_L(n) asm volatile("s_waitcnt lgkmcnt(" #n ")" ::: "memory")
#define PG8_BAR __builtin_amdgcn_s_barrier()
#define PG8_SCHED __builtin_amdgcn_sched_barrier(0)
#define PG8_VOFF(dst, U, UI) do { int _tv = tid; asm volatile("" : "+v"(_tv)); _Pragma("unroll") for (int _i = 0; _i < 2; ++_i) { int _R, _C; stage_rc(_tv * 16 + _i * 8192, _R, _C); \
        _Pragma("unroll") for (int _h = 0; _h < 2; ++_h) dst[_h][_i] = (S.rowA(U, UI, _h * HALF + _R) * (unsigned)K + (unsigned)_C) * 2u; } } while (0)
#define PG8_SP1A(A1) do { \
          \
        PG8_LDB(B0, 0, 0); PG8_LDB(B1, 0, 1); PG8_SCHED; PG8_LDA(At, 0, 0); PG8_STAGE(PG8_SA(1, 1), (A1), vc[1]); \
        PG8_WAIT_V(8); PG8_WAIT_L(0); PG8_BAR; PG8_MMA(0, 0, At, B0); PG8_MMA(0, 1, At, B1); PG8_BAR; PG8_SCHED; } while (0)
#define PG8_REST(A2, B2) do { \
          \
        PG8_LDA(At, 0, 1); PG8_STAGE(PG8_SB(0, 0), (B2), voffB); PG8_STAGE(PG8_SB(0, 1), (B2) + hstep, voffB); PG8_STAGE(PG8_SA(0, 0), (A2), vc[0]); \
        PG8_WAIT_V(8); PG8_WAIT_L(0); PG8_BAR; PG8_MMA(1, 0, At, B0); PG8_MMA(1, 1, At, B1); PG8_BAR; PG8_SCHED; \
          \
        PG8_LDB(B0, 1, 0); PG8_LDB(B1, 1, 1); PG8_SCHED; PG8_LDA(At, 1, 0); PG8_STAGE(PG8_SA(0, 1), (A2), vc[1]); \
        PG8_WAIT_V(8); PG8_WAIT_L(0); PG8_BAR; PG8_MMA(0, 0, At, B0); PG8_MMA(0, 1, At, B1); PG8_BAR; PG8_SCHED; \
          \
        PG8_LDA(At, 1, 1); PG8_STAGE(PG8_SB(1, 0), (B2) + kstep, voffB); PG8_STAGE(PG8_SB(1, 1), (B2) + kstep + hstep, voffB); PG8_STAGE(PG8_SA(1, 0), (A2) + kstep, vc[0]); \
        PG8_WAIT_V(8); PG8_WAIT_L(0); PG8_BAR; PG8_MMA(1, 0, At, B0); PG8_MMA(1, 1, At, B1); PG8_BAR; PG8_SCHED; } while (0)
    Unit cur, nxt; int ui = 0;
    if (!S.next(0, cur)) return;
    f32x4 acc[2][2][4][2];
#pragma unroll
    for (int a = 0; a < 2; ++a)
#pragma unroll
        for (int b = 0; b < 2; ++b)
#pragma unroll
            for (int m = 0; m < 4; ++m)
#pragma unroll
                for (int n = 0; n < 2; ++n) acc[a][b][m][n] = (f32x4){0.f, 0.f, 0.f, 0.f};
    bf16x8 At[4][2], B0[2][2], B1[2][2];
    unsigned vc[2][2];
    PG8_VOFF(vc, cur, 0);
    const char* gA = (const char*)gA_; const char* cB = (const char*)gBt_ + (size_t)cur.pn * tstep;
    PG8_STAGE(PG8_SB(0, 0), cB, voffB); PG8_STAGE(PG8_SB(0, 1), cB + hstep, voffB); PG8_STAGE(PG8_SA(0, 0), gA, vc[0]); PG8_STAGE(PG8_SA(0, 1), gA, vc[1]);
    if (wr == 1) PG8_BAR;
    PG8_WAIT_V(2); PG8_BAR;
    PG8_STAGE(PG8_SB(1, 0), cB + kstep, voffB); PG8_STAGE(PG8_SA(1, 0), gA + kstep, vc[0]); PG8_STAGE(PG8_SB(1, 1), cB + hstep + kstep, voffB);
    PG8_WAIT_V(6); PG8_BAR;
    for (;;) {
        const bool has_next = S.next(ui + 1, nxt);
        const char* nB = has_next ? (const char*)gBt_ + (size_t)nxt.pn * tstep : cB;
        for (int t = 0; t < nt - 2; t += 2) { PG8_SP1A(gA + (size_t)(t + 1) * kstep); PG8_REST(gA + (size_t)(t + 2) * kstep, cB + (size_t)(t + 2) * kstep); }
        PG8_SP1A(gA + (size_t)(nt - 1) * kstep);
        if (has_next) PG8_VOFF(vc, nxt, ui + 1);
        PG8_REST(gA, nB);
        if (wr == 0) PG8_BAR;
        E(acc, cur, wr, wc, fr, fq);
        if (!has_next) break;
#pragma unroll
        for (int a = 0; a < 2; ++a)
#pragma unroll
            for (int b = 0; b < 2; ++b)
#pragma unroll
                for (int m = 0; m < 4; ++m)
#pragma unroll
                    for (int n = 0; n < 2; ++n) acc[a][b][m][n] = (f32x4){0.f, 0.f, 0.f, 0.f};
        cur = nxt; cB = nB; ++ui;
        if (wr == 1) PG8_BAR;
    }
    PG8_WAIT_V(0);
    PG8_BAR;
#undef PG8_SA
#undef PG8_SB
#undef PG8_STAGE
#undef PG8_LDA
#undef PG8_LDB
#undef PG8_MMA
#undef PG8_WAIT_V
#undef PG8_WAIT_L
#undef PG8_BAR
#undef PG8_SCHED
#undef PG8_VOFF
#undef PG8_SP1A
#undef PG8_REST
}

struct DensePlan {
    int nM, nN, nwg, G, c;
    __device__ void init(int M, int N, int G_, int c_) { nM = M / BM; nN = N / BM; nwg = nM * nN; G = G_; c = c_; }
    __device__ __forceinline__ bool next(int i, Unit& u) const {
        const long L = (long)i * G + c; if (L >= nwg) return false;
        int wgid = (int)L; { const int q = nwg / 8, r = nwg % 8, xcd = wgid % 8, off = wgid / 8; wgid = (xcd < r ? xcd * (q + 1) : r * (q + 1) + (xcd - r) * q) + off; }
        const int nig = 8 * nN, gid = wgid / nig, fm = gid * 8, gsz = (nM - fm) < 8 ? (nM - fm) : 8;
        u.pm = fm + ((wgid % nig) % gsz); u.pn = (wgid % nig) / gsz; u.e = 0; u.lt = 0; u.ne = 0; return true;
    }
    __device__ __forceinline__ unsigned rowA(const Unit& u, int, int r) const { return (unsigned)(u.pm * BM + r); }
};
constexpr int MAXU = 20, PLAN_BYTES = MAXU * 32 + MAXU * 1024;
struct MoePlan {
    const PG8_LAS int* desc; const PG8_LAS unsigned* rowtab;
    __device__ __forceinline__ bool next(int i, Unit& u) const {
        if (i >= MAXU) return false;
        const PG8_LAS int* d = desc + i * 8;
        const int v = __builtin_amdgcn_readfirstlane(d[0]); u.pm = __builtin_amdgcn_readfirstlane(d[1]); u.pn = __builtin_amdgcn_readfirstlane(d[2]);
        u.e = __builtin_amdgcn_readfirstlane(d[3]); u.lt = __builtin_amdgcn_readfirstlane(d[4]); u.ne = __builtin_amdgcn_readfirstlane(d[5]); return v != 0;
    }
    __device__ __forceinline__ unsigned rowA(const Unit&, int ui, int r) const { return rowtab[ui * 256 + r]; }
};
template <bool GATHER>
__device__ __forceinline__ MoePlan moe_plan_setup(PG8_LAS unsigned char* tab, const int* cnt, const int* ltok, int NT, int G, int c) {
    PG8_LAS int* desc = (PG8_LAS int*)tab; PG8_LAS unsigned* rowtab = (PG8_LAS unsigned*)(tab + MAXU * 32);
    const int tid = threadIdx.x, xcd = c & 7, j = c >> 3;
    for (int i = 0; i < MAXU; ++i) {
        const int q = i * (G >> 3) + j, mt = (q / NT) * 8 + xcd, pnl = q % NT;
        int base = 0, e = -1, lt = 0, ne = 0;
        for (int k = 0; k < 32; ++k) { const int cc = __hip_atomic_load(cnt + k, __ATOMIC_RELAXED, __HIP_MEMORY_SCOPE_AGENT), ntl = (cc + BM - 1) / BM; if (e < 0 && mt < base + ntl) { e = k; lt = mt - base; ne = cc; } base += ntl; }
        if (tid == 0) { desc[i * 8 + 0] = e >= 0 ? 1 : 0; desc[i * 8 + 1] = mt; desc[i * 8 + 2] = (e >= 0 ? e : 0) * NT + pnl; desc[i * 8 + 3] = e; desc[i * 8 + 4] = lt; desc[i * 8 + 5] = ne; }
        if (tid < 256) { unsigned row = (unsigned)(mt * BM + tid);
            if (GATHER) { const int p = lt * BM + tid; row = (e >= 0 && p < ne) ? (unsigned)ltok[(size_t)e * TC + p] : 0u; }
            rowtab[i * 256 + tid] = row; }
    }
    __syncthreads();
    MoePlan S; S.desc = desc; S.rowtab = rowtab; return S;
}

struct EpiBf16 {
    static constexpr bool PERM = true;
    bf16_t* O; int ldc;
    __device__ __forceinline__ void operator()(const f32x4 (&acc)[2][2][4][2], const Unit& u, int wr, int wc, int fr, int fq) const {
        const int row0 = u.pm * BM + wr * 64 + fr, col0 = u.pn * BM + wc * 32 + 8 * fq;
#pragma unroll
        for (int ai = 0; ai < 2; ++ai)
#pragma unroll
            for (int m = 0; m < 4; ++m) { bf16_t* rowp = O + (size_t)(row0 + ai * HALF + m * 16) * ldc + col0;
#pragma unroll
                for (int bj = 0; bj < 2; ++bj) { const f32x4 v0 = acc[ai][bj][m][0], v1 = acc[ai][bj][m][1];
                    u32x4 w; w.x = cvt_pk_bf16(v0[0], v0[1]); w.y = cvt_pk_bf16(v0[2], v0[3]); w.z = cvt_pk_bf16(v1[0], v1[1]); w.w = cvt_pk_bf16(v1[2], v1[3]);
                    *(u32x4*)(rowp + bj * HALF) = w; } }
    }
};
struct EpiResF32 {
    static constexpr bool PERM = false;
    float* C; const float* resid; int ldc;
    __device__ __forceinline__ void operator()(const f32x4 (&acc)[2][2][4][2], const Unit& u, int wr, int wc, int fr, int fq) const {
        const int row0 = u.pm * BM + wr * 64 + fr, col0 = u.pn * BM + wc * 32 + 4 * fq;
#pragma unroll
        for (int ai = 0; ai < 2; ++ai)
#pragma unroll
            for (int m = 0; m < 4; ++m) { const size_t off = (size_t)(row0 + ai * HALF + m * 16) * ldc + col0;
#pragma unroll
                for (int bj = 0; bj < 2; ++bj)
#pragma unroll
                    for (int n = 0; n < 2; ++n) *(f32x4*)(C + off + bj * HALF + n * 16) = *(const f32x4*)(resid + off + bj * HALF + n * 16) + acc[ai][bj][m][n]; }
    }
};
struct EpiGLU {
    static constexpr bool PERM = true;
    bf16_t* HM; const float* b_gu; int NT;
    __device__ __forceinline__ void operator()(const f32x4 (&acc)[2][2][4][2], const Unit& u, int wr, int wc, int fr, int fq) const {
        const int pnl = u.pn - u.e * NT, f0 = pnl * HALF + wc * 32 + 8 * fq, row0 = u.pm * BM + wr * 64 + fr;
        const float* bg = b_gu + (size_t)u.e * 2048 + f0;
        f32x4 bgt[2], bup[2];
#pragma unroll
        for (int n = 0; n < 2; ++n) { bgt[n] = *(const f32x4*)(bg + 4 * n); bup[n] = *(const f32x4*)(bg + 1024 + 4 * n); }
#pragma unroll
        for (int ai = 0; ai < 2; ++ai)
#pragma unroll
            for (int m = 0; m < 4; ++m) { float h[8];
#pragma unroll
                for (int n = 0; n < 2; ++n)
#pragma unroll
                    for (int j = 0; j < 4; ++j) { const float gv = fminf(acc[ai][0][m][n][j] + bgt[n][j], 7.0f), uv = fminf(fmaxf(acc[ai][1][m][n][j] + bup[n][j], -7.0f), 7.0f);
                        h[4 * n + j] = (uv + 1.0f) * (gv / (1.0f + __expf(-1.702f * gv))); }
                u32x4 w; w.x = cvt_pk_bf16(h[0], h[1]); w.y = cvt_pk_bf16(h[2], h[3]); w.z = cvt_pk_bf16(h[4], h[5]); w.w = cvt_pk_bf16(h[6], h[7]);
                *(u32x4*)(HM + (size_t)(row0 + ai * HALF + m * 16) * FF + f0) = w; }
    }
};
struct EpiDown {
    static constexpr bool PERM = true;
    bf16_t* YP; const float* b_d; const float* lgate; int NT;
    __device__ __forceinline__ void operator()(const f32x4 (&acc)[2][2][4][2], const Unit& u, int wr, int wc, int fr, int fq) const {
        const int pnl = u.pn - u.e * NT, col0 = pnl * BM + wc * 32 + 8 * fq, rl0 = wr * 64 + fr;
        f32x4 bv[2][2];
#pragma unroll
        for (int bj = 0; bj < 2; ++bj)
#pragma unroll
            for (int n = 0; n < 2; ++n) bv[bj][n] = *(const f32x4*)(b_d + (size_t)u.e * 1024 + col0 + bj * HALF + 4 * n);
#pragma unroll
        for (int ai = 0; ai < 2; ++ai)
#pragma unroll
            for (int m = 0; m < 4; ++m) { const int rl = rl0 + ai * HALF + m * 16, p = u.lt * BM + rl; const float g = p < u.ne ? lgate[(size_t)u.e * TC + p] : 0.f;
                bf16_t* rowp = YP + (size_t)(u.pm * BM + rl) * D + col0;
#pragma unroll
                for (int bj = 0; bj < 2; ++bj) { const f32x4 v0 = (acc[ai][bj][m][0] + bv[bj][0]) * g, v1 = (acc[ai][bj][m][1] + bv[bj][1]) * g;
                    u32x4 w; w.x = cvt_pk_bf16(v0[0], v0[1]); w.y = cvt_pk_bf16(v0[2], v0[3]); w.z = cvt_pk_bf16(v1[0], v1[1]); w.w = cvt_pk_bf16(v1[2], v1[3]);
                    *(u32x4*)(rowp + bj * HALF) = w; } }
    }
};
}

struct GArgs { const bf16_t* A; const bf16_t* Bt; void* out; const float* f0; const float* f1; const int* cnt; const int* ltok; int M, N, K, pad; };
constexpr int PG8_LDS = pg8::STAGE_BYTES + pg8::PLAN_BYTES;
template <int WHICH>
__global__ __launch_bounds__(512, 2) void k_pg8(GArgs a) {
    extern __shared__ __attribute__((aligned(16))) unsigned char lds[];
    PG8_LAS unsigned char* l3 = (PG8_LAS unsigned char*)lds;
    const int G = gridDim.x, c = blockIdx.x;
    if (WHICH == 0) { pg8::DensePlan S; S.init(a.M, a.N, G, c); pg8::EpiBf16 E{(bf16_t*)a.out, a.N}; pg8::gemm_phase<1024>(l3, a.A, a.Bt, S, E); }
    if (WHICH == 1) { pg8::DensePlan S; S.init(a.M, a.N, G, c); pg8::EpiResF32 E{(float*)a.out, a.f0, a.N}; pg8::gemm_phase<1024>(l3, a.A, a.Bt, S, E); }
    if (WHICH == 2) { pg8::MoePlan S = pg8::moe_plan_setup<true>(l3 + pg8::STAGE_BYTES, a.cnt, a.ltok, 8, G, c); pg8::EpiGLU E{(bf16_t*)a.out, a.f0, 8}; pg8::gemm_phase<1024>(l3, a.A, a.Bt, S, E); }
    if (WHICH == 3) { pg8::MoePlan S = pg8::moe_plan_setup<false>(l3 + pg8::STAGE_BYTES, a.cnt, a.ltok, 4, G, c); pg8::EpiDown E{(bf16_t*)a.out, a.f0, a.f1, 4}; pg8::gemm_phase<1024>(l3, a.A, a.Bt, S, E); }
}

__global__ __launch_bounds__(256) void k_final(float* __restrict__ xo, const bf16_t* __restrict__ YP, const int* __restrict__ cnt, const int* __restrict__ slot, const float* __restrict__ w, int t0) {
    const int t = t0 + blockIdx.x * 4 + (threadIdx.x >> 6), lane = threadIdx.x & 63;
    int rows[4];
#pragma unroll
    for (int k = 0; k < 4; ++k) { const int sl = slot[t * 4 + k], e = sl >> 16, pos = sl & 0xffff; int base = 0;
        for (int i = 0; i < 32; ++i) { const int nt = (cnt[i] + TM - 1) / TM; base += (i < e) ? nt : 0; }
        rows[k] = base * TM + pos; }
    f32x4* xr = (f32x4*)(xo + (size_t)t * D) + lane;
    f32x4 v[4]; float s = 0.f;
#pragma unroll
    for (int j = 0; j < 4; ++j) {
        v[j] = xr[64 * j];
#pragma unroll
        for (int k = 0; k < 4; ++k) { const unsigned long long y = *((const unsigned long long*)(YP + (size_t)rows[k] * D) + 64 * j + lane);
            v[j].x += bf2f((unsigned)(y & 0xffff)); v[j].y += bf2f((unsigned)((y >> 16) & 0xffff)); v[j].z += bf2f((unsigned)((y >> 32) & 0xffff)); v[j].w += bf2f((unsigned)(y >> 48)); }
        s += v[j].x * v[j].x + v[j].y * v[j].y + v[j].z * v[j].z + v[j].w * v[j].w;
    }
    const float rstd = 1.0f / sqrtf(wave_sum(s) * (1.f / D) + EPS);
#pragma unroll
    for (int j = 0; j < 4; ++j) { const f32x4 ww = ((const f32x4*)w)[64 * j + lane]; xr[64 * j] = (f32x4){v[j].x * rstd * ww.x, v[j].y * rstd * ww.y, v[j].z * rstd * ww.z, v[j].w * rstd * ww.w}; }
}

extern "C" void kernel_launch(void* const* d_in, const int* in_sizes, int n_in, void* d_out, int out_size, void* d_ws, size_t ws_size, hipStream_t stream) {
    if (n_in != 20 || in_sizes[0] != T * D || out_size != T * D || ws_size < WS_END) { fprintf(stderr, "kernel_launch: unexpected shapes / workspace (%d, %d, %d, %zu)\n", n_in, n_in > 0 ? in_sizes[0] : -1, out_size, ws_size); return; }
    const float* x = (const float*)d_in[0]; const int* positions = (const int*)d_in[1]; const float* attn_norm_w = (const float*)d_in[2]; const float* w_in = (const float*)d_in[3];
    const float* lq1 = (const float*)d_in[4]; const float* lk1 = (const float*)d_in[5]; const float* lq2 = (const float*)d_in[6]; const float* lk2 = (const float*)d_in[7];
    const float* subln_w = (const float*)d_in[8]; const float* pool_w = (const float*)d_in[9]; const float* pool_scale = (const float*)d_in[10]; const float* w_out = (const float*)d_in[11];
    const float* ffn_norm_w = (const float*)d_in[12]; const float* router_w = (const float*)d_in[13]; const float* router_b = (const float*)d_in[14];
    const float* w_gu = (const float*)d_in[15]; const float* b_gu = (const float*)d_in[16]; const float* w_down = (const float*)d_in[17]; const float* b_down = (const float*)d_in[18]; const float* final_w = (const float*)d_in[19];
    char* ws = (char*)d_ws; float* out = (float*)d_out;
    int* cnt = (int*)(ws + WS_CTL); int* ltok = (int*)(ws + WS_LTOK); float* lgate = (float*)(ws + WS_LGATE); int* slot = (int*)(ws + WS_SLOT); float* rope = (float*)(ws + WS_ROPE);
    bf16_t* Win_t = (bf16_t*)(ws + WS_WIN); bf16_t* Wo_t = (bf16_t*)(ws + WS_WO); bf16_t* Wd_t = (bf16_t*)(ws + WS_WD); bf16_t* Wgu_t = (bf16_t*)(ws + WS_WGU);
    bf16_t* XN = (bf16_t*)(ws + WS_XN); bf16_t* PROJ = (bf16_t*)(ws + WS_PROJ); bf16_t* CAT = (bf16_t*)(ws + WS_CAT); bf16_t* HM = (bf16_t*)(ws + WS_HM); bf16_t* YP = (bf16_t*)(ws + WS_YP);

    static bool attr_done = false;
    if (!attr_done) { (void)hipFuncSetAttribute((const void*)k_pg8<0>, hipFuncAttributeMaxDynamicSharedMemorySize, PG8_LDS); (void)hipFuncSetAttribute((const void*)k_pg8<1>, hipFuncAttributeMaxDynamicSharedMemorySize, PG8_LDS);
        (void)hipFuncSetAttribute((const void*)k_pg8<2>, hipFuncAttributeMaxDynamicSharedMemorySize, PG8_LDS); (void)hipFuncSetAttribute((const void*)k_pg8<3>, hipFuncAttributeMaxDynamicSharedMemorySize, PG8_LDS); attr_done = true; }
    (void)hipMemsetAsync(cnt, 0, 4096, stream);
    k_transpose<0><<<dim3(INW / 32, D / 32, 1), 256, 0, stream>>>(w_in, Win_t, D, INW, D);
    k_transpose<0><<<dim3(D / 32, 512 / 32, 1), 256, 0, stream>>>(w_out, Wo_t, 512, D, D);
    k_fold_pool<<<512 * 1024 / 256, 256, 0, stream>>>(pool_w, pool_scale, w_out, Wo_t);
    k_transpose<1><<<dim3(2048 / 32, D / 32, NE), 256, 0, stream>>>(w_gu, Wgu_t, D, 2048, D);
    k_transpose<0><<<dim3(D / 32, FF / 32, NE), 256, 0, stream>>>(w_down, Wd_t, FF, D, FF);
    k_rope_table<<<T * 8 / 256, 256, 0, stream>>>(positions, rope);
    k_rmsnorm<<<T / 4, 256, 0, stream>>>(x, attn_norm_w, XN);
    { GArgs g{}; g.A = XN; g.Bt = Win_t; g.out = PROJ; g.M = T; g.N = INW; g.K = D; k_pg8<0><<<256, 512, PG8_LDS, stream>>>(g); }
    k_rope<<<T * 128 / 256, 256, 0, stream>>>(PROJ, rope);
    k_attn_simple<<<T, 256, 0, stream>>>(PROJ, subln_w, lq1, lk1, lq2, lk2, CAT);
    k_pool<<<T * 512 / 256, 256, 0, stream>>>(PROJ, CAT);
    { GArgs g{}; g.A = CAT; g.Bt = Wo_t; g.out = out; g.f0 = x; g.M = T; g.N = D; g.K = D; k_pg8<1><<<256, 512, PG8_LDS, stream>>>(g); }
    k_router<<<T / 4, 256, 0, stream>>>(out, ffn_norm_w, router_w, router_b, XN, cnt, ltok, lgate, slot);
    for (int ch = 0; ch < NCHUNK; ++ch) {
        const int* cc = cnt + ch * 32; const int* lt = ltok + (size_t)ch * 32 * TC; const float* lg = lgate + (size_t)ch * 32 * TC;
        { GArgs g{}; g.A = XN; g.Bt = Wgu_t; g.out = HM; g.f0 = b_gu; g.cnt = cc; g.ltok = lt; g.K = D; k_pg8<2><<<256, 512, PG8_LDS, stream>>>(g); }
        { GArgs g{}; g.A = HM; g.Bt = Wd_t; g.out = YP; g.f0 = b_down; g.f1 = lg; g.cnt = cc; g.ltok = lt; g.K = FF; k_pg8<3><<<256, 512, PG8_LDS, stream>>>(g); }
        k_final<<<TC / 4, 256, 0, stream>>>(out, YP, cc, slot, final_w, ch * TC);
    }
}
```

```cpp
#include <hip/hip_runtime.h>
#include <cstdint>
#include <cstdio>

typedef unsigned short bf16_t;
typedef short bf16x8 __attribute__((ext_vector_type(8)));
typedef float f32x4 __attribute__((ext_vector_type(4)));
typedef unsigned u32x4 __attribute__((ext_vector_type(4)));

constexpr int T = 65536, D = 1024, SEQ = 2048, INW = 2048, NE = 32, FF = 1024, TOPK = 4;
constexpr int NCHUNK = 1, TC = T / NCHUNK;
constexpr int TM = 256;
constexpr int PC = TC * TOPK + NE * TM;
constexpr float EPS = 1e-5f;

constexpr size_t MiB = 1u << 20;
constexpr size_t WS_CTL = 0;
constexpr size_t WS_RSTD = 524288;
constexpr size_t WS_BAR = 65536;
constexpr size_t WS_LTOK = 1 * MiB;
constexpr size_t WS_LGATE = 9 * MiB;
constexpr size_t WS_SLOT = 17 * MiB;
constexpr size_t WS_ROPE = 18 * MiB;
constexpr size_t WS_WIN = 22 * MiB;
constexpr size_t WS_WO = 26 * MiB;
constexpr size_t WS_WD = 28 * MiB;
constexpr size_t WS_WGU = 92 * MiB;
constexpr size_t WS_XN = 220 * MiB;
constexpr size_t WS_PROJ = 348 * MiB;
constexpr size_t WS_CAT = 604 * MiB;
constexpr size_t WS_HM = 348 * MiB;
constexpr size_t WS_YP = 612 * MiB;
constexpr size_t WS_XB = 876 * MiB;
constexpr size_t WS_END = 1004 * MiB;
static_assert(WS_HM + (size_t)PC * 1024 <= WS_YP && WS_YP + (size_t)PC * 1024 <= WS_XB && WS_XB + (size_t)T * 1024 * 2 <= WS_END && WS_CAT + (size_t)T * 1024 * 2 <= WS_XB, "ws map");

__device__ __forceinline__ int otid() { int t = threadIdx.x; asm volatile("" : "+v"(t)); return t; }
__device__ __forceinline__ unsigned f2bf(float f) { unsigned u = __float_as_uint(f); return (u + 0x7fffu + ((u >> 16) & 1u)) >> 16; }
__device__ __forceinline__ unsigned pk4_fp8(float a, float b, float c, float d) {
    a = fminf(fmaxf(a, -448.f), 448.f); b = fminf(fmaxf(b, -448.f), 448.f); c = fminf(fmaxf(c, -448.f), 448.f); d = fminf(fmaxf(d, -448.f), 448.f);
    unsigned w = 0; w = __builtin_amdgcn_cvt_pk_fp8_f32(a, b, w, false); w = __builtin_amdgcn_cvt_pk_fp8_f32(c, d, w, true); return w; }
constexpr float FP8_SX = 16.f, FP8_SW = 512.f, FP8_SH = 4.f, FP8_SY = 32.f;
__device__ __forceinline__ float bf2f(unsigned h) { return __uint_as_float(h << 16); }
__device__ __forceinline__ float wave_sum(float v) {
#pragma unroll
    for (int o = 1; o < 64; o <<= 1) v += __shfl_xor(v, o);
    return v;
}
__device__ __forceinline__ float wave_max(float v) {
#pragma unroll
    for (int o = 1; o < 64; o <<= 1) v = fmaxf(v, __shfl_xor(v, o));
    return v;
}

namespace pg8 {
#define PG8_LAS __attribute__((address_space(3)))
constexpr int BM = 256, BK = 64, HALF = 128, HTB = HALF * BK * 2  , STAGE_BYTES = 8 * HTB;
constexpr int MAXU = 36, PLAN_BYTES = MAXU * 32 + MAXU * 512, EPI_LDS = STAGE_BYTES + PLAN_BYTES + 64;
__host__ __device__ __forceinline__ int lds_byte(int r, int c) { return r * 128 + ((((c >> 3) ^ ((r >> 1) & 7))) << 4); }
__host__ __device__ __forceinline__ void stage_rc(int b, int& R, int& C) { R = b >> 7; C = ((((b >> 4) & 7) ^ ((R >> 1) & 7))) << 3; }
__host__ __device__ __forceinline__ int perm32(int rho) { const int n = rho >> 4, i = rho & 15; return 8 * (i >> 2) + 4 * n + (i & 3); }
__device__ __forceinline__ unsigned cvt_pk_bf16(float lo, float hi) { unsigned r; asm volatile("v_cvt_pk_bf16_f32 %0, %1, %2" : "=v"(r) : "v"(lo), "v"(hi)); return r; }

template <int IMM = 0>
__device__ __forceinline__ void glds16s(const void* sbase, unsigned voff, unsigned lds_dst) { unsigned keep;
    asm volatile("s_mov_b32 %0, m0\n\ts_mov_b32 m0, %3\n\ts_nop 0\n\tglobal_load_lds_dwordx4 %1, %2 offset:%4\n\ts_mov_b32 m0, %0" : "=&s"(keep) : "v"(voff), "s"(sbase), "s"(lds_dst), "i"(IMM) : "memory"); }
typedef int v4i_t __attribute__((ext_vector_type(4)));
typedef int v8i_t __attribute__((ext_vector_type(8)));
__device__ __forceinline__ v8i_t cat8(bf16x8 lo, bf16x8 hi) { return __builtin_shufflevector(__builtin_bit_cast(v4i_t, lo), __builtin_bit_cast(v4i_t, hi), 0, 1, 2, 3, 4, 5, 6, 7); }
__device__ __forceinline__ void mfma_fp8_inplace(f32x4& acc, v8i_t a, v8i_t b) {
    asm volatile("v_mfma_scale_f32_16x16x128_f8f6f4 %0, %1, %2, %0, %3, %3 op_sel_hi:[0,0,0]" : "+v"(acc) : "v"(a), "v"(b), "v"(0x7F7F7F7F)); }
struct Unit { int pm, pn, e, lt, ne; };

template <int ROWB, bool FP8, class Epi, class Plan>
__device__ __forceinline__ void gemm_phase(PG8_LAS unsigned char* lds, const bf16_t* gA_, const bf16_t* gBt_, const Plan& S, const Epi& E) {
    const int tid = otid(), wid = __builtin_amdgcn_readfirstlane(tid >> 6), lane = tid & 63, wr = wid >> 2, wc = wid & 3, fr = lane & 15, fq = lane >> 4;
    constexpr int nt = ROWB / 128;
    unsigned voffB[2];
#pragma unroll
    for (int i = 0; i < 2; ++i) { int R, C; stage_rc(tid * 16 + i * 8192, R, C); const int Rb = Epi::PERM ? ((R & ~31) + perm32(R & 31)) : R; voffB[i] = (unsigned)(Rb * ROWB + C * 2); }
    const size_t kstep = (size_t)(BK * 2);
    const size_t hstep = (size_t)HALF * ROWB;
    const size_t tstep = 2 * hstep;
    const unsigned ldsb_epi0 = (unsigned)__builtin_amdgcn_readfirstlane((unsigned)(__UINTPTR_TYPE__)lds + (unsigned)EPI_LDS);
    const unsigned ldsb = (unsigned)__builtin_amdgcn_readfirstlane((unsigned)(__UINTPTR_TYPE__)lds + (unsigned)wid * 1024u);
    const int aoff0 = lds_byte(wr * 64 + fr, fq * 8), aoff1 = lds_byte(wr * 64 + fr, 32 + fq * 8), boff0 = lds_byte(wc * 32 + fr, fq * 8), boff1 = lds_byte(wc * 32 + fr, 32 + fq * 8);
#define PG8_SA(b, h) (((b) * 2 + (h)) * HTB)
#define PG8_SB(b, h) ((4 + (b) * 2 + (h)) * HTB)
#define PG8_STAGE(bufoff, gbase, voff) do { _Pragma("unroll") for (int _i = 0; _i < 2; ++_i) glds16s<0>((gbase), (voff)[_i], ldsb + (unsigned)((bufoff) + _i * 8192)); } while (0)
#define PG8_STAGEK(bufoff, gbase, voff) do { _Pragma("unroll") for (int _i = 0; _i < 2; ++_i) glds16s<BK * 2>((gbase), (voff)[_i], ldsb + (unsigned)((bufoff) + _i * 8192)); } while (0)
#define PG8_LDA(dst, b, h) do { _Pragma("unroll") for (int m = 0; m < 4; ++m) { \
        if constexpr (FP8) dst##8[m] = cat8(*(const PG8_LAS bf16x8*)(lds + PG8_SA(b, h) + aoff0 + m * 2048), *(const PG8_LAS bf16x8*)(lds + PG8_SA(b, h) + aoff1 + m * 2048)); \
        else { dst[m][0] = *(const PG8_LAS bf16x8*)(lds + PG8_SA(b, h) + aoff0 + m * 2048); dst[m][1] = *(const PG8_LAS bf16x8*)(lds + PG8_SA(b, h) + aoff1 + m * 2048); } } } while (0)
#define PG8_LDB(dst, b, h) do { _Pragma("unroll") for (int n = 0; n < 2; ++n) { \
        if constexpr (FP8) dst##8[n] = cat8(*(const PG8_LAS bf16x8*)(lds + PG8_SB(b, h) + boff0 + n * 2048), *(const PG8_LAS bf16x8*)(lds + PG8_SB(b, h) + boff1 + n * 2048)); \
        else { dst[n][0] = *(const PG8_LAS bf16x8*)(lds + PG8_SB(b, h) + boff0 + n * 2048); dst[n][1] = *(const PG8_LAS bf16x8*)(lds + PG8_SB(b, h) + boff1 + n * 2048); } } } while (0)
#define PG8_MMA(ai, bj, At, Bt) do { __builtin_amdgcn_s_setprio(1); _Pragma("unroll") for (int m = 0; m < 4; ++m) _Pragma("unroll") for (int n = 0; n < 2; ++n) { \
        if constexpr (FP8) mfma_fp8_inplace(acc[ai][bj][m][n], Bt##8[n], At##8[m]); \
        else { _Pragma("unroll") for (int k = 0; k < 2; ++k) acc[ai][bj][m][n] = __builtin_amdgcn_mfma_f32_16x16x32_bf16(Bt[n][k], At[m][k], acc[ai][bj][m][n], 0, 0, 0); } } \
        __builtin_amdgcn_s_setprio(0); } while (0)
#define PG8_WAIT_V(n) asm volatile("s_waitcnt vmcnt(" #n ")" ::: "memory")
#define PG8_WAIT_L(n) asm volatile("s_waitcnt lgkmcnt(" #n ")" ::: "memory")
#define PG8_BAR __builtin_amdgcn_s_barrier()
#define PG8_SCHED __builtin_amdgcn_sched_barrier(0)
#define PG8_VOFF(dst, U, UI) do { const int _tv = otid(); _Pragma("unroll") for (int _i = 0; _i < 2; ++_i) { int _R, _C; stage_rc(_tv * 16 + _i * 8192, _R, _C); \
        _Pragma("unroll") for (int _h = 0; _h < 2; ++_h) dst[_h][_i] = S.rowA(U, UI, _h * HALF + _R) * (unsigned)ROWB + (unsigned)(_C * 2); } } while (0)
#define PG8_SP1A(A1) do { \
          \
        PG8_LDB(B0, 0, 0); PG8_LDB(B1, 0, 1); PG8_SCHED; PG8_LDA(At, 0, 0); PG8_STAGE(PG8_SA(1, 1), (A1), vc[1]); \
        PG8_WAIT_V(8); PG8_WAIT_L(0); PG8_BAR; PG8_MMA(0, 0, At, B0); PG8_MMA(0, 1, At, B1); PG8_BAR; PG8_SCHED; } while (0)
#define PG8_REST(A2, B2) do { \
          \
        PG8_LDA(At, 0, 1); PG8_STAGE(PG8_SB(0, 0), (B2), voffB); PG8_STAGE(PG8_SB(0, 1), (B2) + hstep, voffB); PG8_STAGE(PG8_SA(0, 0), (A2), vc[0]); \
        PG8_WAIT_V(8); PG8_WAIT_L(0); PG8_BAR; PG8_MMA(1, 0, At, B0); PG8_MMA(1, 1, At, B1); PG8_BAR; PG8_SCHED; \
          \
        PG8_LDB(B0, 1, 0); PG8_LDB(B1, 1, 1); PG8_SCHED; PG8_LDA(At, 1, 0); PG8_STAGE(PG8_SA(0, 1), (A2), vc[1]); \
        PG8_WAIT_V(8); PG8_WAIT_L(0); PG8_BAR; PG8_MMA(0, 0, At, B0); PG8_MMA(0, 1, At, B1); PG8_BAR; PG8_SCHED; \
          \
        PG8_LDA(At, 1, 1); PG8_STAGE(PG8_SB(1, 0), (B2) + kstep, voffB); PG8_STAGE(PG8_SB(1, 1), (B2) + kstep + hstep, voffB); PG8_STAGE(PG8_SA(1, 0), (A2) + kstep, vc[0]); \
        PG8_WAIT_V(8); PG8_WAIT_L(0); PG8_BAR; PG8_MMA(1, 0, At, B0); PG8_MMA(1, 1, At, B1); PG8_BAR; PG8_SCHED; } while (0)
    Unit cur, nxt; int ui = 0;
    if (!S.next(0, cur)) return;
    f32x4 acc[2][2][4][2];
#pragma unroll
    for (int a = 0; a < 2; ++a)
#pragma unroll
        for (int b = 0; b < 2; ++b)
#pragma unroll
            for (int m = 0; m < 4; ++m)
#pragma unroll
                for (int n = 0; n < 2; ++n) acc[a][b][m][n] = (f32x4){0.f, 0.f, 0.f, 0.f};
    bf16x8 At[4][2], B0[2][2], B1[2][2]; v8i_t At8[4], B08[2], B18[2];
    unsigned vc[2][2];
    PG8_VOFF(vc, cur, 0);
    if (wid == 0) E.prefetch(cur, ldsb_epi0, lane);
    const char* gA = (const char*)gA_; const char* cB = (const char*)gBt_ + (size_t)cur.pn * tstep;
    PG8_STAGE(PG8_SB(0, 0), cB, voffB); PG8_STAGE(PG8_SB(0, 1), cB + hstep, voffB); PG8_STAGE(PG8_SA(0, 0), gA, vc[0]); PG8_STAGE(PG8_SA(0, 1), gA, vc[1]);
    if (wr == 1) PG8_BAR;
    PG8_WAIT_V(2); PG8_BAR;
    PG8_STAGE(PG8_SB(1, 0), cB + kstep, voffB); PG8_STAGE(PG8_SA(1, 0), gA + kstep, vc[0]); PG8_STAGE(PG8_SB(1, 1), cB + hstep + kstep, voffB);
    PG8_WAIT_V(6); PG8_BAR;
    for (;;) {
        const bool has_next = S.next(ui + 1, nxt);
        const char* nB = has_next ? (const char*)gBt_ + (size_t)nxt.pn * tstep : cB;
#pragma clang loop unroll(disable)
        for (int t = 0; t < nt - 2; t += 2) { PG8_SP1A(gA + (size_t)(t + 1) * kstep); PG8_REST(gA + (size_t)(t + 2) * kstep, cB + (size_t)(t + 2) * kstep); }
        PG8_SP1A(gA + (size_t)(nt - 1) * kstep);
        if (has_next) PG8_VOFF(vc, nxt, ui + 1);
        PG8_REST(gA, nB);
        if constexpr (FP8) {
            asm volatile("s_nop 15\n\ts_nop 15" ::: "memory");
#pragma unroll
            for (int a = 0; a < 2; ++a)
#pragma unroll
                for (int b = 0; b < 2; ++b)
#pragma unroll
                    for (int m = 0; m < 4; ++m)
#pragma unroll
                        for (int n = 0; n < 2; ++n) asm volatile("" : "+v"(acc[a][b][m][n]));
        }
        if (wr == 0) PG8_BAR;
        E(acc, cur, lds + EPI_LDS + (ui & 1) * 1024);
        if (!has_next) break;
#pragma unroll
        for (int a = 0; a < 2; ++a)
#pragma unroll
            for (int b = 0; b < 2; ++b)
#pragma unroll
                for (int m = 0; m < 4; ++m)
#pragma unroll
                    for (int n = 0; n < 2; ++n) acc[a][b][m][n] = (f32x4){0.f, 0.f, 0.f, 0.f};
        cur = nxt; cB = nB; ++ui;
        if (wid == 0) E.prefetch(cur, ldsb_epi0 + (unsigned)((ui & 1) * 1024), lane);
        if (wr == 1) PG8_BAR;
    }
    PG8_WAIT_V(0);
    PG8_BAR;
#undef PG8_SA
#undef PG8_SB
#undef PG8_STAGE
#undef PG8_STAGEK
#undef PG8_LDA
#undef PG8_LDB
#undef PG8_MMA
#undef PG8_WAIT_V
#undef PG8_WAIT_L
#undef PG8_BAR
#undef PG8_SCHED
#undef PG8_VOFF
#undef PG8_SP1A
#undef PG8_REST
}

struct DensePlan {
    int nM, nN, nwg, G, c;
    __device__ void init(int M, int N, int G_, int c_) { nM = M / BM; nN = N / BM; nwg = nM * nN; G = G_; c = c_; }
    __device__ __forceinline__ bool next(int i, Unit& u) const {
        const long L = (long)i * G + c; if (L >= nwg) return false;
        int wgid = (int)L; { const int q = nwg / 8, r = nwg % 8, xcd = wgid % 8, off = wgid / 8; wgid = (xcd < r ? xcd * (q + 1) : r * (q + 1) + (xcd - r) * q) + off; }
        const int nig = 8 * nN, gid = wgid / nig, fm = gid * 8, gsz = (nM - fm) < 8 ? (nM - fm) : 8;
        u.pm = fm + ((wgid % nig) % gsz); u.pn = (wgid % nig) / gsz; u.e = 0; u.lt = 0; u.ne = 0; return true;
    }
    __device__ __forceinline__ unsigned rowA(const Unit& u, int, int r) const { return (unsigned)(u.pm * BM + r); }
};
template <bool GATHER>
struct MoePlan {
    const PG8_LAS int* desc; const PG8_LAS unsigned short* rowtab;
    __device__ __forceinline__ bool next(int i, Unit& u) const {
        if (i >= MAXU) return false;
        const PG8_LAS int* d = desc + i * 8;
        const int v = __builtin_amdgcn_readfirstlane(d[0]); u.pm = __builtin_amdgcn_readfirstlane(d[1]); u.pn = __builtin_amdgcn_readfirstlane(d[2]);
        u.e = __builtin_amdgcn_readfirstlane(d[3]); u.lt = __builtin_amdgcn_readfirstlane(d[4]); u.ne = __builtin_amdgcn_readfirstlane(d[5]); return v != 0;
    }
    __device__ __forceinline__ unsigned rowA(const Unit& u, int ui, int r) const { return GATHER ? (unsigned)rowtab[ui * 256 + r] : (unsigned)(u.pm * BM + r); }
};
template <bool GATHER>
__device__ __forceinline__ MoePlan<GATHER> moe_plan_setup(PG8_LAS unsigned char* tab, const int* cnt, const int* ltok, int NT, int G, int c) {
    PG8_LAS int* desc = (PG8_LAS int*)tab; PG8_LAS unsigned short* rowtab = (PG8_LAS unsigned short*)(tab + MAXU * 32);
    PG8_LAS int* cs = (PG8_LAS int*)rowtab;
    PG8_LAS int* bs = cs + 32;
    const int tid = otid(), xcd = c & 7, j = c >> 3;
    if (tid < 32) cs[tid] = __hip_atomic_load(cnt + tid, __ATOMIC_RELAXED, __HIP_MEMORY_SCOPE_AGENT);
    __syncthreads();
    if (tid < 64) { const int ln = tid & 63; int v = (ln < 32) ? (cs[ln & 31] + BM - 1) / BM : 0, incl = v;
#pragma unroll
        for (int o = 1; o < 32; o <<= 1) { const int up = __shfl_up(incl, o); if (ln >= o) incl += up; }
        if (ln < 32) bs[ln] = incl - v; if (ln == 31) bs[32] = incl; }
    __syncthreads();
    if (tid < MAXU) {
        const int q = tid * (G >> 3) + j, mt = (q / NT) * 8 + xcd, pnl = q % NT;
        int e = -1;
        for (int k = 0; k < 32; ++k) if (mt >= bs[k] && mt < bs[k + 1]) e = k;
        desc[tid * 8 + 0] = e >= 0 ? 1 : 0; desc[tid * 8 + 1] = mt; desc[tid * 8 + 2] = (e >= 0 ? e : 0) * NT + pnl; desc[tid * 8 + 3] = e;
        desc[tid * 8 + 4] = e >= 0 ? mt - bs[e] : 0; desc[tid * 8 + 5] = e >= 0 ? cs[e] : 0;
    }
    __syncthreads();
    if (GATHER && tid < 256) {
        for (int i = 0; i < MAXU; ++i) {
            const PG8_LAS int* d = desc + i * 8; const int valid = d[0], e = d[3], lt = d[4], ne = d[5];
            const int p = lt * BM + tid; rowtab[i * 256 + tid] = (unsigned short)((valid && p < ne) ? ltok[(size_t)e * TC + p] : 0);
        }
    }
    __syncthreads();
    MoePlan<GATHER> S; S.desc = desc; S.rowtab = rowtab; return S;
}

struct EpiBf16 {
    __device__ __forceinline__ void prefetch(const Unit& u, unsigned lds_dst, int lane) const { glds16s<0>(rstd + (size_t)u.pm * BM, (unsigned)(lane * 16), lds_dst); }
    static constexpr bool PERM = true;
    bf16_t* O; int ldc; const float* rope; int rope_tiles; const float* rstd;
    __device__ __forceinline__ void operator()(const f32x4 (&acc)[2][2][4][2], const Unit& u, const PG8_LAS unsigned char* el) const {
        const int tv_ = otid();
        const int wr = tv_ >> 8, wc = (tv_ >> 6) & 3, fr = tv_ & 15, fq = (tv_ >> 4) & 3;
        const int row0 = u.pm * BM + wr * 64 + fr, col0 = u.pn * BM + wc * 32 + 8 * fq;
        const bool rot = (u.pn < rope_tiles) && ((__builtin_amdgcn_readfirstlane(tv_ >> 6) & 1) == 0);
#pragma unroll
        for (int ai = 0; ai < 2; ++ai)
#pragma unroll
            for (int m = 0; m < 4; ++m) { const int row = row0 + ai * HALF + m * 16; bf16_t* rowp = O + (size_t)row * ldc + col0;
                const float rsd = ((const PG8_LAS float*)el)[wr * 64 + fr + ai * HALF + m * 16];
                f32x4 cs0, cs1, sn0, sn1;
                if (rot) { const float* rp = rope + (size_t)row * 16; cs0 = *(const f32x4*)rp; cs1 = *(const f32x4*)(rp + 4); sn0 = *(const f32x4*)(rp + 8); sn1 = *(const f32x4*)(rp + 12);
                    if (fq == 0) { sn0 = -sn0; sn1 = -sn1; } }
#pragma unroll
                for (int bj = 0; bj < 2; ++bj) { f32x4 v0 = acc[ai][bj][m][0] * rsd, v1 = acc[ai][bj][m][1] * rsd;
                    if (rot) { f32x4 p0, p1;
#pragma unroll
                        for (int j = 0; j < 4; ++j) { p0[j] = __shfl_xor(v0[j], 16); p1[j] = __shfl_xor(v1[j], 16); }
                        if (fq < 2) { v0 = v0 * cs0 + p0 * sn0; v1 = v1 * cs1 + p1 * sn1; } }
                    u32x4 w; w.x = cvt_pk_bf16(v0[0], v0[1]); w.y = cvt_pk_bf16(v0[2], v0[3]); w.z = cvt_pk_bf16(v1[0], v1[1]); w.w = cvt_pk_bf16(v1[2], v1[3]);
                    *(u32x4*)(rowp + bj * HALF) = w; } }
    }
};
struct EpiResBf16 {
    __device__ __forceinline__ void prefetch(const Unit&, unsigned, int) const {}
    static constexpr bool PERM = true;
    bf16_t* XB; const bf16_t* resid; int ldc;
    __device__ __forceinline__ void operator()(const f32x4 (&acc)[2][2][4][2], const Unit& u, const PG8_LAS unsigned char* el) const {
        const int tv_ = otid();
        const int wr = tv_ >> 8, wc = (tv_ >> 6) & 3, fr = tv_ & 15, fq = (tv_ >> 4) & 3;
        const int row0 = u.pm * BM + wr * 64 + fr, col0 = u.pn * BM + wc * 32 + 8 * fq;
#pragma unroll
        for (int ai = 0; ai < 2; ++ai)
#pragma unroll
            for (int m = 0; m < 4; ++m) { const size_t off = (size_t)(row0 + ai * HALF + m * 16) * ldc + col0;
#pragma unroll
                for (int bj = 0; bj < 2; ++bj) { const u32x4 xr = *(const u32x4*)(resid + off + bj * HALF);
                    const f32x4 v0 = (f32x4){__uint_as_float(xr.x << 16), __uint_as_float(xr.x & 0xffff0000u), __uint_as_float(xr.y << 16), __uint_as_float(xr.y & 0xffff0000u)} + acc[ai][bj][m][0],
                                v1 = (f32x4){__uint_as_float(xr.z << 16), __uint_as_float(xr.z & 0xffff0000u), __uint_as_float(xr.w << 16), __uint_as_float(xr.w & 0xffff0000u)} + acc[ai][bj][m][1];
                    u32x4 w; w.x = cvt_pk_bf16(v0[0], v0[1]); w.y = cvt_pk_bf16(v0[2], v0[3]); w.z = cvt_pk_bf16(v1[0], v1[1]); w.w = cvt_pk_bf16(v1[2], v1[3]);
                    *(u32x4*)(XB + off + bj * HALF) = w; } }
    }
};
struct EpiGLU {
    static constexpr bool PERM = true;
    bf16_t* HM; const float* b_gu; int NT;
    __device__ __forceinline__ void prefetch(const Unit& u, unsigned lds_dst, int lane) const {
        const int pnl = u.pn - u.e * NT; glds16s<0>(b_gu + (size_t)u.e * 2048 + pnl * HALF, (unsigned)((lane & 31) * 16 + (lane >> 5) * 4096), lds_dst); }
    __device__ __forceinline__ void operator()(const f32x4 (&acc)[2][2][4][2], const Unit& u, const PG8_LAS unsigned char* el) const {
        const int tv_ = otid();
        const int wr = tv_ >> 8, wc = (tv_ >> 6) & 3, fr = tv_ & 15, fq = (tv_ >> 4) & 3;
        const int pnl = u.pn - u.e * NT, f0 = pnl * HALF + wc * 32 + 8 * fq, row0 = u.pm * BM + wr * 64 + fr;
        const PG8_LAS float* bl = (const PG8_LAS float*)el + wc * 32 + 8 * fq;
        f32x4 bgt[2], bup[2];
#pragma unroll
        for (int n = 0; n < 2; ++n) { bgt[n] = *(const PG8_LAS f32x4*)(bl + 4 * n); bup[n] = *(const PG8_LAS f32x4*)(bl + 128 + 4 * n); }
        constexpr float rs = 1.0f / (FP8_SX * FP8_SW);
#pragma unroll
        for (int ai = 0; ai < 2; ++ai)
#pragma unroll
            for (int m = 0; m < 4; ++m) { float h[8];
#pragma unroll
                for (int n = 0; n < 2; ++n)
#pragma unroll
                    for (int j = 0; j < 4; ++j) { const float gv = fminf(acc[ai][0][m][n][j] * rs + bgt[n][j], 7.0f), uv = fminf(fmaxf(acc[ai][1][m][n][j] * rs + bup[n][j], -7.0f), 7.0f);
                        h[4 * n + j] = (uv + 1.0f) * gv * __builtin_amdgcn_rcpf(1.0f + __expf(-1.702f * gv)); }
                const unsigned long long w = (unsigned long long)pk4_fp8(h[0] * FP8_SH, h[1] * FP8_SH, h[2] * FP8_SH, h[3] * FP8_SH) | ((unsigned long long)pk4_fp8(h[4] * FP8_SH, h[5] * FP8_SH, h[6] * FP8_SH, h[7] * FP8_SH) << 32);
                *(unsigned long long*)((unsigned char*)HM + (size_t)(row0 + ai * HALF + m * 16) * FF + f0) = w; }
    }
};
struct EpiDown {
    static constexpr bool PERM = true;
    bf16_t* YP; const float* b_d; int NT;
    __device__ __forceinline__ void prefetch(const Unit& u, unsigned lds_dst, int lane) const {
        const int pnl = u.pn - u.e * NT; glds16s<0>(b_d + (size_t)u.e * 1024 + pnl * BM, (unsigned)(lane * 16), lds_dst); }
    __device__ __forceinline__ void operator()(const f32x4 (&acc)[2][2][4][2], const Unit& u, const PG8_LAS unsigned char* el) const {
        const int tv_ = otid();
        const int wr = tv_ >> 8, wc = (tv_ >> 6) & 3, fr = tv_ & 15, fq = (tv_ >> 4) & 3;
        const int pnl = u.pn - u.e * NT, col0 = pnl * BM + wc * 32 + 8 * fq, rl0 = wr * 64 + fr;
        const PG8_LAS float* bl = (const PG8_LAS float*)el + wc * 32 + 8 * fq;
        f32x4 bv[2][2];
#pragma unroll
        for (int bj = 0; bj < 2; ++bj)
#pragma unroll
            for (int n = 0; n < 2; ++n) bv[bj][n] = *(const PG8_LAS f32x4*)(bl + bj * HALF + 4 * n);
        constexpr float sa = FP8_SY / (FP8_SH * FP8_SW);
#pragma unroll
        for (int ai = 0; ai < 2; ++ai)
#pragma unroll
            for (int m = 0; m < 4; ++m) { const int rl = rl0 + ai * HALF + m * 16;
                unsigned char* rowp = (unsigned char*)YP + (size_t)(u.pm * BM + rl) * D + col0;
#pragma unroll
                for (int bj = 0; bj < 2; ++bj) { const f32x4 v0 = acc[ai][bj][m][0] * sa + bv[bj][0] * FP8_SY, v1 = acc[ai][bj][m][1] * sa + bv[bj][1] * FP8_SY;
                    *(unsigned long long*)(rowp + bj * HALF) = (unsigned long long)pk4_fp8(v0[0], v0[1], v0[2], v0[3]) | ((unsigned long long)pk4_fp8(v1[0], v1[1], v1[2], v1[3]) << 32); } }
    }
};
}


namespace dattn {
typedef float f32x16 __attribute__((ext_vector_type(16)));
typedef short s16x4 __attribute__((ext_vector_type(4)));
constexpr int NW = 8, QBLK = 32, KVBLK = 64, QB = NW * QBLK, DK = 64, DV = 128, RS = INW;
constexpr int SHM_V = KVBLK * DV * 2, SHM_K = KVBLK * DK * 2;
constexpr int NVB = 4;
constexpr int LDS_V = 0, LDS_K = NVB * SHM_V, LDS_WS = LDS_K + 2 * SHM_K, LDS_OST = LDS_WS + NW * 64 * 4, LDS_BYTES = LDS_OST + NW * 8192;
constexpr float SCALE = 0.125f, THR = 8.f;
#define KSWZ64(row, colB) ((row) * 128 + ((colB) ^ ((((row) >> 1) & 7) << 4)))
#define SBAR() __builtin_amdgcn_sched_barrier(0)
__device__ __forceinline__ int v_slot_key(int p) { const int kk = ((p >> 7) << 3) | ((p & 31) >> 2); return (kk & ~0xC) | ((kk & 4) << 1) | ((kk & 8) >> 1); }
__device__ __forceinline__ int v_slot_col(int p) { return ((p >> 5) & 3) * 32 + (p & 3) * 8; }
__device__ __forceinline__ int v_rd_base(int lane) { return ((lane & 3) << 3) | (((lane >> 2) & 3) << 6) | (((lane >> 4) & 1) << 5) | (((lane >> 5) & 1) << 8); }
constexpr int v_rd_off(int d0, int ks, int half) { return d0 * 512 + ks * 4096 + half * 2048; }
__device__ __forceinline__ int crow(int r, int hi) { return (r & 3) + 8 * (r >> 2) + 4 * hi; }
__device__ __forceinline__ unsigned cvtpk(float lo, float hi) { unsigned r; asm volatile("v_cvt_pk_bf16_f32 %0, %1, %2" : "=v"(r) : "v"(lo), "v"(hi)); return r; }
__device__ __forceinline__ bf16x8 load8(const bf16_t* p) { return *reinterpret_cast<const bf16x8*>(p); }
__device__ __forceinline__ void mask_tile(f32x16& p0, f32x16& p1, int dq) {
    const float NEG = -__builtin_inff();
#pragma unroll
    for (int r = 0; r < 16; ++r) { const int c = (r & 3) + 8 * (r >> 2); if (dq - c < 0) p0[r] = NEG; if (dq - c - 32 < 0) p1[r] = NEG; }
}
__device__ __forceinline__ void partialSM(f32x16& p0, f32x16& p1, float& m_reg, float& mn, float& alpha) {
    float pmax = p0[0];
#pragma unroll
    for (int r = 1; r < 16; ++r) pmax = fmaxf(pmax, p0[r]);
#pragma unroll
    for (int r = 0; r < 16; ++r) pmax = fmaxf(pmax, p1[r]);
    { auto rr = __builtin_amdgcn_permlane32_swap(__float_as_uint(pmax), __float_as_uint(pmax), false, false); pmax = fmaxf(__uint_as_float(rr[0]), __uint_as_float(rr[1])); }
    constexpr float C2 = 1.4426950408889634f * SCALE;
    if (__builtin_expect(__all((pmax - m_reg) * SCALE <= THR), 1)) { mn = m_reg; alpha = 1.f; }
    else { mn = fmaxf(m_reg, pmax); alpha = __builtin_amdgcn_exp2f((m_reg - mn) * C2); m_reg = mn; }
    const float mnL = -mn * C2;
#pragma unroll
    for (int r = 0; r < 16; ++r) p0[r] = fmaf(p0[r], C2, mnL);
#pragma unroll
    for (int r = 0; r < 16; ++r) p1[r] = fmaf(p1[r], C2, mnL);
#pragma unroll
    for (int r = 0; r < 16; ++r) p0[r] = __builtin_amdgcn_exp2f(p0[r]);
}
__device__ __forceinline__ void finishSM(f32x16& p0, f32x16& p1, float alpha, float& l_reg, bf16x8& pa0, bf16x8& pa1, bf16x8& pa2, bf16x8& pa3) {
#pragma unroll
    for (int r = 0; r < 16; ++r) p1[r] = __builtin_amdgcn_exp2f(p1[r]);
    float ps = 0;
#pragma unroll
    for (int r = 0; r < 16; ++r) ps += p0[r];
#pragma unroll
    for (int r = 0; r < 16; ++r) ps += p1[r];
    { auto rr = __builtin_amdgcn_permlane32_swap(__float_as_uint(ps), __float_as_uint(ps), false, false); ps = __uint_as_float(rr[0]) + __uint_as_float(rr[1]); }
    l_reg = l_reg * alpha + ps;
#define PK4(P, B_, OUT) do { unsigned a0 = cvtpk(P[B_+0], P[B_+1]), a1 = cvtpk(P[B_+2], P[B_+3]);                          \
        unsigned b0 = cvtpk(P[B_+4], P[B_+5]), b1 = cvtpk(P[B_+6], P[B_+7]);                                             \
        auto r0 = __builtin_amdgcn_permlane32_swap(a0, b0, false, false); auto r1 = __builtin_amdgcn_permlane32_swap(a1, b1, false, false); \
        u32x4 w = {r0[0], r1[0], r0[1], r1[1]}; OUT = *reinterpret_cast<bf16x8*>(&w); } while (0)
    PK4(p0, 0, pa0); PK4(p0, 8, pa1); PK4(p1, 0, pa2); PK4(p1, 8, pa3);
#undef PK4
}
template <int KB>
__device__ __forceinline__ void qkt(f32x16& p0, f32x16& p1, const char* K_lds, int r32, int hi, const bf16x8* qr) {
    p0 = f32x16{}; p1 = f32x16{};
#pragma unroll
    for (int d0 = 0; d0 < 4; ++d0) { const char* a = K_lds + KB * SHM_K + KSWZ64(r32, (d0 * 16 + hi * 8) * 2);
        bf16x8 b0 = *reinterpret_cast<const bf16x8*>(a);
        bf16x8 b1 = *reinterpret_cast<const bf16x8*>(a + 32 * 128);
        p0 = __builtin_amdgcn_mfma_f32_32x32x16_bf16(b0, qr[d0], p0, 0, 0, 0);
        p1 = __builtin_amdgcn_mfma_f32_32x32x16_bf16(b1, qr[d0], p1, 0, 0, 0); }
}
template <int VB>
__device__ __forceinline__ void pv_tile(f32x16* o, int vb0, bf16x8 pa0, bf16x8 pa1, bf16x8 pa2, bf16x8 pa3) {
#define TRRD(dst, off) asm volatile("ds_read_b64_tr_b16 %0, %1 offset:%2" : "=&v"(dst) : "v"(vb0), "i"(off) : "memory")
#define PV_RD(S, d0) do { constexpr int b_ = LDS_V + VB * SHM_V + v_rd_off(d0, 0, 0); \
        TRRD(S##l0, b_); TRRD(S##h0, b_ + 2048); TRRD(S##l1, b_ + 4096); TRRD(S##h1, b_ + 6144); TRRD(S##l2, b_ + 8192); TRRD(S##h2, b_ + 10240); TRRD(S##l3, b_ + 12288); TRRD(S##h3, b_ + 14336); } while (0)
#define PV_MM(S, d0) do { \
        o[d0] = __builtin_amdgcn_mfma_f32_32x32x16_bf16(pa0, (bf16x8){S##l0[0], S##l0[1], S##l0[2], S##l0[3], S##h0[0], S##h0[1], S##h0[2], S##h0[3]}, o[d0], 0, 0, 0);   \
        o[d0] = __builtin_amdgcn_mfma_f32_32x32x16_bf16(pa1, (bf16x8){S##l1[0], S##l1[1], S##l1[2], S##l1[3], S##h1[0], S##h1[1], S##h1[2], S##h1[3]}, o[d0], 0, 0, 0);   \
        o[d0] = __builtin_amdgcn_mfma_f32_32x32x16_bf16(pa2, (bf16x8){S##l2[0], S##l2[1], S##l2[2], S##l2[3], S##h2[0], S##h2[1], S##h2[2], S##h2[3]}, o[d0], 0, 0, 0);   \
        o[d0] = __builtin_amdgcn_mfma_f32_32x32x16_bf16(pa3, (bf16x8){S##l3[0], S##l3[1], S##l3[2], S##l3[3], S##h3[0], S##h3[1], S##h3[2], S##h3[3]}, o[d0], 0, 0, 0); } while (0)
#define LGK(n) do { asm volatile("s_waitcnt lgkmcnt(" #n ")" ::: "memory"); SBAR(); } while (0)
    s16x4 Al0, Al1, Al2, Al3, Ah0, Ah1, Ah2, Ah3, Bl0, Bl1, Bl2, Bl3, Bh0, Bh1, Bh2, Bh3;
    PV_RD(A, 0); PV_RD(B, 1); LGK(8); PV_MM(A, 0); SBAR();
    PV_RD(A, 2); LGK(8); PV_MM(B, 1); SBAR();
    PV_RD(B, 3); LGK(8); PV_MM(A, 2); SBAR();
    LGK(0); PV_MM(B, 3);
#undef PV_RD
#undef PV_MM
#undef LGK
#undef TRRD
}
struct BlockRef { const bf16_t* Q; const bf16_t* K; const bf16_t* V; bf16_t* OUT; int P0, c; };
struct Seam { bf16x8 qr[4]; };
#define DA_VMW() asm volatile("s_waitcnt vmcnt(0)" ::: "memory")
#define DA_KDMA(Kp, k0, bf) pg8::glds16s<0>((Kp) + (size_t)(k0) * RS, kvo, kdst + (unsigned)((bf) * SHM_K))
#define DA_VDMA(Vp, k0, bf) do { pg8::glds16s<0>((Vp) + (size_t)(k0) * RS, vvo0, vdst + (unsigned)((bf) * SHM_V)); pg8::glds16s<0>((Vp) + (size_t)(k0) * RS, vvo1, vdst + (unsigned)((bf) * SHM_V + 8192)); } while (0)
#define DA_ADDR() \
    const int kr = tid >> 3; \
    const unsigned kvo = (unsigned)(kr * RS + (((tid & 7) ^ ((kr >> 1) & 7)) * 8)) * 2u, kdst = (unsigned)__builtin_amdgcn_readfirstlane((unsigned)(uintptr_t)lds + LDS_K + wid * 1024); \
    const unsigned vvo0 = (unsigned)(v_slot_key(tid) * RS + v_slot_col(tid)) * 2u, vvo1 = (unsigned)(v_slot_key(tid + 512) * RS + v_slot_col(tid + 512)) * 2u, \
                   vdst = (unsigned)__builtin_amdgcn_readfirstlane((unsigned)(uintptr_t)lds + LDS_V + wid * 1024)
__device__ __forceinline__ void prime(const BlockRef& cur, char* lds, Seam& S) {
    const int tid = otid(), wid = __builtin_amdgcn_readfirstlane(tid >> 6), lane = tid & 63, r32 = lane & 31, hi = lane >> 5;
    DA_ADDR();
#pragma unroll
    for (int d0 = 0; d0 < 4; ++d0) S.qr[d0] = load8(cur.Q + (size_t)(wid * QBLK + r32) * RS + d0 * 16 + hi * 8);
    DA_KDMA(cur.K, 0, 0); DA_VDMA(cur.V, 0, 0); DA_VMW();
    __syncthreads();
}
__device__ __forceinline__ void block(const BlockRef& cur, const BlockRef& nxt, char* lds, Seam& S, float lam, const float* __restrict__ subln_w) {
    const int tid = otid(), wid = __builtin_amdgcn_readfirstlane(tid >> 6), lane = tid & 63, r32 = lane & 31, hi = lane >> 5;
    const int NT = (cur.P0 + QB) / KVBLK;
    const int qlo = cur.P0 + wid * QBLK, qm = qlo + r32 - 4 * hi;
    char* K_lds = lds + LDS_K;
    float* ws = (float*)(lds + LDS_WS) + wid * 64; float* li_l = ws; float* al_l = ws + 32;
    float m_reg = -1e30f, l_reg = 0; f32x16 o[4] = {};
    DA_ADDR();
    const int vb0 = (int)(uintptr_t)lds + v_rd_base(lane);
    const bf16_t* Kh = cur.K; const bf16_t* Vh = cur.V;
#define RESC(a) do { if (__any((a) < 1.f)) { if (hi == 0) al_l[r32] = (a); asm volatile("s_waitcnt lgkmcnt(0)" ::: "memory");              \
                     _Pragma("unroll") for (int d_ = 0; d_ < 4; ++d_) _Pragma("unroll") for (int r = 0; r < 16; ++r) o[d_][r] *= al_l[crow(r, hi)]; } } while (0)
#define KBASE(t) ((t) * KVBLK)
#define MASKT(P0_, P1_, t) do { const int kb_ = KBASE(t); if (kb_ + KVBLK - 1 > qlo) mask_tile(P0_, P1_, qm - kb_); } while (0)
    f32x16 pA0, pA1, pB0, pB1; float mnA, mnB, alA, alB; bf16x8 pa0, pa1, pa2, pa3;
    DA_KDMA(Kh, KBASE(1), 1); DA_VDMA(Vh, KBASE(1), 1);
    SBAR(); qkt<0>(pA0, pA1, K_lds, r32, hi, S.qr);
    MASKT(pA0, pA1, 0); partialSM(pA0, pA1, m_reg, mnA, alA);
    DA_VMW(); __syncthreads();
#define HALF_STEP(PX0, PX1, mnX, alX, PY0, PY1, alY, t, KB, VBP, KBN, VBN) do {                                               \
        SBAR(); qkt<KB>(PX0, PX1, K_lds, r32, hi, S.qr);                                                                      \
        finishSM(PY0, PY1, alY, l_reg, pa0, pa1, pa2, pa3); SBAR();                                                           \
        DA_KDMA(Kh, KBASE((t) + 1), KBN); DA_VDMA(Vh, KBASE((t) + 1), VBN); SBAR();                                          \
        pv_tile<VBP>(o, vb0, pa0, pa1, pa2, pa3); MASKT(PX0, PX1, (t)); partialSM(PX0, PX1, m_reg, mnX, alX);                  \
        RESC(alX); DA_VMW(); __syncthreads(); } while (0)
    HALF_STEP(pB0, pB1, mnB, alB, pA0, pA1, alA, 1, 1, 0, 0, 2);
    HALF_STEP(pA0, pA1, mnA, alA, pB0, pB1, alB, 2, 0, 1, 1, 3);
    for (int t = 3; t + 1 < NT; t += 4) {
        HALF_STEP(pB0, pB1, mnB, alB, pA0, pA1, alA, t, 1, 2, 0, 0);
        HALF_STEP(pA0, pA1, mnA, alA, pB0, pB1, alB, t + 1, 0, 3, 1, 1);
        HALF_STEP(pB0, pB1, mnB, alB, pA0, pA1, alA, t + 2, 1, 0, 0, 2);
        HALF_STEP(pA0, pA1, mnA, alA, pB0, pB1, alB, t + 3, 0, 1, 1, 3);
    }
    SBAR(); qkt<1>(pB0, pB1, K_lds, r32, hi, S.qr); SBAR();
    DA_KDMA(nxt.K, 0, 0); DA_VDMA(nxt.V, 0, 0); SBAR();
#pragma unroll
    for (int d0 = 0; d0 < 4; ++d0) S.qr[d0] = load8(nxt.Q + (size_t)(wid * QBLK + r32) * RS + d0 * 16 + hi * 8);
    SBAR();
    finishSM(pA0, pA1, alA, l_reg, pa0, pa1, pa2, pa3); SBAR();
    pv_tile<2>(o, vb0, pa0, pa1, pa2, pa3);
    MASKT(pB0, pB1, NT - 1); partialSM(pB0, pB1, m_reg, mnB, alB); RESC(alB);
    finishSM(pB0, pB1, alB, l_reg, pa0, pa1, pa2, pa3); SBAR(); pv_tile<3>(o, vb0, pa0, pa1, pa2, pa3);
    SBAR();
    if (hi == 0) li_l[r32] = l_reg;
    asm volatile("s_waitcnt lgkmcnt(0)" ::: "memory");
    float rli[16];
#pragma unroll
    for (int r = 0; r < 16; ++r) rli[r] = __builtin_amdgcn_rcpf(li_l[crow(r, hi)]);
    unsigned* ostw = (unsigned*)(lds + LDS_OST + wid * 8192);
    if (cur.c == 1) {
#pragma unroll
        for (int d0 = 0; d0 < 4; ++d0)
#pragma unroll
            for (int r = 0; r < 16; r += 2) ostw[(d0 * 8 + (r >> 1)) * 64 + lane] = cvtpk(o[d0][r] * rli[r], o[d0][r + 1] * rli[r + 1]);
    } else {
        float ss[16];
#pragma unroll
        for (int r = 0; r < 16; ++r) ss[r] = 0.f;
#pragma unroll
        for (int d0 = 0; d0 < 4; ++d0)
#pragma unroll
            for (int r = 0; r < 16; r += 2) { const unsigned u = ostw[(d0 * 8 + (r >> 1)) * 64 + lane];
                const float v0 = o[d0][r] * rli[r] - lam * __uint_as_float(u << 16), v1 = o[d0][r + 1] * rli[r + 1] - lam * __uint_as_float(u & 0xffff0000u);
                o[d0][r] = v0; o[d0][r + 1] = v1; ss[r] += v0 * v0; ss[r + 1] += v1 * v1; }
#pragma unroll
        for (int msk = 1; msk < 32; msk <<= 1)
#pragma unroll
            for (int r = 0; r < 16; ++r) ss[r] += __shfl_xor(ss[r], msk);
        float sw[4];
#pragma unroll
        for (int d0 = 0; d0 < 4; ++d0) sw[d0] = subln_w[d0 * 32 + r32] * 0.8f;
        asm volatile("s_waitcnt lgkmcnt(0)" ::: "memory");
        bf16_t* stg = (bf16_t*)ostw;
#pragma unroll
        for (int r = 0; r < 16; ++r) { const float rs = 1.0f / sqrtf(ss[r] * (1.f / 128.f) + EPS); const int orow = crow(r, hi);
#pragma unroll
            for (int d0 = 0; d0 < 4; ++d0) stg[orow * 128 + d0 * 32 + r32] = (bf16_t)f2bf(o[d0][r] * rs * sw[d0]); }
        asm volatile("s_waitcnt lgkmcnt(0)" ::: "memory");
        bf16_t* Ow = cur.OUT + (size_t)(wid * QBLK) * D;
#pragma unroll
        for (int i = 0; i < 8; ++i) { const int row = i * 4 + (lane >> 4), ch = lane & 15; const u32x4 v = *(const u32x4*)(stg + row * 128 + ch * 8); *(u32x4*)(Ow + (size_t)row * D + ch * 8) = v; }
    }
    DA_VMW();
    __syncthreads();
#undef RESC
#undef KBASE
#undef MASKT
#undef HALF_STEP
}
#undef DA_VMW
#undef DA_KDMA
#undef DA_VDMA
#undef DA_ADDR
__device__ __forceinline__ BlockRef ref_of(int L, int seq, const bf16_t* PROJ, bf16_t* CAT) {
    const int bh = L >> 2, y = L & 3, b = bh >> 2, h = bh & 3, qb = (seq < 2) ? y : 7 - y, c = (seq & 1) ? 0 : 1;
    BlockRef r; const size_t row0 = (size_t)b * SEQ;
    r.Q = PROJ + (row0 + (size_t)qb * QB) * RS + h * 128 + c * 64; r.K = PROJ + row0 * RS + 512 + h * 128 + c * 64; r.V = PROJ + row0 * RS + 1024 + h * 128;
    r.OUT = CAT + (row0 + (size_t)qb * QB) * D + h * 128; r.P0 = qb * QB; r.c = c; return r;
}
__device__ __forceinline__ void phase(char* lds, const bf16_t* PROJ, bf16_t* CAT, float lam, const float* subln_w, int G, int bid) {
    constexpr int TOTAL = (T / SEQ) * 4 * 4;
    const int v = (G % 8 == 0) ? (bid & 7) * (G >> 3) + (bid >> 3) : bid;
    int L = v; if (L >= TOTAL) return;
    int seq = 0; BlockRef cur = ref_of(L, 0, PROJ, CAT);
    Seam S; prime(cur, lds, S);
    for (;;) {
        int Ln = L, seqn = seq + 1; if (seqn == 4) { seqn = 0; Ln = L + G; }
        const bool last = Ln >= TOTAL;
        const BlockRef nxt = last ? cur : ref_of(Ln, seqn, PROJ, CAT);
        block(cur, nxt, lds, S, lam, subln_w);
        if (last) break;
        cur = nxt; L = Ln; seq = seqn;
    }
}
#undef KSWZ64
#undef SBAR
}


#define LAS __attribute__((address_space(3)))
constexpr int NWAVES = 8, NTHREADS = 512;
namespace rtr {
typedef float f32x2 __attribute__((ext_vector_type(2)));
constexpr int LDS_W = 0, LDS_LG = 131072, LDS_CNT = LDS_LG + 8 * 16 * 33 * 4, LDS_BYTES = LDS_CNT + 256;
__device__ __forceinline__ void phase(LAS unsigned char* lds, const bf16_t* __restrict__ x1, const float* __restrict__ fw, const float* __restrict__ rw, const float* __restrict__ rb,
                                      int* cnt, int* ltok, float* lgate, int* slot, unsigned char* __restrict__ XQ, int G, int bid) {
    const int tid = otid(), lane = tid & 63, wid = __builtin_amdgcn_readfirstlane(tid >> 6), r = lane & 15, q = lane >> 4;
    LAS float* Wl = (LAS float*)(lds + LDS_W); LAS float* lg = (LAS float*)(lds + LDS_LG) + wid * (16 * 33); LAS int* lcount = (LAS int*)(lds + LDS_CNT); LAS int* lbase = lcount + 32;
    for (int idx = tid; idx < 1024 * 32; idx += NTHREADS) { const int k = idx >> 5, e = idx & 31; Wl[k * 32 + 2 * (e & 15) + (e >> 4)] = rw[idx] * fw[k]; }
    if (tid < 32) lcount[tid] = 0;
    __syncthreads();
    const float rb0 = rb[r], rb1 = rb[16 + r];
    for (int tile = bid; tile < T / 128; tile += G) {
        const int t0 = tile * 128 + wid * 16, ch = (tile * 128) / TC;
        const bf16_t* xrow = x1 + (size_t)(t0 + r) * D + 8 * q;
        f32x4 acc0 = {0.f, 0.f, 0.f, 0.f}, acc1 = {0.f, 0.f, 0.f, 0.f}; float ssq = 0.f;
#pragma unroll 4
        for (int j = 0; j < 32; ++j) {
            const u32x4 xw = *(const u32x4*)(xrow + 32 * j);
            const f32x4 xa = {__uint_as_float(xw[0] << 16), __uint_as_float(xw[0] & 0xffff0000u), __uint_as_float(xw[1] << 16), __uint_as_float(xw[1] & 0xffff0000u)},
                        xb = {__uint_as_float(xw[2] << 16), __uint_as_float(xw[2] & 0xffff0000u), __uint_as_float(xw[3] << 16), __uint_as_float(xw[3] & 0xffff0000u)};
            ssq += xa[0] * xa[0] + xa[1] * xa[1] + xa[2] * xa[2] + xa[3] * xa[3] + xb[0] * xb[0] + xb[1] * xb[1] + xb[2] * xb[2] + xb[3] * xb[3];
            const LAS float* wp = Wl + (32 * j + 8 * q) * 32 + 2 * r;
#pragma unroll
            for (int i = 0; i < 8; ++i) { const f32x2 w2 = *(const LAS f32x2*)(wp + i * 32); const float xv = i < 4 ? xa[i] : xb[i - 4];
                acc0 = __builtin_amdgcn_mfma_f32_16x16x4f32(xv, w2[0], acc0, 0, 0, 0); acc1 = __builtin_amdgcn_mfma_f32_16x16x4f32(xv, w2[1], acc1, 0, 0, 0); }
        }
        ssq += __shfl_xor(ssq, 16); ssq += __shfl_xor(ssq, 32);
        const float rstd = 1.0f / sqrtf(ssq * (1.f / D) + EPS);
        { const float sx = rstd * FP8_SX;
#pragma unroll 4
          for (int j = 0; j < 32; ++j) { const u32x4 xw = *(const u32x4*)(xrow + 32 * j);
              *(unsigned long long*)(XQ + (size_t)(t0 + r) * D + 32 * j + 8 * q) =
                  (unsigned long long)pk4_fp8(__uint_as_float(xw[0] << 16) * sx, __uint_as_float(xw[0] & 0xffff0000u) * sx, __uint_as_float(xw[1] << 16) * sx, __uint_as_float(xw[1] & 0xffff0000u) * sx)
                | ((unsigned long long)pk4_fp8(__uint_as_float(xw[2] << 16) * sx, __uint_as_float(xw[2] & 0xffff0000u) * sx, __uint_as_float(xw[3] << 16) * sx, __uint_as_float(xw[3] & 0xffff0000u) * sx) << 32); } }
        asm volatile("s_waitcnt lgkmcnt(0)" ::: "memory");
#pragma unroll
        for (int g4 = 0; g4 < 4; ++g4) { const float rs = __shfl(rstd, q * 4 + g4); lg[(q * 4 + g4) * 33 + r] = acc0[g4] * rs + rb0; lg[(q * 4 + g4) * 33 + 16 + r] = acc1[g4] * rs + rb1; }
        asm volatile("s_waitcnt lgkmcnt(0)" ::: "memory");
        int ti[4]; float gt[4]; int lpos[4];
        if (lane < 16) {
            float v[32];
#pragma unroll
            for (int e = 0; e < 32; ++e) v[e] = lg[lane * 33 + e];
            unsigned used = 0u; float tv[4];
#pragma unroll
            for (int k = 0; k < 4; ++k) { float best = -INFINITY; int bi = -1;
#pragma unroll
                for (int e = 0; e < 32; ++e) { const bool take = !((used >> e) & 1u) && (bi < 0 || v[e] > best); best = take ? v[e] : best; bi = take ? e : bi; }
                tv[k] = best; ti[k] = bi; used |= 1u << bi; }
            const float e1 = expf(tv[1] - tv[0]), e2 = expf(tv[2] - tv[0]), e3 = expf(tv[3] - tv[0]), inv = 1.f / (1.f + e1 + e2 + e3);
            gt[0] = inv; gt[1] = e1 * inv; gt[2] = e2 * inv; gt[3] = e3 * inv;
#pragma unroll
            for (int k = 0; k < 4; ++k) lpos[k] = __hip_atomic_fetch_add(lcount + ti[k], 1, __ATOMIC_RELAXED, __HIP_MEMORY_SCOPE_WORKGROUP);
        }
        __syncthreads();
        if (tid < 32) { const int c = lcount[tid]; lbase[tid] = c ? atomicAdd(&cnt[ch * 32 + tid], c) : 0; lcount[tid] = 0; }
        __syncthreads();
        if (lane < 16) { const int t = t0 + lane;
#pragma unroll
            for (int k = 0; k < 4; ++k) { const int pos = lbase[ti[k]] + lpos[k]; const size_t idx = ((size_t)ch * 32 + ti[k]) * TC + pos;
                ltok[idx] = t; lgate[idx] = gt[k]; slot[t * 4 + k] = (ti[k] << 16) | pos; } }
    }
    __syncthreads();
}
}

typedef unsigned gu32_t;
#define XB_TMO      128
#define XB_XCNT(j)  (256  + 64 * (j))
#define XB_XSUB(j)  (1280 + 64 * (j))
#define XB_XGEN(j)  (2304 + 64 * (j))
#define XB_TOP      3328
#define XB_TOPGEN   3392
#define XCD_BAR_WORDS 3456
#define XB_SPIN_CAP (1u << 18)

__device__ __forceinline__ unsigned xb_ld(unsigned* p)              { return __hip_atomic_load(p, __ATOMIC_RELAXED, __HIP_MEMORY_SCOPE_AGENT); }
__device__ __forceinline__ unsigned xb_add(unsigned* p, unsigned v) { return __hip_atomic_fetch_add(p, v, __ATOMIC_RELAXED, __HIP_MEMORY_SCOPE_AGENT); }
__device__ __forceinline__ unsigned xb_xcc_id() { return (unsigned)__builtin_amdgcn_s_getreg((3 << 11) | 20) & 0xFu; }
#define XB_SPIN(cond, bar) do { unsigned _sp = 0; while (cond) { __builtin_amdgcn_s_sleep(1); \
    if ((++_sp & 255u) == 0u) { if (xb_ld(&(bar)[XB_TMO])) break; if (_sp > XB_SPIN_CAP) { atomicAdd(&(bar)[XB_TMO], 1u); break; } } } } while (0)

struct XcdBarrier {
    unsigned* bar; unsigned x;
    volatile LAS unsigned* st;
};

__device__ __forceinline__ XcdBarrier xcd_barrier_post(unsigned* bar, volatile LAS unsigned* st) {
    XcdBarrier b; b.bar = bar; b.x = xb_xcc_id(); b.st = st;
    if (threadIdx.x == 0) (void)xb_add(&bar[XB_XCNT(b.x)], 1u);
    return b;
}
__device__ __forceinline__ void xcd_barrier_complete(unsigned* bar, unsigned x, unsigned& nloc, unsigned& nx) {
    const unsigned G = gridDim.x * gridDim.y * gridDim.z;
    unsigned sum, cnt, mine, sp = 0u;
    for (;;) {
        sum = 0u; cnt = 0u; mine = 0u;
#pragma unroll
        for (unsigned j = 0; j < 16; ++j) { const unsigned c = xb_ld(&bar[XB_XCNT(j)]); sum += c; cnt += (c > 0u) ? 1u : 0u; mine = (j == x) ? c : mine; }
        if (sum == G) break;
        __builtin_amdgcn_s_sleep(1);
        if ((++sp & 255u) == 0u) { if (xb_ld(&bar[XB_TMO])) break; if (sp > XB_SPIN_CAP) { atomicAdd(&bar[XB_TMO], 1u); break; } }
    }
    nloc = mine > 0u ? mine : 1u; nx = cnt > 0u ? cnt : 1u;
}

__device__ __forceinline__ void xcd_barrier(const XcdBarrier& b) {
    asm volatile("s_waitcnt vmcnt(0)" ::: "memory");
    __syncthreads();
    if (threadIdx.x == 0) {
        unsigned* bar = b.bar;
        __builtin_amdgcn_s_waitcnt(0);
        unsigned nloc = b.st[0], nx = b.st[1];
        if (nloc == 0u) { xcd_barrier_complete(bar, b.x, nloc, nx); b.st[0] = nloc; b.st[1] = nx; }
        const unsigned old = xb_add(&bar[XB_XSUB(b.x)], 1u);
        const unsigned gen = old / nloc;
        if (old + 1u == (gen + 1u) * nloc) {
            __builtin_amdgcn_fence(__ATOMIC_RELEASE, "agent");
            asm volatile("s_waitcnt vmcnt(0)" ::: "memory");
            const unsigned og = xb_add(&bar[XB_TOP], 1u);
            const unsigned tg = og / nx;
            if (og + 1u == (tg + 1u) * nx) xb_add(&bar[XB_TOPGEN], 1u);
            else XB_SPIN(xb_ld(&bar[XB_TOPGEN]) == tg, bar);
            __builtin_amdgcn_fence(__ATOMIC_ACQUIRE, "agent");
            xb_add(&bar[XB_XGEN(b.x)], 1u);
            asm volatile("s_waitcnt vmcnt(0)" ::: "memory");
        } else {
            XB_SPIN(xb_ld(&bar[XB_XGEN(b.x)]) == gen, bar);
            __builtin_amdgcn_fence(__ATOMIC_ACQUIRE, "agent");
            asm volatile("s_waitcnt vmcnt(0)" ::: "memory");
        }
    }
    __syncthreads();
}


constexpr int XB_LDS = pg8::STAGE_BYTES + pg8::PLAN_BYTES;
constexpr int MK_LDS = pg8::STAGE_BYTES + pg8::PLAN_BYTES + 64 + 2048;

struct MArgs {
    const float* x; const int* positions; const float* attn_norm_w; const float* w_in; const float* lq1; const float* lk1; const float* lq2; const float* lk2;
    const float* subln_w; const float* pool_w; const float* pool_scale; const float* w_out; const float* ffn_norm_w; const float* router_w; const float* router_b;
    const float* w_gu; const float* b_gu; const float* w_down; const float* b_down; const float* final_w; float* out; unsigned char* ws;
};

template <int MODE>
__device__ __forceinline__ void p0_transpose_item(const float* __restrict__ W, int N, bf16_t* __restrict__ WT, int ldk, LAS float* scr, int item, int lane, const float* __restrict__ kscale) {
    const int nblk = N / 32, kb = item / nblk, nb = item % nblk, k0 = 64 * kb, n0 = 32 * nb;
#pragma unroll 8
    for (int i = 0; i < 32; ++i) { const int kk = 2 * i + (lane >> 5); float v = W[(size_t)(k0 + kk) * N + n0 + (lane & 31)]; if (MODE != 0) v *= kscale[k0 + kk]; scr[kk * 33 + (lane & 31)] = v; }
    asm volatile("s_waitcnt lgkmcnt(0)" ::: "memory");
    const int c = lane & 7;
#pragma unroll
    for (int j = 0; j < 4; ++j) { const int nl = (lane >> 3) + 8 * j, n = n0 + nl; const LAS float* s = scr + (8 * c) * 33 + nl;
        int row = n;
        if (MODE == 1) { const int f = n & 1023, up = n >> 10; row = (f >> 7) * 256 + up * 128 + (f & 127); }
        u32x4 o; o.x = f2bf(s[0 * 33]) | (f2bf(s[1 * 33]) << 16); o.y = f2bf(s[2 * 33]) | (f2bf(s[3 * 33]) << 16); o.z = f2bf(s[4 * 33]) | (f2bf(s[5 * 33]) << 16); o.w = f2bf(s[6 * 33]) | (f2bf(s[7 * 33]) << 16);
        *(u32x4*)(WT + (size_t)row * ldk + k0 + 8 * c) = o; }
    asm volatile("s_waitcnt lgkmcnt(0)" ::: "memory");
}
template <int MODE>
__device__ __forceinline__ void p0_transpose_item_fp8(const float* __restrict__ W, int N, unsigned char* __restrict__ WT, int ldk, LAS float* scr, int item, int lane, const float* __restrict__ kscale, float sc) {
    const int nblk = N / 32, kb = item / nblk, nb = item % nblk, k0 = 64 * kb, n0 = 32 * nb;
#pragma unroll 8
    for (int i = 0; i < 32; ++i) { const int kk = 2 * i + (lane >> 5); float v = W[(size_t)(k0 + kk) * N + n0 + (lane & 31)] * sc; if (MODE == 1) v *= kscale[k0 + kk]; scr[kk * 33 + (lane & 31)] = v; }
    asm volatile("s_waitcnt lgkmcnt(0)" ::: "memory");
    const int c = lane & 3;
#pragma unroll
    for (int j = 0; j < 2; ++j) { const int nl = (lane >> 2) + 16 * j, n = n0 + nl; const LAS float* s = scr + (16 * c) * 33 + nl;
        int row = n;
        if (MODE == 1) { const int f = n & 1023, up = n >> 10; row = (f >> 7) * 256 + up * 128 + (f & 127); }
        u32x4 o;
#pragma unroll
        for (int q = 0; q < 4; ++q) o[q] = pk4_fp8(s[(4 * q) * 33], s[(4 * q + 1) * 33], s[(4 * q + 2) * 33], s[(4 * q + 3) * 33]);
        *(u32x4*)(WT + (size_t)row * ldk + k0 + 16 * c) = o; }
    asm volatile("s_waitcnt lgkmcnt(0)" ::: "memory");
}
__device__ __forceinline__ void xbf_row(const float* __restrict__ xrow, bf16_t* __restrict__ orow, float* __restrict__ rstd_out, int lane) {
    const f32x4* xr = (const f32x4*)xrow + lane;
    f32x4 v[4]; float s = 0.f;
#pragma unroll
    for (int j = 0; j < 4; ++j) { v[j] = xr[64 * j]; s += v[j].x * v[j].x + v[j].y * v[j].y + v[j].z * v[j].z + v[j].w * v[j].w; }
    unsigned long long* o8 = (unsigned long long*)orow + lane;
#pragma unroll
    for (int j = 0; j < 4; ++j) { const unsigned lo = f2bf(v[j].x) | (f2bf(v[j].y) << 16), hi = f2bf(v[j].z) | (f2bf(v[j].w) << 16); o8[64 * j] = (unsigned long long)lo | ((unsigned long long)hi << 32); }
    const float rstd = 1.0f / sqrtf(wave_sum(s) * (1.f / D) + EPS);
    if (lane == 0) *rstd_out = rstd;
}
__device__ __forceinline__ void rmsnorm_row_bf16(const float* __restrict__ xrow, const float* __restrict__ w, bf16_t* __restrict__ orow, int lane) {
    const f32x4* xr = (const f32x4*)xrow + lane;
    f32x4 v[4]; float s = 0.f;
#pragma unroll
    for (int j = 0; j < 4; ++j) { v[j] = xr[64 * j]; s += v[j].x * v[j].x + v[j].y * v[j].y + v[j].z * v[j].z + v[j].w * v[j].w; }
    const float rstd = 1.0f / sqrtf(wave_sum(s) * (1.f / D) + EPS);
    unsigned long long* o8 = (unsigned long long*)orow + lane;
#pragma unroll
    for (int j = 0; j < 4; ++j) { const f32x4 ww = ((const f32x4*)w)[64 * j + lane];
        const unsigned lo = f2bf(v[j].x * rstd * ww.x) | (f2bf(v[j].y * rstd * ww.y) << 16), hi = f2bf(v[j].z * rstd * ww.z) | (f2bf(v[j].w * rstd * ww.w) << 16);
        o8[64 * j] = (unsigned long long)lo | ((unsigned long long)hi << 32); }
}

__device__ __forceinline__ void final_row(float* __restrict__ out, const bf16_t* __restrict__ XB, const unsigned char* __restrict__ YP, const LAS int* tb, const int* slot, const float* __restrict__ lgate, const float* __restrict__ w, int t, int lane) {
    int rows[4]; float gk[4];
#pragma unroll
    for (int k = 0; k < 4; ++k) { const int sl = slot[t * 4 + k]; rows[k] = tb[sl >> 16] + (sl & 0xffff); gk[k] = lgate[(size_t)(sl >> 16) * TC + (sl & 0xffff)] * (1.0f / FP8_SY); }
    float v[16];
    { const u32x4 a0 = *(const u32x4*)(XB + (size_t)t * D + 16 * lane), a1 = *(const u32x4*)(XB + (size_t)t * D + 16 * lane + 8);
#pragma unroll
      for (int e = 0; e < 4; ++e) { v[2 * e] = __uint_as_float(a0[e] << 16); v[2 * e + 1] = __uint_as_float(a0[e] & 0xffff0000u); v[8 + 2 * e] = __uint_as_float(a1[e] << 16); v[8 + 2 * e + 1] = __uint_as_float(a1[e] & 0xffff0000u); } }
    float y[16];
#pragma unroll
    for (int e = 0; e < 16; ++e) y[e] = 0.f;
#pragma unroll
    for (int k = 0; k < 4; ++k) { const u32x4 q = *(const u32x4*)(YP + (size_t)rows[k] * D + 16 * lane);
#pragma unroll
        for (int e = 0; e < 4; ++e) { y[4 * e] += gk[k] * __builtin_amdgcn_cvt_f32_fp8(q[e], 0); y[4 * e + 1] += gk[k] * __builtin_amdgcn_cvt_f32_fp8(q[e], 1); y[4 * e + 2] += gk[k] * __builtin_amdgcn_cvt_f32_fp8(q[e], 2); y[4 * e + 3] += gk[k] * __builtin_amdgcn_cvt_f32_fp8(q[e], 3); } }
    float s = 0.f;
#pragma unroll
    for (int e = 0; e < 16; ++e) { v[e] += y[e]; s += v[e] * v[e]; }
    const float rstd = 1.0f / sqrtf(wave_sum(s) * (1.f / D) + EPS);
    float* op = out + (size_t)t * D + 16 * lane; const float* wp = w + 16 * lane;
#pragma unroll
    for (int e = 0; e < 4; ++e) { const f32x4 ww = *(const f32x4*)(wp + 4 * e); *(f32x4*)(op + 4 * e) = (f32x4){v[4 * e] * rstd * ww.x, v[4 * e + 1] * rstd * ww.y, v[4 * e + 2] * rstd * ww.z, v[4 * e + 3] * rstd * ww.w}; }
}

typedef const MArgs __attribute__((address_space(4)))* KArgP;
__device__ __forceinline__ KArgP kargs() { KArgP p = (KArgP)__builtin_amdgcn_kernarg_segment_ptr(); asm volatile("" : "+s"(p)); return p; }
#define WSP(T_, off) ((T_*)(ws + (off)))
__global__ __launch_bounds__(NTHREADS, 2) void mega_fwd(MArgs a_unused) {
    extern __shared__ __attribute__((aligned(16))) unsigned char lds_raw[];
    LAS unsigned char* lds = (LAS unsigned char*)lds_raw;
    const int G = gridDim.x, bid = blockIdx.x, gsz = G * NTHREADS, ngw = G * NWAVES;
    if (threadIdx.x < 16) ((LAS unsigned*)(lds + XB_LDS))[threadIdx.x] = 0u;
    __syncthreads();
    (void)xcd_barrier_post((unsigned*)(kargs()->ws + WS_BAR), (volatile LAS unsigned*)(lds + XB_LDS));
#define GRID_SYNC() do { XcdBarrier xb_; xb_.bar = (unsigned*)(kargs()->ws + WS_BAR); xb_.x = xb_xcc_id(); xb_.st = (volatile LAS unsigned*)(lds + XB_LDS); xcd_barrier(xb_); } while (0)
#define PHASE_IDX() const int tid = otid(), lane = tid & 63, wid = __builtin_amdgcn_readfirstlane(tid >> 6), gtid = bid * NTHREADS + tid, gw = bid * NWAVES + wid; (void)lane; (void)gtid; (void)gw

    {
        PHASE_IDX(); KArgP a = kargs(); unsigned char* ws = a->ws; int* cnt = WSP(int, WS_CTL); float* rope = WSP(float, WS_ROPE); bf16_t* Win_t = WSP(bf16_t, WS_WIN); bf16_t* Wo_t = WSP(bf16_t, WS_WO); bf16_t* Wd_t = WSP(bf16_t, WS_WD); bf16_t* Wgu_t = WSP(bf16_t, WS_WGU); bf16_t* XN = WSP(bf16_t, WS_XN);
        if (gtid < NCHUNK * 32) cnt[gtid] = 0;
        LAS float* scr = (LAS float*)(lds + wid * 8448);
        constexpr int I_IN = (D / 64) * (INW / 32), I_WO = (512 / 64) * (D / 32), I_GU = (D / 64) * (2048 / 32), I_DN = (FF / 64) * (D / 32);
        constexpr int NITEMS = I_IN + I_WO + NE * I_GU + NE * I_DN;
        for (int it = gw; it < NITEMS; it += ngw) {
            int r = it;
            if (r < I_IN) { p0_transpose_item<2>(a->w_in, INW, Win_t, D, scr, r, lane, a->attn_norm_w); continue; } r -= I_IN;
            if (r < I_WO) { p0_transpose_item<0>(a->w_out, D, Wo_t, D, scr, r, lane, nullptr); continue; } r -= I_WO;
            if (r < NE * I_GU) { const int e = r / I_GU; p0_transpose_item_fp8<1>(a->w_gu + (size_t)e * D * 2048, 2048, (unsigned char*)Wgu_t + (size_t)e * 2048 * D, D, scr, r % I_GU, lane, a->ffn_norm_w, FP8_SW); continue; } r -= NE * I_GU;
            { const int e = r / I_DN; p0_transpose_item_fp8<0>(a->w_down + (size_t)e * FF * D, D, (unsigned char*)Wd_t + (size_t)e * D * FF, FF, scr, r % I_DN, lane, nullptr, FP8_SW); }
        }
        for (int idx = gtid; idx < 512 * 1024; idx += gsz) {
            const int n = idx & 1023, gc = idx >> 10, g = gc >> 7; float acc = 0.f;
            for (int d = 0; d < 128; ++d) acc += a->pool_w[(size_t)gc * 128 + d] * a->pool_scale[g * 128 + d] * a->w_out[(size_t)(512 + g * 128 + d) * 1024 + n];
            Wo_t[(size_t)n * 1024 + 512 + gc] = (bf16_t)f2bf(acc);
        }
        for (int idx = gtid; idx < T * 8; idx += gsz) {
            const int t = idx >> 3, j = idx & 7;
            const double inv = exp(-(double)(2 * j) / 16.0 * log(500000.0)); const double ang = (double)a->positions[t] * inv;
            rope[(size_t)t * 16 + j] = (float)cos(ang); rope[(size_t)t * 16 + 8 + j] = (float)sin(ang);
        }
        for (int row = gw; row < T; row += ngw) xbf_row(a->x + (size_t)row * D, XN + (size_t)row * D, WSP(float, WS_RSTD) + row, lane);
    }
    GRID_SYNC();
    { PHASE_IDX(); KArgP a = kargs(); unsigned char* ws = a->ws; bf16_t* Win_t = WSP(bf16_t, WS_WIN); bf16_t* XN = WSP(bf16_t, WS_XN); bf16_t* PROJ = WSP(bf16_t, WS_PROJ); const float* rope = WSP(float, WS_ROPE);
      pg8::DensePlan S; S.init(T, INW, G, bid); pg8::EpiBf16 E{PROJ, INW, rope, 4, WSP(float, WS_RSTD)}; pg8::gemm_phase<2048, false>(lds, XN, Win_t, S, E); }
    GRID_SYNC();
    {
        PHASE_IDX(); KArgP a = kargs(); unsigned char* ws = a->ws; bf16_t* PROJ = WSP(bf16_t, WS_PROJ); bf16_t* CAT = WSP(bf16_t, WS_CAT);
        const float lam = expf(wave_sum(a->lq1[lane] * a->lk1[lane])) - expf(wave_sum(a->lq2[lane] * a->lk2[lane])) + 0.2f;
        dattn::phase((char*)lds_raw, PROJ, CAT, lam, a->subln_w, G, bid);
        for (int item = gtid; item < (T / 32) * 64; item += gsz) {
            const int chunk = item & 63, tb = item >> 6, c0 = chunk * 8, w = 2 << (c0 >> 7), t0 = tb * 32, s0 = t0 % SEQ;
            const bf16_t* up = PROJ + (size_t)t0 * INW + 1536 + c0; bf16_t* op = CAT + (size_t)t0 * D + 512 + c0;
            float sum[8];
#pragma unroll
            for (int e = 0; e < 8; ++e) sum[e] = 0.f;
            if (s0 > 0) for (int i = 1; i < w; ++i) { const u32x4 v = *(const u32x4*)(up - (size_t)i * INW);
#pragma unroll
                for (int e = 0; e < 4; ++e) { sum[2 * e] += __uint_as_float(v[e] << 16); sum[2 * e + 1] += __uint_as_float(v[e] & 0xffff0000u); } }
            for (int tt = 0; tt < 32; ++tt) {
                const u32x4 v = *(const u32x4*)(up + (size_t)tt * INW); float f[8];
#pragma unroll
                for (int e = 0; e < 4; ++e) { f[2 * e] = __uint_as_float(v[e] << 16); f[2 * e + 1] = __uint_as_float(v[e] & 0xffff0000u); }
                const int s = s0 + tt; const float rn = 1.0f / (float)((s + 1 < w) ? s + 1 : w);
                u32x4 o;
#pragma unroll
                for (int e = 0; e < 4; ++e) { sum[2 * e] += f[2 * e]; sum[2 * e + 1] += f[2 * e + 1]; o[e] = pg8::cvt_pk_bf16(sum[2 * e] * rn - f[2 * e], sum[2 * e + 1] * rn - f[2 * e + 1]); }
                *(u32x4*)(op + (size_t)tt * D) = o;
                if (s + 1 >= w) { const u32x4 ov = *(const u32x4*)(up + (size_t)(tt - w + 1) * INW);
#pragma unroll
                    for (int e = 0; e < 4; ++e) { sum[2 * e] -= __uint_as_float(ov[e] << 16); sum[2 * e + 1] -= __uint_as_float(ov[e] & 0xffff0000u); } }
            }
        }
    }
    GRID_SYNC();
    { PHASE_IDX(); KArgP a = kargs(); unsigned char* ws = a->ws; bf16_t* Wo_t = WSP(bf16_t, WS_WO); bf16_t* CAT = WSP(bf16_t, WS_CAT);
      pg8::DensePlan S; S.init(T, D, G, bid); pg8::EpiResBf16 E{WSP(bf16_t, WS_XB), WSP(bf16_t, WS_XN), D}; pg8::gemm_phase<2048, false>(lds, CAT, Wo_t, S, E); }
    GRID_SYNC();
    { PHASE_IDX(); KArgP a = kargs(); unsigned char* ws = a->ws;
      rtr::phase(lds, WSP(bf16_t, WS_XB), a->ffn_norm_w, a->router_w, a->router_b, WSP(int, WS_CTL), WSP(int, WS_LTOK), WSP(float, WS_LGATE), WSP(int, WS_SLOT), WSP(unsigned char, WS_XN), G, bid); }
    GRID_SYNC();
    for (int ch = 0; ch < NCHUNK; ++ch) {
        PHASE_IDX(); KArgP a = kargs(); unsigned char* ws = a->ws; int* cnt = WSP(int, WS_CTL); int* ltok = WSP(int, WS_LTOK); float* lgate = WSP(float, WS_LGATE); int* slot = WSP(int, WS_SLOT); bf16_t* Wd_t = WSP(bf16_t, WS_WD); bf16_t* Wgu_t = WSP(bf16_t, WS_WGU); bf16_t* XN = WSP(bf16_t, WS_XN); bf16_t* HM = WSP(bf16_t, WS_HM); bf16_t* YP = WSP(bf16_t, WS_YP); float* out = a->out;
        const int* cc = cnt + ch * 32; const int* lt = ltok + (size_t)ch * 32 * TC; const float* lg = lgate + (size_t)ch * 32 * TC;
        { pg8::MoePlan<true> S = pg8::moe_plan_setup<true>(lds + pg8::STAGE_BYTES, cc, lt, 8, G, bid); pg8::EpiGLU E{HM, a->b_gu, 8}; pg8::gemm_phase<1024, true>(lds, XN, Wgu_t, S, E); }
        GRID_SYNC();
        { pg8::MoePlan<false> S = pg8::moe_plan_setup<false>(lds + pg8::STAGE_BYTES, cc, lt, 4, G, bid); pg8::EpiDown E{YP, a->b_down, 4}; pg8::gemm_phase<1024, true>(lds, HM, Wd_t, S, E); }
        GRID_SYNC();
        { LAS int* tb = (LAS int*)(lds + pg8::STAGE_BYTES);
          if (tid < 64) { int v = (lane < 32) ? (__hip_atomic_load(cc + (lane & 31), __ATOMIC_RELAXED, __HIP_MEMORY_SCOPE_AGENT) + TM - 1) / TM : 0, incl = v;
#pragma unroll
              for (int o = 1; o < 32; o <<= 1) { const int up = __shfl_up(incl, o); if (lane >= o) incl += up; }
              if (lane < 32) tb[lane] = (incl - v) * TM; }
          __syncthreads();
          for (int t = ch * TC + gw; t < (ch + 1) * TC; t += ngw) final_row(out, WSP(bf16_t, WS_XB), (const unsigned char*)YP, tb, slot, lg, a->final_w, t, lane);
          __syncthreads(); }
    }
}

extern "C" void kernel_launch(void* const* d_in, const int* in_sizes, int n_in, void* d_out, int out_size, void* d_ws, size_t ws_size, hipStream_t stream) {
    if (n_in != 20 || in_sizes[0] != T * D || out_size != T * D || ws_size < WS_END) { fprintf(stderr, "kernel_launch: unexpected shapes / workspace (%d, %d, %d, %zu)\n", n_in, n_in > 0 ? in_sizes[0] : -1, out_size, ws_size); return; }
    static int grid_blocks = 0;
    if (!grid_blocks) {
        int dev = 0, cus = 0, per_cu = 0;
        (void)hipGetDevice(&dev); (void)hipDeviceGetAttribute(&cus, hipDeviceAttributeMultiprocessorCount, dev);
        (void)hipFuncSetAttribute((const void*)mega_fwd, hipFuncAttributeMaxDynamicSharedMemorySize, MK_LDS);
        (void)hipOccupancyMaxActiveBlocksPerMultiprocessor(&per_cu, (const void*)mega_fwd, NTHREADS, MK_LDS);
        if (per_cu < 1) { fprintf(stderr, "kernel_launch: occupancy query says %d blocks per CU\n", per_cu); per_cu = 1; }
        grid_blocks = cus * 1;
        if (grid_blocks % 8 != 0) grid_blocks -= grid_blocks % 8;
    }
    (void)hipMemsetAsync((char*)d_ws + WS_BAR, 0, XCD_BAR_WORDS * 4, stream);
    MArgs a{};
    a.x = (const float*)d_in[0]; a.positions = (const int*)d_in[1]; a.attn_norm_w = (const float*)d_in[2]; a.w_in = (const float*)d_in[3];
    a.lq1 = (const float*)d_in[4]; a.lk1 = (const float*)d_in[5]; a.lq2 = (const float*)d_in[6]; a.lk2 = (const float*)d_in[7];
    a.subln_w = (const float*)d_in[8]; a.pool_w = (const float*)d_in[9]; a.pool_scale = (const float*)d_in[10]; a.w_out = (const float*)d_in[11];
    a.ffn_norm_w = (const float*)d_in[12]; a.router_w = (const float*)d_in[13]; a.router_b = (const float*)d_in[14];
    a.w_gu = (const float*)d_in[15]; a.b_gu = (const float*)d_in[16]; a.w_down = (const float*)d_in[17]; a.b_down = (const float*)d_in[18]; a.final_w = (const float*)d_in[19];
    a.out = (float*)d_out; a.ws = (unsigned char*)d_ws;
    void* args[] = {&a};
    hipError_t e = hipLaunchCooperativeKernel((const void*)mega_fwd, dim3(grid_blocks), dim3(NTHREADS), args, MK_LDS, stream);
    if (e != hipSuccess) fprintf(stderr, "cooperative launch failed: %s (grid %d)\n", hipGetErrorString(e), grid_blocks);
}
```

```cpp
#include <hip/hip_runtime.h>
#include <cstdint>
#include <cstdio>

typedef unsigned short bf16_t;
typedef short bf16x8 __attribute__((ext_vector_type(8)));
typedef float f32x4 __attribute__((ext_vector_type(4)));
typedef unsigned u32x4 __attribute__((ext_vector_type(4)));

constexpr int T = 65536, D = 1024, SEQ = 2048, INW = 2048, NE = 32, FF = 1024, TOPK = 4;
constexpr int NCHUNK = 1, TC = T / NCHUNK;
constexpr int TM = 256;
constexpr int PC = TC * TOPK + NE * TM;
constexpr float EPS = 1e-5f;

constexpr size_t MiB = 1u << 20;
constexpr size_t WS_CTL = 0;
constexpr size_t WS_RSTD = 524288;
constexpr size_t WS_BAR = 65536;
constexpr size_t WS_LTOK = 1 * MiB;
constexpr size_t WS_LGATE = 9 * MiB;
constexpr size_t WS_SLOT = 17 * MiB;
constexpr size_t WS_ROPE = 18 * MiB;
constexpr size_t WS_WIN = 22 * MiB;
constexpr size_t WS_WO = 26 * MiB;
constexpr size_t WS_WD = 28 * MiB;
constexpr size_t WS_WGU = 92 * MiB;
constexpr size_t WS_XN = 220 * MiB;
constexpr size_t WS_PROJ = 348 * MiB;
constexpr size_t WS_CAT = 604 * MiB;
constexpr size_t WS_HM = 348 * MiB;
constexpr size_t WS_YP = 612 * MiB;
constexpr size_t WS_XB = 876 * MiB;
constexpr size_t WS_END = 1004 * MiB;
static_assert(WS_HM + (size_t)PC * 1024 <= WS_YP && WS_YP + (size_t)PC * 1024 <= WS_XB && WS_XB + (size_t)T * 1024 * 2 <= WS_END && WS_CAT + (size_t)T * 1024 * 2 <= WS_XB, "ws map");

__device__ __forceinline__ int otid() { int t = threadIdx.x; asm volatile("" : "+v"(t)); return t; }
__device__ __forceinline__ unsigned f2bf(float f) { unsigned u = __float_as_uint(f); return (u + 0x7fffu + ((u >> 16) & 1u)) >> 16; }
__device__ __forceinline__ unsigned pk4_fp8(float a, float b, float c, float d) {
    a = fminf(fmaxf(a, -448.f), 448.f); b = fminf(fmaxf(b, -448.f), 448.f); c = fminf(fmaxf(c, -448.f), 448.f); d = fminf(fmaxf(d, -448.f), 448.f);
    unsigned w = 0; w = __builtin_amdgcn_cvt_pk_fp8_f32(a, b, w, false); w = __builtin_amdgcn_cvt_pk_fp8_f32(c, d, w, true); return w; }
constexpr float FP8_SX = 16.f, FP8_SW = 512.f, FP8_SH = 4.f, FP8_SY = 32.f;
__device__ __forceinline__ float bf2f(unsigned h) { return __uint_as_float(h << 16); }
__device__ __forceinline__ float wave_sum(float v) {
#pragma unroll
    for (int o = 1; o < 64; o <<= 1) v += __shfl_xor(v, o);
    return v;
}
__device__ __forceinline__ float wave_max(float v) {
#pragma unroll
    for (int o = 1; o < 64; o <<= 1) v = fmaxf(v, __shfl_xor(v, o));
    return v;
}

namespace pg8 {
#define PG8_LAS __attribute__((address_space(3)))
constexpr int BM = 256, BK = 64, HALF = 128, HTB = HALF * BK * 2  , STAGE_BYTES = 8 * HTB;
constexpr int MAXU = 36, PLAN_BYTES = MAXU * 32 + MAXU * 512, EPI_LDS = STAGE_BYTES + PLAN_BYTES + 64;
__host__ __device__ __forceinline__ int lds_byte(int r, int c) { return r * 128 + ((((c >> 3) ^ ((r >> 1) & 7))) << 4); }
__host__ __device__ __forceinline__ void stage_rc(int b, int& R, int& C) { R = b >> 7; C = ((((b >> 4) & 7) ^ ((R >> 1) & 7))) << 3; }
__host__ __device__ __forceinline__ int perm32(int rho) { const int n = rho >> 4, i = rho & 15; return 8 * (i >> 2) + 4 * n + (i & 3); }
__device__ __forceinline__ unsigned cvt_pk_bf16(float lo, float hi) { unsigned r; asm volatile("v_cvt_pk_bf16_f32 %0, %1, %2" : "=v"(r) : "v"(lo), "v"(hi)); return r; }

template <int IMM = 0>
__device__ __forceinline__ void glds16s(const void* sbase, unsigned voff, unsigned lds_dst) { unsigned keep;
    asm volatile("s_mov_b32 %0, m0\n\ts_mov_b32 m0, %3\n\ts_nop 0\n\tglobal_load_lds_dwordx4 %1, %2 offset:%4\n\ts_mov_b32 m0, %0" : "=&s"(keep) : "v"(voff), "s"(sbase), "s"(lds_dst), "i"(IMM) : "memory"); }
typedef int v4i_t __attribute__((ext_vector_type(4)));
typedef int v8i_t __attribute__((ext_vector_type(8)));
__device__ __forceinline__ v8i_t cat8(bf16x8 lo, bf16x8 hi) { return __builtin_shufflevector(__builtin_bit_cast(v4i_t, lo), __builtin_bit_cast(v4i_t, hi), 0, 1, 2, 3, 4, 5, 6, 7); }
__device__ __forceinline__ void mfma_fp8_inplace(f32x4& acc, v8i_t a, v8i_t b) {
    asm volatile("v_mfma_scale_f32_16x16x128_f8f6f4 %0, %1, %2, %0, %3, %3 op_sel_hi:[0,0,0]" : "+v"(acc) : "v"(a), "v"(b), "v"(0x7F7F7F7F)); }
struct Unit { int pm, pn, e, lt, ne; };

template <int ROWB, bool FP8, class Epi, class Plan>
__device__ __forceinline__ void gemm_phase(PG8_LAS unsigned char* lds, const bf16_t* gA_, const bf16_t* gBt_, const Plan& S, const Epi& E) {
    const int tid = otid(), wid = __builtin_amdgcn_readfirstlane(tid >> 6), lane = tid & 63, wr = wid >> 2, wc = wid & 3, fr = lane & 15, fq = lane >> 4;
    constexpr int nt = ROWB / 128;
    unsigned voffB[2];
#pragma unroll
    for (int i = 0; i < 2; ++i) { int R, C; stage_rc(tid * 16 + i * 8192, R, C); const int Rb = Epi::PERM ? ((R & ~31) + perm32(R & 31)) : R; voffB[i] = (unsigned)(Rb * ROWB + C * 2); }
    const size_t kstep = (size_t)(BK * 2);
    const size_t hstep = (size_t)HALF * ROWB;
    const size_t tstep = 2 * hstep;
    const unsigned ldsb_epi0 = (unsigned)__builtin_amdgcn_readfirstlane((unsigned)(__UINTPTR_TYPE__)lds + (unsigned)EPI_LDS);
    const unsigned ldsb = (unsigned)__builtin_amdgcn_readfirstlane((unsigned)(__UINTPTR_TYPE__)lds + (unsigned)wid * 1024u);
    const int aoff0 = lds_byte(wr * 64 + fr, fq * 8), aoff1 = lds_byte(wr * 64 + fr, 32 + fq * 8), boff0 = lds_byte(wc * 32 + fr, fq * 8), boff1 = lds_byte(wc * 32 + fr, 32 + fq * 8);
#define PG8_SA(b, h) (((b) * 2 + (h)) * HTB)
#define PG8_SB(b, h) ((4 + (b) * 2 + (h)) * HTB)
#define PG8_STAGE(bufoff, gbase, voff) do { _Pragma("unroll") for (int _i = 0; _i < 2; ++_i) glds16s<0>((gbase), (voff)[_i], ldsb + (unsigned)((bufoff) + _i * 8192)); } while (0)
#define PG8_STAGEK(bufoff, gbase, voff) do { _Pragma("unroll") for (int _i = 0; _i < 2; ++_i) glds16s<BK * 2>((gbase), (voff)[_i], ldsb + (unsigned)((bufoff) + _i * 8192)); } while (0)
#define PG8_LDA(dst, b, h) do { _Pragma("unroll") for (int m = 0; m < 4; ++m) { \
        if constexpr (FP8) dst##8[m] = cat8(*(const PG8_LAS bf16x8*)(lds + PG8_SA(b, h) + aoff0 + m * 2048), *(const PG8_LAS bf16x8*)(lds + PG8_SA(b, h) + aoff1 + m * 2048)); \
        else { dst[m][0] = *(const PG8_LAS bf16x8*)(lds + PG8_SA(b, h) + aoff0 + m * 2048); dst[m][1] = *(const PG8_LAS bf16x8*)(lds + PG8_SA(b, h) + aoff1 + m * 2048); } } } while (0)
#define PG8_LDB(dst, b, h) do { _Pragma("unroll") for (int n = 0; n < 2; ++n) { \
        if constexpr (FP8) dst##8[n] = cat8(*(const PG8_LAS bf16x8*)(lds + PG8_SB(b, h) + boff0 + n * 2048), *(const PG8_LAS bf16x8*)(lds + PG8_SB(b, h) + boff1 + n * 2048)); \
        else { dst[n][0] = *(const PG8_LAS bf16x8*)(lds + PG8_SB(b, h) + boff0 + n * 2048); dst[n][1] = *(const PG8_LAS bf16x8*)(lds + PG8_SB(b, h) + boff1 + n * 2048); } } } while (0)
#define PG8_MMA(ai, bj, At, Bt) do { __builtin_amdgcn_s_setprio(1); _Pragma("unroll") for (int m = 0; m < 4; ++m) _Pragma("unroll") for (int n = 0; n < 2; ++n) { \
        if constexpr (FP8) mfma_fp8_inplace(acc[ai][bj][m][n], Bt##8[n], At##8[m]); \
        else { _Pragma("unroll") for (int k = 0; k < 2; ++k) acc[ai][bj][m][n] = __builtin_amdgcn_mfma_f32_16x16x32_bf16(Bt[n][k], At[m][k], acc[ai][bj][m][n], 0, 0, 0); } } \
        __builtin_amdgcn_s_setprio(0); } while (0)
#define PG8_WAIT_V(n) asm volatile("s_waitcnt vmcnt(" #n ")" ::: "memory")
#define PG8_WAIT_L(n) asm volatile("s_waitcnt lgkmcnt(" #n ")" ::: "memory")
#define PG8_BAR __builtin_amdgcn_s_barrier()
#define PG8_SCHED __builtin_amdgcn_sched_barrier(0)
#define PG8_VOFF(dst, U, UI) do { const int _tv = otid(); _Pragma("unroll") for (int _i = 0; _i < 2; ++_i) { int _R, _C; stage_rc(_tv * 16 + _i * 8192, _R, _C); \
        _Pragma("unroll") for (int _h = 0; _h < 2; ++_h) dst[_h][_i] = S.rowA(U, UI, _h * HALF + _R) * (unsigned)ROWB + (unsigned)(_C * 2); } } while (0)
#define PG8_SP1A(A1) do { \
          \
        PG8_LDB(B0, 0, 0); PG8_LDB(B1, 0, 1); PG8_SCHED; PG8_LDA(At, 0, 0); PG8_STAGE(PG8_SA(1, 1), (A1), vc[1]); \
        PG8_WAIT_V(8); PG8_WAIT_L(0); PG8_BAR; PG8_MMA(0, 0, At, B0); PG8_MMA(0, 1, At, B1); PG8_BAR; PG8_SCHED; } while (0)
#define PG8_REST(A2, B2) do { \
          \
        PG8_LDA(At, 0, 1); PG8_STAGE(PG8_SB(0, 0), (B2), voffB); PG8_STAGE(PG8_SB(0, 1), (B2) + hstep, voffB); PG8_STAGE(PG8_SA(0, 0), (A2), vc[0]); \
        PG8_WAIT_V(8); PG8_WAIT_L(0); PG8_BAR; PG8_MMA(1, 0, At, B0); PG8_MMA(1, 1, At, B1); PG8_BAR; PG8_SCHED; \
          \
        PG8_LDB(B0, 1, 0); PG8_LDB(B1, 1, 1); PG8_SCHED; PG8_LDA(At, 1, 0); PG8_STAGE(PG8_SA(0, 1), (A2), vc[1]); \
        PG8_WAIT_V(8); PG8_WAIT_L(0); PG8_BAR; PG8_MMA(0, 0, At, B0); PG8_MMA(0, 1, At, B1); PG8_BAR; PG8_SCHED; \
          \
        PG8_LDA(At, 1, 1); PG8_STAGE(PG8_SB(1, 0), (B2) + kstep, voffB); PG8_STAGE(PG8_SB(1, 1), (B2) + kstep + hstep, voffB); PG8_STAGE(PG8_SA(1, 0), (A2) + kstep, vc[0]); \
        PG8_WAIT_V(8); PG8_WAIT_L(0); PG8_BAR; PG8_MMA(1, 0, At, B0); PG8_MMA(1, 1, At, B1); PG8_BAR; PG8_SCHED; } while (0)
    Unit cur, nxt; int ui = 0;
    if (!S.next(0, cur)) return;
    f32x4 acc[2][2][4][2];
#pragma unroll
    for (int a = 0; a < 2; ++a)
#pragma unroll
        for (int b = 0; b < 2; ++b)
#pragma unroll
            for (int m = 0; m < 4; ++m)
#pragma unroll
                for (int n = 0; n < 2; ++n) acc[a][b][m][n] = (f32x4){0.f, 0.f, 0.f, 0.f};
    bf16x8 At[4][2], B0[2][2], B1[2][2]; v8i_t At8[4], B08[2], B18[2];
    unsigned vc[2][2];
    PG8_VOFF(vc, cur, 0);
    if (wid == 0) E.prefetch(cur, ldsb_epi0, lane);
    const char* gA = (const char*)gA_; const char* cB = (const char*)gBt_ + (size_t)cur.pn * tstep;
    PG8_STAGE(PG8_SB(0, 0), cB, voffB); PG8_STAGE(PG8_SB(0, 1), cB + hstep, voffB); PG8_STAGE(PG8_SA(0, 0), gA, vc[0]); PG8_STAGE(PG8_SA(0, 1), gA, vc[1]);
    if (wr == 1) PG8_BAR;
    PG8_WAIT_V(2); PG8_BAR;
    PG8_STAGE(PG8_SB(1, 0), cB + kstep, voffB); PG8_STAGE(PG8_SA(1, 0), gA + kstep, vc[0]); PG8_STAGE(PG8_SB(1, 1), cB + hstep + kstep, voffB);
    PG8_WAIT_V(6); PG8_BAR;
    for (;;) {
        const bool has_next = S.next(ui + 1, nxt);
        const char* nB = has_next ? (const char*)gBt_ + (size_t)nxt.pn * tstep : cB;
#pragma clang loop unroll(disable)
        for (int t = 0; t < nt - 2; t += 2) { PG8_SP1A(gA + (size_t)(t + 1) * kstep); PG8_REST(gA + (size_t)(t + 2) * kstep, cB + (size_t)(t + 2) * kstep); }
        PG8_SP1A(gA + (size_t)(nt - 1) * kstep);
        if (has_next) PG8_VOFF(vc, nxt, ui + 1);
        PG8_REST(gA, nB);
        if constexpr (FP8) {
            asm volatile("s_nop 15\n\ts_nop 15" ::: "memory");
#pragma unroll
            for (int a = 0; a < 2; ++a)
#pragma unroll
                for (int b = 0; b < 2; ++b)
#pragma unroll
                    for (int m = 0; m < 4; ++m)
#pragma unroll
                        for (int n = 0; n < 2; ++n) asm volatile("" : "+v"(acc[a][b][m][n]));
        }
        if (wr == 0) PG8_BAR;
        E(acc, cur, lds + EPI_LDS + (ui & 1) * 1024);
        if (!has_next) break;
#pragma unroll
        for (int a = 0; a < 2; ++a)
#pragma unroll
            for (int b = 0; b < 2; ++b)
#pragma unroll
                for (int m = 0; m < 4; ++m)
#pragma unroll
                    for (int n = 0; n < 2; ++n) acc[a][b][m][n] = (f32x4){0.f, 0.f, 0.f, 0.f};
        cur = nxt; cB = nB; ++ui;
        if (wid == 0) E.prefetch(cur, ldsb_epi0 + (unsigned)((ui & 1) * 1024), lane);
        if (wr == 1) PG8_BAR;
    }
    PG8_WAIT_V(0);
    PG8_BAR;
#undef PG8_SA
#undef PG8_SB
#undef PG8_STAGE
#undef PG8_STAGEK
#undef PG8_LDA
#undef PG8_LDB
#undef PG8_MMA
#undef PG8_WAIT_V
#undef PG8_WAIT_L
#undef PG8_BAR
#undef PG8_SCHED
#undef PG8_VOFF
#undef PG8_SP1A
#undef PG8_REST
}

struct DensePlan {
    int nM, nN, nwg, G, c;
    __device__ void init(int M, int N, int G_, int c_) { nM = M / BM; nN = N / BM; nwg = nM * nN; G = G_; c = c_; }
    __device__ __forceinline__ bool next(int i, Unit& u) const {
        const long L = (long)i * G + c; if (L >= nwg) return false;
        int wgid = (int)L; { const int q = nwg / 8, r = nwg % 8, xcd = wgid % 8, off = wgid / 8; wgid = (xcd < r ? xcd * (q + 1) : r * (q + 1) + (xcd - r) * q) + off; }
        const int nig = 8 * nN, gid = wgid / nig, fm = gid * 8, gsz = (nM - fm) < 8 ? (nM - fm) : 8;
        u.pm = fm + ((wgid % nig) % gsz); u.pn = (wgid % nig) / gsz; u.e = 0; u.lt = 0; u.ne = 0; return true;
    }
    __device__ __forceinline__ unsigned rowA(const Unit& u, int, int r) const { return (unsigned)(u.pm * BM + r); }
};
template <bool GATHER>
struct MoePlan {
    const PG8_LAS int* desc; const PG8_LAS unsigned short* rowtab;
    __device__ __forceinline__ bool next(int i, Unit& u) const {
        if (i >= MAXU) return false;
        const PG8_LAS int* d = desc + i * 8;
        const int v = __builtin_amdgcn_readfirstlane(d[0]); u.pm = __builtin_amdgcn_readfirstlane(d[1]); u.pn = __builtin_amdgcn_readfirstlane(d[2]);
        u.e = __builtin_amdgcn_readfirstlane(d[3]); u.lt = __builtin_amdgcn_readfirstlane(d[4]); u.ne = __builtin_amdgcn_readfirstlane(d[5]); return v != 0;
    }
    __device__ __forceinline__ unsigned rowA(const Unit& u, int ui, int r) const { return GATHER ? (unsigned)rowtab[ui * 256 + r] : (unsigned)(u.pm * BM + r); }
};
template <bool GATHER>
__device__ __forceinline__ MoePlan<GATHER> moe_plan_setup(PG8_LAS unsigned char* tab, const int* cnt, const int* ltok, int NT, int G, int c) {
    PG8_LAS int* desc = (PG8_LAS int*)tab; PG8_LAS unsigned short* rowtab = (PG8_LAS unsigned short*)(tab + MAXU * 32);
    PG8_LAS int* cs = (PG8_LAS int*)rowtab;
    PG8_LAS int* bs = cs + 32;
    const int tid = otid(), xcd = c & 7, j = c >> 3;
    if (tid < 32) cs[tid] = __hip_atomic_load(cnt + tid, __ATOMIC_RELAXED, __HIP_MEMORY_SCOPE_AGENT);
    __syncthreads();
    if (tid < 64) { const int ln = tid & 63; int v = (ln < 32) ? (cs[ln & 31] + BM - 1) / BM : 0, incl = v;
#pragma unroll
        for (int o = 1; o < 32; o <<= 1) { const int up = __shfl_up(incl, o); if (ln >= o) incl += up; }
        if (ln < 32) bs[ln] = incl - v; if (ln == 31) bs[32] = incl; }
    __syncthreads();
    if (tid < MAXU) {
        const int q = tid * (G >> 3) + j, mt = (q / NT) * 8 + xcd, pnl = q % NT;
        int e = -1;
        for (int k = 0; k < 32; ++k) if (mt >= bs[k] && mt < bs[k + 1]) e = k;
        desc[tid * 8 + 0] = e >= 0 ? 1 : 0; desc[tid * 8 + 1] = mt; desc[tid * 8 + 2] = (e >= 0 ? e : 0) * NT + pnl; desc[tid * 8 + 3] = e;
        desc[tid * 8 + 4] = e >= 0 ? mt - bs[e] : 0; desc[tid * 8 + 5] = e >= 0 ? cs[e] : 0;
    }
    __syncthreads();
    if (GATHER && tid < 256) {
        for (int i = 0; i < MAXU; ++i) {
            const PG8_LAS int* d = desc + i * 8; const int valid = d[0], e = d[3], lt = d[4], ne = d[5];
            const int p = lt * BM + tid; rowtab[i * 256 + tid] = (unsigned short)((valid && p < ne) ? ltok[(size_t)e * TC + p] : 0);
        }
    }
    __syncthreads();
    MoePlan<GATHER> S; S.desc = desc; S.rowtab = rowtab; return S;
}

struct EpiBf16 {
    __device__ __forceinline__ void prefetch(const Unit& u, unsigned lds_dst, int lane) const { glds16s<0>(rstd + (size_t)u.pm * BM, (unsigned)(lane * 16), lds_dst); }
    static constexpr bool PERM = true;
    bf16_t* O; int ldc; const float* rope; int rope_tiles; const float* rstd;
    __device__ __forceinline__ void operator()(const f32x4 (&acc)[2][2][4][2], const Unit& u, const PG8_LAS unsigned char* el) const {
        const int tv_ = otid();
        const int wr = tv_ >> 8, wc = (tv_ >> 6) & 3, fr = tv_ & 15, fq = (tv_ >> 4) & 3;
        const int row0 = u.pm * BM + wr * 64 + fr, col0 = u.pn * BM + wc * 32 + 8 * fq;
        const bool rot = (u.pn < rope_tiles) && ((__builtin_amdgcn_readfirstlane(tv_ >> 6) & 1) == 0);
#pragma unroll
        for (int ai = 0; ai < 2; ++ai)
#pragma unroll
            for (int m = 0; m < 4; ++m) { const int row = row0 + ai * HALF + m * 16; bf16_t* rowp = O + (size_t)row * ldc + col0;
                const float rsd = ((const PG8_LAS float*)el)[wr * 64 + fr + ai * HALF + m * 16];
                f32x4 cs0, cs1, sn0, sn1;
                if (rot) { const float* rp = rope + (size_t)row * 16; cs0 = *(const f32x4*)rp; cs1 = *(const f32x4*)(rp + 4); sn0 = *(const f32x4*)(rp + 8); sn1 = *(const f32x4*)(rp + 12);
                    if (fq == 0) { sn0 = -sn0; sn1 = -sn1; } }
#pragma unroll
                for (int bj = 0; bj < 2; ++bj) { f32x4 v0 = acc[ai][bj][m][0] * rsd, v1 = acc[ai][bj][m][1] * rsd;
                    if (rot) { f32x4 p0, p1;
#pragma unroll
                        for (int j = 0; j < 4; ++j) { p0[j] = __shfl_xor(v0[j], 16); p1[j] = __shfl_xor(v1[j], 16); }
                        if (fq < 2) { v0 = v0 * cs0 + p0 * sn0; v1 = v1 * cs1 + p1 * sn1; } }
                    u32x4 w; w.x = cvt_pk_bf16(v0[0], v0[1]); w.y = cvt_pk_bf16(v0[2], v0[3]); w.z = cvt_pk_bf16(v1[0], v1[1]); w.w = cvt_pk_bf16(v1[2], v1[3]);
                    *(u32x4*)(rowp + bj * HALF) = w; } }
    }
};
struct EpiResBf16 {
    __device__ __forceinline__ void prefetch(const Unit&, unsigned, int) const {}
    static constexpr bool PERM = true;
    bf16_t* XB; const bf16_t* resid; int ldc;
    __device__ __forceinline__ void operator()(const f32x4 (&acc)[2][2][4][2], const Unit& u, const PG8_LAS unsigned char* el) const {
        const int tv_ = otid();
        const int wr = tv_ >> 8, wc = (tv_ >> 6) & 3, fr = tv_ & 15, fq = (tv_ >> 4) & 3;
        const int row0 = u.pm * BM + wr * 64 + fr, col0 = u.pn * BM + wc * 32 + 8 * fq;
        u32x4 xr[2][4][2];
#pragma unroll
        for (int ai = 0; ai < 2; ++ai)
#pragma unroll
            for (int m = 0; m < 4; ++m)
#pragma unroll
                for (int bj = 0; bj < 2; ++bj) xr[ai][m][bj] = *(const u32x4*)(resid + (size_t)(row0 + ai * HALF + m * 16) * ldc + col0 + bj * HALF);
        asm volatile("" ::: "memory");
#pragma unroll
        for (int ai = 0; ai < 2; ++ai)
#pragma unroll
            for (int m = 0; m < 4; ++m) { const size_t off = (size_t)(row0 + ai * HALF + m * 16) * ldc + col0;
#pragma unroll
                for (int bj = 0; bj < 2; ++bj) { const u32x4 x4 = xr[ai][m][bj];
                    const f32x4 v0 = (f32x4){__uint_as_float(x4.x << 16), __uint_as_float(x4.x & 0xffff0000u), __uint_as_float(x4.y << 16), __uint_as_float(x4.y & 0xffff0000u)} + acc[ai][bj][m][0],
                                v1 = (f32x4){__uint_as_float(x4.z << 16), __uint_as_float(x4.z & 0xffff0000u), __uint_as_float(x4.w << 16), __uint_as_float(x4.w & 0xffff0000u)} + acc[ai][bj][m][1];
                    u32x4 w; w.x = cvt_pk_bf16(v0[0], v0[1]); w.y = cvt_pk_bf16(v0[2], v0[3]); w.z = cvt_pk_bf16(v1[0], v1[1]); w.w = cvt_pk_bf16(v1[2], v1[3]);
                    *(u32x4*)(XB + off + bj * HALF) = w; } }
    }
};
struct EpiGLU {
    static constexpr bool PERM = true;
    bf16_t* HM; const float* b_gu; int NT;
    __device__ __forceinline__ void prefetch(const Unit& u, unsigned lds_dst, int lane) const {
        const int pnl = u.pn - u.e * NT; glds16s<0>(b_gu + (size_t)u.e * 2048 + pnl * HALF, (unsigned)((lane & 31) * 16 + (lane >> 5) * 4096), lds_dst); }
    __device__ __forceinline__ void operator()(const f32x4 (&acc)[2][2][4][2], const Unit& u, const PG8_LAS unsigned char* el) const {
        const int tv_ = otid();
        const int wr = tv_ >> 8, wc = (tv_ >> 6) & 3, fr = tv_ & 15, fq = (tv_ >> 4) & 3;
        const int pnl = u.pn - u.e * NT, f0 = pnl * HALF + wc * 32 + 8 * fq, row0 = u.pm * BM + wr * 64 + fr;
        const PG8_LAS float* bl = (const PG8_LAS float*)el + wc * 32 + 8 * fq;
        f32x4 bgt[2], bup[2];
#pragma unroll
        for (int n = 0; n < 2; ++n) { bgt[n] = *(const PG8_LAS f32x4*)(bl + 4 * n); bup[n] = *(const PG8_LAS f32x4*)(bl + 128 + 4 * n); }
        constexpr float rs = 1.0f / (FP8_SX * FP8_SW);
#pragma unroll
        for (int ai = 0; ai < 2; ++ai)
#pragma unroll
            for (int m = 0; m < 4; ++m) { float h[8];
#pragma unroll
                for (int n = 0; n < 2; ++n)
#pragma unroll
                    for (int j = 0; j < 4; ++j) { const float gv = fminf(acc[ai][0][m][n][j] * rs + bgt[n][j], 7.0f), uv = fminf(fmaxf(acc[ai][1][m][n][j] * rs + bup[n][j], -7.0f), 7.0f);
                        h[4 * n + j] = (uv + 1.0f) * gv * __builtin_amdgcn_rcpf(1.0f + __expf(-1.702f * gv)); }
                const unsigned long long w = (unsigned long long)pk4_fp8(h[0] * FP8_SH, h[1] * FP8_SH, h[2] * FP8_SH, h[3] * FP8_SH) | ((unsigned long long)pk4_fp8(h[4] * FP8_SH, h[5] * FP8_SH, h[6] * FP8_SH, h[7] * FP8_SH) << 32);
                *(unsigned long long*)((unsigned char*)HM + (size_t)(row0 + ai * HALF + m * 16) * FF + f0) = w; }
    }
};
struct EpiDown {
    static constexpr bool PERM = true;
    bf16_t* YP; const float* b_d; int NT;
    __device__ __forceinline__ void prefetch(const Unit& u, unsigned lds_dst, int lane) const {
        const int pnl = u.pn - u.e * NT; glds16s<0>(b_d + (size_t)u.e * 1024 + pnl * BM, (unsigned)(lane * 16), lds_dst); }
    __device__ __forceinline__ void operator()(const f32x4 (&acc)[2][2][4][2], const Unit& u, const PG8_LAS unsigned char* el) const {
        const int tv_ = otid();
        const int wr = tv_ >> 8, wc = (tv_ >> 6) & 3, fr = tv_ & 15, fq = (tv_ >> 4) & 3;
        const int pnl = u.pn - u.e * NT, col0 = pnl * BM + wc * 32 + 8 * fq, rl0 = wr * 64 + fr;
        const PG8_LAS float* bl = (const PG8_LAS float*)el + wc * 32 + 8 * fq;
        f32x4 bv[2][2];
#pragma unroll
        for (int bj = 0; bj < 2; ++bj)
#pragma unroll
            for (int n = 0; n < 2; ++n) bv[bj][n] = *(const PG8_LAS f32x4*)(bl + bj * HALF + 4 * n);
        constexpr float sa = FP8_SY / (FP8_SH * FP8_SW);
#pragma unroll
        for (int ai = 0; ai < 2; ++ai)
#pragma unroll
            for (int m = 0; m < 4; ++m) { const int rl = rl0 + ai * HALF + m * 16;
                unsigned char* rowp = (unsigned char*)YP + (size_t)(u.pm * BM + rl) * D + col0;
#pragma unroll
                for (int bj = 0; bj < 2; ++bj) { const f32x4 v0 = acc[ai][bj][m][0] * sa + bv[bj][0] * FP8_SY, v1 = acc[ai][bj][m][1] * sa + bv[bj][1] * FP8_SY;
                    *(unsigned long long*)(rowp + bj * HALF) = (unsigned long long)pk4_fp8(v0[0], v0[1], v0[2], v0[3]) | ((unsigned long long)pk4_fp8(v1[0], v1[1], v1[2], v1[3]) << 32); } }
    }
};
}


namespace dattn {
typedef float f32x16 __attribute__((ext_vector_type(16)));
typedef short s16x4 __attribute__((ext_vector_type(4)));
constexpr int NW = 8, QBLK = 32, KVBLK = 64, QB = NW * QBLK, DK = 64, DV = 128, RS = INW;
constexpr int SHM_V = KVBLK * DV * 2, SHM_K = KVBLK * DK * 2;
constexpr int NVB = 4;
constexpr int LDS_V = 0, LDS_K = NVB * SHM_V, LDS_WS = LDS_K + 2 * SHM_K, LDS_OST = LDS_WS + NW * 64 * 4, LDS_BYTES = LDS_OST + NW * 8192;
constexpr float SCALE = 0.125f, THR = 8.f;
#define KSWZ64(row, colB) ((row) * 128 + ((colB) ^ ((((row) >> 1) & 7) << 4)))
#define SBAR() __builtin_amdgcn_sched_barrier(0)
__device__ __forceinline__ int v_slot_key(int p) { const int kk = ((p >> 7) << 3) | ((p & 31) >> 2); return (kk & ~0xC) | ((kk & 4) << 1) | ((kk & 8) >> 1); }
__device__ __forceinline__ int v_slot_col(int p) { return ((p >> 5) & 3) * 32 + (p & 3) * 8; }
__device__ __forceinline__ int v_rd_base(int lane) { return ((lane & 3) << 3) | (((lane >> 2) & 3) << 6) | (((lane >> 4) & 1) << 5) | (((lane >> 5) & 1) << 8); }
constexpr int v_rd_off(int d0, int ks, int half) { return d0 * 512 + ks * 4096 + half * 2048; }
__device__ __forceinline__ int crow(int r, int hi) { return (r & 3) + 8 * (r >> 2) + 4 * hi; }
__device__ __forceinline__ unsigned cvtpk(float lo, float hi) { unsigned r; asm volatile("v_cvt_pk_bf16_f32 %0, %1, %2" : "=v"(r) : "v"(lo), "v"(hi)); return r; }
__device__ __forceinline__ bf16x8 load8(const bf16_t* p) { return *reinterpret_cast<const bf16x8*>(p); }
__device__ __forceinline__ void mask_tile(f32x16& p0, f32x16& p1, int dq) {
    const float NEG = -__builtin_inff();
#pragma unroll
    for (int r = 0; r < 16; ++r) { const int c = (r & 3) + 8 * (r >> 2); if (dq - c < 0) p0[r] = NEG; if (dq - c - 32 < 0) p1[r] = NEG; }
}
__device__ __forceinline__ void partialSM(f32x16& p0, f32x16& p1, float& m_reg, float& mn, float& alpha) {
    float pmax = p0[0];
#pragma unroll
    for (int r = 1; r < 16; ++r) pmax = fmaxf(pmax, p0[r]);
#pragma unroll
    for (int r = 0; r < 16; ++r) pmax = fmaxf(pmax, p1[r]);
    { auto rr = __builtin_amdgcn_permlane32_swap(__float_as_uint(pmax), __float_as_uint(pmax), false, false); pmax = fmaxf(__uint_as_float(rr[0]), __uint_as_float(rr[1])); }
    constexpr float C2 = 1.4426950408889634f * SCALE;
    if (__builtin_expect(__all((pmax - m_reg) * SCALE <= THR), 1)) { mn = m_reg; alpha = 1.f; }
    else { mn = fmaxf(m_reg, pmax); alpha = __builtin_amdgcn_exp2f((m_reg - mn) * C2); m_reg = mn; }
    const float mnL = -mn * C2;
#pragma unroll
    for (int r = 0; r < 16; ++r) p0[r] = fmaf(p0[r], C2, mnL);
#pragma unroll
    for (int r = 0; r < 16; ++r) p1[r] = fmaf(p1[r], C2, mnL);
#pragma unroll
    for (int r = 0; r < 16; ++r) p0[r] = __builtin_amdgcn_exp2f(p0[r]);
}
__device__ __forceinline__ void finishSM(f32x16& p0, f32x16& p1, float alpha, float& l_reg, bf16x8& pa0, bf16x8& pa1, bf16x8& pa2, bf16x8& pa3) {
#pragma unroll
    for (int r = 0; r < 16; ++r) p1[r] = __builtin_amdgcn_exp2f(p1[r]);
    float ps = 0;
#pragma unroll
    for (int r = 0; r < 16; ++r) ps += p0[r];
#pragma unroll
    for (int r = 0; r < 16; ++r) ps += p1[r];
    { auto rr = __builtin_amdgcn_permlane32_swap(__float_as_uint(ps), __float_as_uint(ps), false, false); ps = __uint_as_float(rr[0]) + __uint_as_float(rr[1]); }
    l_reg = l_reg * alpha + ps;
#define PK4(P, B_, OUT) do { unsigned a0 = cvtpk(P[B_+0], P[B_+1]), a1 = cvtpk(P[B_+2], P[B_+3]);                          \
        unsigned b0 = cvtpk(P[B_+4], P[B_+5]), b1 = cvtpk(P[B_+6], P[B_+7]);                                             \
        auto r0 = __builtin_amdgcn_permlane32_swap(a0, b0, false, false); auto r1 = __builtin_amdgcn_permlane32_swap(a1, b1, false, false); \
        u32x4 w = {r0[0], r1[0], r0[1], r1[1]}; OUT = *reinterpret_cast<bf16x8*>(&w); } while (0)
    PK4(p0, 0, pa0); PK4(p0, 8, pa1); PK4(p1, 0, pa2); PK4(p1, 8, pa3);
#undef PK4
}
template <int KB>
__device__ __forceinline__ void qkt(f32x16& p0, f32x16& p1, const char* K_lds, int r32, int hi, const bf16x8* qr) {
    p0 = f32x16{}; p1 = f32x16{};
#pragma unroll
    for (int d0 = 0; d0 < 4; ++d0) { const char* a = K_lds + KB * SHM_K + KSWZ64(r32, (d0 * 16 + hi * 8) * 2);
        bf16x8 b0 = *reinterpret_cast<const bf16x8*>(a);
        bf16x8 b1 = *reinterpret_cast<const bf16x8*>(a + 32 * 128);
        p0 = __builtin_amdgcn_mfma_f32_32x32x16_bf16(b0, qr[d0], p0, 0, 0, 0);
        p1 = __builtin_amdgcn_mfma_f32_32x32x16_bf16(b1, qr[d0], p1, 0, 0, 0); }
}
template <int VB>
__device__ __forceinline__ void pv_tile(f32x16* o, int vb0, bf16x8 pa0, bf16x8 pa1, bf16x8 pa2, bf16x8 pa3) {
#define TRRD(dst, off) asm volatile("ds_read_b64_tr_b16 %0, %1 offset:%2" : "=&v"(dst) : "v"(vb0), "i"(off) : "memory")
#define PV_RD(S, d0) do { constexpr int b_ = LDS_V + VB * SHM_V + v_rd_off(d0, 0, 0); \
        TRRD(S##l0, b_); TRRD(S##h0, b_ + 2048); TRRD(S##l1, b_ + 4096); TRRD(S##h1, b_ + 6144); TRRD(S##l2, b_ + 8192); TRRD(S##h2, b_ + 10240); TRRD(S##l3, b_ + 12288); TRRD(S##h3, b_ + 14336); } while (0)
#define PV_MM(S, d0) do { \
        o[d0] = __builtin_amdgcn_mfma_f32_32x32x16_bf16(pa0, (bf16x8){S##l0[0], S##l0[1], S##l0[2], S##l0[3], S##h0[0], S##h0[1], S##h0[2], S##h0[3]}, o[d0], 0, 0, 0);   \
        o[d0] = __builtin_amdgcn_mfma_f32_32x32x16_bf16(pa1, (bf16x8){S##l1[0], S##l1[1], S##l1[2], S##l1[3], S##h1[0], S##h1[1], S##h1[2], S##h1[3]}, o[d0], 0, 0, 0);   \
        o[d0] = __builtin_amdgcn_mfma_f32_32x32x16_bf16(pa2, (bf16x8){S##l2[0], S##l2[1], S##l2[2], S##l2[3], S##h2[0], S##h2[1], S##h2[2], S##h2[3]}, o[d0], 0, 0, 0);   \
        o[d0] = __builtin_amdgcn_mfma_f32_32x32x16_bf16(pa3, (bf16x8){S##l3[0], S##l3[1], S##l3[2], S##l3[3], S##h3[0], S##h3[1], S##h3[2], S##h3[3]}, o[d0], 0, 0, 0); } while (0)
#define LGK(n) do { asm volatile("s_waitcnt lgkmcnt(" #n ")" ::: "memory"); SBAR(); } while (0)
    s16x4 Al0, Al1, Al2, Al3, Ah0, Ah1, Ah2, Ah3, Bl0, Bl1, Bl2, Bl3, Bh0, Bh1, Bh2, Bh3;
    PV_RD(A, 0); PV_RD(B, 1); LGK(8); PV_MM(A, 0); SBAR();
    PV_RD(A, 2); LGK(8); PV_MM(B, 1); SBAR();
    PV_RD(B, 3); LGK(8); PV_MM(A, 2); SBAR();
    LGK(0); PV_MM(B, 3);
#undef PV_RD
#undef PV_MM
#undef LGK
#undef TRRD
}
struct BlockRef { const bf16_t* Q; const bf16_t* K; const bf16_t* V; bf16_t* OUT; int P0, c; };
struct Seam { bf16x8 qr[4]; };
#define DA_VMW() asm volatile("s_waitcnt vmcnt(0)" ::: "memory")
#define DA_KDMA(Kp, k0, bf) pg8::glds16s<0>((Kp) + (size_t)(k0) * RS, kvo, kdst + (unsigned)((bf) * SHM_K))
#define DA_VDMA(Vp, k0, bf) do { pg8::glds16s<0>((Vp) + (size_t)(k0) * RS, vvo0, vdst + (unsigned)((bf) * SHM_V)); pg8::glds16s<0>((Vp) + (size_t)(k0) * RS, vvo1, vdst + (unsigned)((bf) * SHM_V + 8192)); } while (0)
#define DA_ADDR() \
    const int kr = tid >> 3; \
    const unsigned kvo = (unsigned)(kr * RS + (((tid & 7) ^ ((kr >> 1) & 7)) * 8)) * 2u, kdst = (unsigned)__builtin_amdgcn_readfirstlane((unsigned)(uintptr_t)lds + LDS_K + wid * 1024); \
    const unsigned vvo0 = (unsigned)(v_slot_key(tid) * RS + v_slot_col(tid)) * 2u, vvo1 = (unsigned)(v_slot_key(tid + 512) * RS + v_slot_col(tid + 512)) * 2u, \
                   vdst = (unsigned)__builtin_amdgcn_readfirstlane((unsigned)(uintptr_t)lds + LDS_V + wid * 1024)
__device__ __forceinline__ void prime(const BlockRef& cur, char* lds, Seam& S) {
    const int tid = otid(), wid = __builtin_amdgcn_readfirstlane(tid >> 6), lane = tid & 63, r32 = lane & 31, hi = lane >> 5;
    DA_ADDR();
#pragma unroll
    for (int d0 = 0; d0 < 4; ++d0) S.qr[d0] = load8(cur.Q + (size_t)(wid * QBLK + r32) * RS + d0 * 16 + hi * 8);
    DA_KDMA(cur.K, 0, 0); DA_VDMA(cur.V, 0, 0); DA_VMW();
    __syncthreads();
}
__device__ __forceinline__ void block(const BlockRef& cur, const BlockRef& nxt, char* lds, Seam& S, float lam, const float* __restrict__ subln_w) {
    const int tid = otid(), wid = __builtin_amdgcn_readfirstlane(tid >> 6), lane = tid & 63, r32 = lane & 31, hi = lane >> 5;
    const int NT = (cur.P0 + QB) / KVBLK;
    const int qlo = cur.P0 + wid * QBLK, qm = qlo + r32 - 4 * hi;
    char* K_lds = lds + LDS_K;
    float* ws = (float*)(lds + LDS_WS) + wid * 64; float* li_l = ws; float* al_l = ws + 32;
    float m_reg = -1e30f, l_reg = 0; f32x16 o[4] = {};
    DA_ADDR();
    const int vb0 = (int)(uintptr_t)lds + v_rd_base(lane);
    const bf16_t* Kh = cur.K; const bf16_t* Vh = cur.V;
#define RESC(a) do { if (__any((a) < 1.f)) { if (hi == 0) al_l[r32] = (a); asm volatile("s_waitcnt lgkmcnt(0)" ::: "memory");              \
                     _Pragma("unroll") for (int d_ = 0; d_ < 4; ++d_) _Pragma("unroll") for (int r = 0; r < 16; ++r) o[d_][r] *= al_l[crow(r, hi)]; } } while (0)
#define KBASE(t) ((t) * KVBLK)
#define MASKT(P0_, P1_, t) do { const int kb_ = KBASE(t); if (kb_ + KVBLK - 1 > qlo) mask_tile(P0_, P1_, qm - kb_); } while (0)
    f32x16 pA0, pA1, pB0, pB1; float mnA, mnB, alA, alB; bf16x8 pa0, pa1, pa2, pa3;
    DA_KDMA(Kh, KBASE(1), 1); DA_VDMA(Vh, KBASE(1), 1);
    SBAR(); qkt<0>(pA0, pA1, K_lds, r32, hi, S.qr);
    MASKT(pA0, pA1, 0); partialSM(pA0, pA1, m_reg, mnA, alA);
    DA_VMW(); __syncthreads();
#define HALF_STEP(PX0, PX1, mnX, alX, PY0, PY1, alY, t, KB, VBP, KBN, VBN) do {                                               \
        SBAR(); qkt<KB>(PX0, PX1, K_lds, r32, hi, S.qr);                                                                      \
        finishSM(PY0, PY1, alY, l_reg, pa0, pa1, pa2, pa3); SBAR();                                                           \
        DA_KDMA(Kh, KBASE((t) + 1), KBN); DA_VDMA(Vh, KBASE((t) + 1), VBN); SBAR();                                          \
        pv_tile<VBP>(o, vb0, pa0, pa1, pa2, pa3); MASKT(PX0, PX1, (t)); partialSM(PX0, PX1, m_reg, mnX, alX);                  \
        RESC(alX); DA_VMW(); __syncthreads(); } while (0)
    HALF_STEP(pB0, pB1, mnB, alB, pA0, pA1, alA, 1, 1, 0, 0, 2);
    HALF_STEP(pA0, pA1, mnA, alA, pB0, pB1, alB, 2, 0, 1, 1, 3);
    for (int t = 3; t + 1 < NT; t += 4) {
        HALF_STEP(pB0, pB1, mnB, alB, pA0, pA1, alA, t, 1, 2, 0, 0);
        HALF_STEP(pA0, pA1, mnA, alA, pB0, pB1, alB, t + 1, 0, 3, 1, 1);
        HALF_STEP(pB0, pB1, mnB, alB, pA0, pA1, alA, t + 2, 1, 0, 0, 2);
        HALF_STEP(pA0, pA1, mnA, alA, pB0, pB1, alB, t + 3, 0, 1, 1, 3);
    }
    SBAR(); qkt<1>(pB0, pB1, K_lds, r32, hi, S.qr); SBAR();
    DA_KDMA(nxt.K, 0, 0); DA_VDMA(nxt.V, 0, 0); SBAR();
#pragma unroll
    for (int d0 = 0; d0 < 4; ++d0) S.qr[d0] = load8(nxt.Q + (size_t)(wid * QBLK + r32) * RS + d0 * 16 + hi * 8);
    SBAR();
    finishSM(pA0, pA1, alA, l_reg, pa0, pa1, pa2, pa3); SBAR();
    pv_tile<2>(o, vb0, pa0, pa1, pa2, pa3);
    MASKT(pB0, pB1, NT - 1); partialSM(pB0, pB1, m_reg, mnB, alB); RESC(alB);
    finishSM(pB0, pB1, alB, l_reg, pa0, pa1, pa2, pa3); SBAR(); pv_tile<3>(o, vb0, pa0, pa1, pa2, pa3);
    SBAR();
    if (hi == 0) li_l[r32] = l_reg;
    asm volatile("s_waitcnt lgkmcnt(0)" ::: "memory");
    float rli[16];
#pragma unroll
    for (int r = 0; r < 16; ++r) rli[r] = __builtin_amdgcn_rcpf(li_l[crow(r, hi)]);
    unsigned* ostw = (unsigned*)(lds + LDS_OST + wid * 8192);
    if (cur.c == 1) {
#pragma unroll
        for (int d0 = 0; d0 < 4; ++d0)
#pragma unroll
            for (int r = 0; r < 16; r += 2) ostw[(d0 * 8 + (r >> 1)) * 64 + lane] = cvtpk(o[d0][r] * rli[r], o[d0][r + 1] * rli[r + 1]);
    } else {
        float ss[16];
#pragma unroll
        for (int r = 0; r < 16; ++r) ss[r] = 0.f;
#pragma unroll
        for (int d0 = 0; d0 < 4; ++d0)
#pragma unroll
            for (int r = 0; r < 16; r += 2) { const unsigned u = ostw[(d0 * 8 + (r >> 1)) * 64 + lane];
                const float v0 = o[d0][r] * rli[r] - lam * __uint_as_float(u << 16), v1 = o[d0][r + 1] * rli[r + 1] - lam * __uint_as_float(u & 0xffff0000u);
                o[d0][r] = v0; o[d0][r + 1] = v1; ss[r] += v0 * v0; ss[r + 1] += v1 * v1; }
#pragma unroll
        for (int msk = 1; msk < 32; msk <<= 1)
#pragma unroll
            for (int r = 0; r < 16; ++r) ss[r] += __shfl_xor(ss[r], msk);
        float sw[4];
#pragma unroll
        for (int d0 = 0; d0 < 4; ++d0) sw[d0] = subln_w[d0 * 32 + r32] * 0.8f;
        asm volatile("s_waitcnt lgkmcnt(0)" ::: "memory");
        bf16_t* stg = (bf16_t*)ostw;
#pragma unroll
        for (int r = 0; r < 16; ++r) { const float rs = 1.0f / sqrtf(ss[r] * (1.f / 128.f) + EPS); const int orow = crow(r, hi);
#pragma unroll
            for (int d0 = 0; d0 < 4; ++d0) stg[orow * 128 + d0 * 32 + r32] = (bf16_t)f2bf(o[d0][r] * rs * sw[d0]); }
        asm volatile("s_waitcnt lgkmcnt(0)" ::: "memory");
        bf16_t* Ow = cur.OUT + (size_t)(wid * QBLK) * D;
#pragma unroll
        for (int i = 0; i < 8; ++i) { const int row = i * 4 + (lane >> 4), ch = lane & 15; const u32x4 v = *(const u32x4*)(stg + row * 128 + ch * 8); *(u32x4*)(Ow + (size_t)row * D + ch * 8) = v; }
    }
    DA_VMW();
    __syncthreads();
#undef RESC
#undef KBASE
#undef MASKT
#undef HALF_STEP
}
#undef DA_VMW
#undef DA_KDMA
#undef DA_VDMA
#undef DA_ADDR
__device__ __forceinline__ BlockRef ref_of(int L, int seq, const bf16_t* PROJ, bf16_t* CAT) {
    const int bh = L >> 2, y = L & 3, b = bh >> 2, h = bh & 3, qb = (seq < 2) ? y : 7 - y, c = (seq & 1) ? 0 : 1;
    BlockRef r; const size_t row0 = (size_t)b * SEQ;
    r.Q = PROJ + (row0 + (size_t)qb * QB) * RS + h * 128 + c * 64; r.K = PROJ + row0 * RS + 512 + h * 128 + c * 64; r.V = PROJ + row0 * RS + 1024 + h * 128;
    r.OUT = CAT + (row0 + (size_t)qb * QB) * D + h * 128; r.P0 = qb * QB; r.c = c; return r;
}
__device__ __forceinline__ void phase(char* lds, const bf16_t* PROJ, bf16_t* CAT, float lam, const float* subln_w, int G, int bid) {
    constexpr int TOTAL = (T / SEQ) * 4 * 4;
    const int v = (G % 8 == 0) ? (bid & 7) * (G >> 3) + (bid >> 3) : bid;
    int L = v; if (L >= TOTAL) return;
    int seq = 0; BlockRef cur = ref_of(L, 0, PROJ, CAT);
    Seam S; prime(cur, lds, S);
    for (;;) {
        int Ln = L, seqn = seq + 1; if (seqn == 4) { seqn = 0; Ln = L + G; }
        const bool last = Ln >= TOTAL;
        const BlockRef nxt = last ? cur : ref_of(Ln, seqn, PROJ, CAT);
        block(cur, nxt, lds, S, lam, subln_w);
        if (last) break;
        cur = nxt; L = Ln; seq = seqn;
    }
}
#undef KSWZ64
#undef SBAR
}


#define LAS __attribute__((address_space(3)))
constexpr int NWAVES = 8, NTHREADS = 512;
namespace rtr {
typedef float f32x2 __attribute__((ext_vector_type(2)));
constexpr int LDS_W = 0, LDS_LG = 131072, LDS_CNT = LDS_LG + 8 * 16 * 33 * 4, LDS_BYTES = LDS_CNT + 256;
__device__ __forceinline__ void phase(LAS unsigned char* lds, const bf16_t* __restrict__ x1, const float* __restrict__ fw, const float* __restrict__ rw, const float* __restrict__ rb,
                                      int* cnt, int* ltok, float* lgate, int* slot, unsigned char* __restrict__ XQ, int G, int bid) {
    const int tid = otid(), lane = tid & 63, wid = __builtin_amdgcn_readfirstlane(tid >> 6), r = lane & 15, q = lane >> 4;
    LAS float* Wl = (LAS float*)(lds + LDS_W); LAS float* lg = (LAS float*)(lds + LDS_LG) + wid * (16 * 33); LAS int* lcount = (LAS int*)(lds + LDS_CNT); LAS int* lbase = lcount + 32;
    for (int idx = tid; idx < 1024 * 32; idx += NTHREADS) { const int k = idx >> 5, e = idx & 31; Wl[k * 32 + 2 * (e & 15) + (e >> 4)] = rw[idx] * fw[k]; }
    if (tid < 32) lcount[tid] = 0;
    __syncthreads();
    const float rb0 = rb[r], rb1 = rb[16 + r];
    for (int tile = bid; tile < T / 128; tile += G) {
        const int t0 = tile * 128 + wid * 16, ch = (tile * 128) / TC;
        const bf16_t* xrow = x1 + (size_t)(t0 + r) * D + 8 * q;
        f32x4 acc0 = {0.f, 0.f, 0.f, 0.f}, acc1 = {0.f, 0.f, 0.f, 0.f}; float ssq = 0.f;
#pragma unroll 4
        for (int j = 0; j < 32; ++j) {
            const u32x4 xw = *(const u32x4*)(xrow + 32 * j);
            const f32x4 xa = {__uint_as_float(xw[0] << 16), __uint_as_float(xw[0] & 0xffff0000u), __uint_as_float(xw[1] << 16), __uint_as_float(xw[1] & 0xffff0000u)},
                        xb = {__uint_as_float(xw[2] << 16), __uint_as_float(xw[2] & 0xffff0000u), __uint_as_float(xw[3] << 16), __uint_as_float(xw[3] & 0xffff0000u)};
            ssq += xa[0] * xa[0] + xa[1] * xa[1] + xa[2] * xa[2] + xa[3] * xa[3] + xb[0] * xb[0] + xb[1] * xb[1] + xb[2] * xb[2] + xb[3] * xb[3];
            const LAS float* wp = Wl + (32 * j + 8 * q) * 32 + 2 * r;
#pragma unroll
            for (int i = 0; i < 8; ++i) { const f32x2 w2 = *(const LAS f32x2*)(wp + i * 32); const float xv = i < 4 ? xa[i] : xb[i - 4];
                acc0 = __builtin_amdgcn_mfma_f32_16x16x4f32(xv, w2[0], acc0, 0, 0, 0); acc1 = __builtin_amdgcn_mfma_f32_16x16x4f32(xv, w2[1], acc1, 0, 0, 0); }
        }
        ssq += __shfl_xor(ssq, 16); ssq += __shfl_xor(ssq, 32);
        const float rstd = 1.0f / sqrtf(ssq * (1.f / D) + EPS);
        { const float sx = rstd * FP8_SX;
#pragma unroll 4
          for (int j = 0; j < 32; ++j) { const u32x4 xw = *(const u32x4*)(xrow + 32 * j);
              *(unsigned long long*)(XQ + (size_t)(t0 + r) * D + 32 * j + 8 * q) =
                  (unsigned long long)pk4_fp8(__uint_as_float(xw[0] << 16) * sx, __uint_as_float(xw[0] & 0xffff0000u) * sx, __uint_as_float(xw[1] << 16) * sx, __uint_as_float(xw[1] & 0xffff0000u) * sx)
                | ((unsigned long long)pk4_fp8(__uint_as_float(xw[2] << 16) * sx, __uint_as_float(xw[2] & 0xffff0000u) * sx, __uint_as_float(xw[3] << 16) * sx, __uint_as_float(xw[3] & 0xffff0000u) * sx) << 32); } }
        asm volatile("s_waitcnt lgkmcnt(0)" ::: "memory");
#pragma unroll
        for (int g4 = 0; g4 < 4; ++g4) { const float rs = __shfl(rstd, q * 4 + g4); lg[(q * 4 + g4) * 33 + r] = acc0[g4] * rs + rb0; lg[(q * 4 + g4) * 33 + 16 + r] = acc1[g4] * rs + rb1; }
        asm volatile("s_waitcnt lgkmcnt(0)" ::: "memory");
        int ti[4]; float gt[4]; int lpos[4];
        if (lane < 16) {
            float v[32];
#pragma unroll
            for (int e = 0; e < 32; ++e) v[e] = lg[lane * 33 + e];
            unsigned used = 0u; float tv[4];
#pragma unroll
            for (int k = 0; k < 4; ++k) { float best = -INFINITY; int bi = -1;
#pragma unroll
                for (int e = 0; e < 32; ++e) { const bool take = !((used >> e) & 1u) && (bi < 0 || v[e] > best); best = take ? v[e] : best; bi = take ? e : bi; }
                tv[k] = best; ti[k] = bi; used |= 1u << bi; }
            const float e1 = expf(tv[1] - tv[0]), e2 = expf(tv[2] - tv[0]), e3 = expf(tv[3] - tv[0]), inv = 1.f / (1.f + e1 + e2 + e3);
            gt[0] = inv; gt[1] = e1 * inv; gt[2] = e2 * inv; gt[3] = e3 * inv;
#pragma unroll
            for (int k = 0; k < 4; ++k) lpos[k] = __hip_atomic_fetch_add(lcount + ti[k], 1, __ATOMIC_RELAXED, __HIP_MEMORY_SCOPE_WORKGROUP);
        }
        __syncthreads();
        if (tid < 32) { const int c = lcount[tid]; lbase[tid] = c ? atomicAdd(&cnt[ch * 32 + tid], c) : 0; lcount[tid] = 0; }
        __syncthreads();
        if (lane < 16) { const int t = t0 + lane;
#pragma unroll
            for (int k = 0; k < 4; ++k) { const int pos = lbase[ti[k]] + lpos[k]; const size_t idx = ((size_t)ch * 32 + ti[k]) * TC + pos;
                ltok[idx] = t; lgate[idx] = gt[k]; slot[t * 4 + k] = (ti[k] << 16) | pos; } }
    }
    __syncthreads();
}
}

typedef unsigned gu32_t;
#define XB_TMO      128
#define XB_XCNT(j)  (256  + 64 * (j))
#define XB_XSUB(j)  (1280 + 64 * (j))
#define XB_XGEN(j)  (2304 + 64 * (j))
#define XB_TOP      3328
#define XB_TOPGEN   3392
#define XCD_BAR_WORDS 3456
#define XB_SPIN_CAP (1u << 18)

__device__ __forceinline__ unsigned xb_ld(unsigned* p)              { return __hip_atomic_load(p, __ATOMIC_RELAXED, __HIP_MEMORY_SCOPE_AGENT); }
__device__ __forceinline__ unsigned xb_add(unsigned* p, unsigned v) { return __hip_atomic_fetch_add(p, v, __ATOMIC_RELAXED, __HIP_MEMORY_SCOPE_AGENT); }
__device__ __forceinline__ unsigned xb_xcc_id() { return (unsigned)__builtin_amdgcn_s_getreg((3 << 11) | 20) & 0xFu; }
#define XB_SPIN(cond, bar) do { unsigned _sp = 0; while (cond) { __builtin_amdgcn_s_sleep(1); \
    if ((++_sp & 255u) == 0u) { if (xb_ld(&(bar)[XB_TMO])) break; if (_sp > XB_SPIN_CAP) { atomicAdd(&(bar)[XB_TMO], 1u); break; } } } } while (0)

struct XcdBarrier {
    unsigned* bar; unsigned x;
    volatile LAS unsigned* st;
};

__device__ __forceinline__ XcdBarrier xcd_barrier_post(unsigned* bar, volatile LAS unsigned* st) {
    XcdBarrier b; b.bar = bar; b.x = xb_xcc_id(); b.st = st;
    if (threadIdx.x == 0) (void)xb_add(&bar[XB_XCNT(b.x)], 1u);
    return b;
}
__device__ __forceinline__ void xcd_barrier_complete(unsigned* bar, unsigned x, unsigned& nloc, unsigned& nx) {
    const unsigned G = gridDim.x * gridDim.y * gridDim.z;
    unsigned sum, cnt, mine, sp = 0u;
    for (;;) {
        sum = 0u; cnt = 0u; mine = 0u;
#pragma unroll
        for (unsigned j = 0; j < 16; ++j) { const unsigned c = xb_ld(&bar[XB_XCNT(j)]); sum += c; cnt += (c > 0u) ? 1u : 0u; mine = (j == x) ? c : mine; }
        if (sum == G) break;
        __builtin_amdgcn_s_sleep(1);
        if ((++sp & 255u) == 0u) { if (xb_ld(&bar[XB_TMO])) break; if (sp > XB_SPIN_CAP) { atomicAdd(&bar[XB_TMO], 1u); break; } }
    }
    nloc = mine > 0u ? mine : 1u; nx = cnt > 0u ? cnt : 1u;
}

__device__ __forceinline__ void xcd_barrier(const XcdBarrier& b) {
    asm volatile("s_waitcnt vmcnt(0)" ::: "memory");
    __syncthreads();
    if (threadIdx.x == 0) {
        unsigned* bar = b.bar;
        __builtin_amdgcn_s_waitcnt(0);
        unsigned nloc = b.st[0], nx = b.st[1];
        if (nloc == 0u) { xcd_barrier_complete(bar, b.x, nloc, nx); b.st[0] = nloc; b.st[1] = nx; }
        const unsigned old = xb_add(&bar[XB_XSUB(b.x)], 1u);
        const unsigned gen = old / nloc;
        if (old + 1u == (gen + 1u) * nloc) {
            __builtin_amdgcn_fence(__ATOMIC_RELEASE, "agent");
            asm volatile("s_waitcnt vmcnt(0)" ::: "memory");
            const unsigned og = xb_add(&bar[XB_TOP], 1u);
            const unsigned tg = og / nx;
            if (og + 1u == (tg + 1u) * nx) xb_add(&bar[XB_TOPGEN], 1u);
            else XB_SPIN(xb_ld(&bar[XB_TOPGEN]) == tg, bar);
            __builtin_amdgcn_fence(__ATOMIC_ACQUIRE, "agent");
            xb_add(&bar[XB_XGEN(b.x)], 1u);
            asm volatile("s_waitcnt vmcnt(0)" ::: "memory");
        } else {
            XB_SPIN(xb_ld(&bar[XB_XGEN(b.x)]) == gen, bar);
            __builtin_amdgcn_fence(__ATOMIC_ACQUIRE, "agent");
            asm volatile("s_waitcnt vmcnt(0)" ::: "memory");
        }
    }
    __syncthreads();
}


constexpr int XB_LDS = pg8::STAGE_BYTES + pg8::PLAN_BYTES;
constexpr int MK_LDS = pg8::STAGE_BYTES + pg8::PLAN_BYTES + 64 + 2048;

struct MArgs {
    const float* x; const int* positions; const float* attn_norm_w; const float* w_in; const float* lq1; const float* lk1; const float* lq2; const float* lk2;
    const float* subln_w; const float* pool_w; const float* pool_scale; const float* w_out; const float* ffn_norm_w; const float* router_w; const float* router_b;
    const float* w_gu; const float* b_gu; const float* w_down; const float* b_down; const float* final_w; float* out; unsigned char* ws;
};

template <int MODE>
__device__ __forceinline__ void p0_transpose_item(const float* __restrict__ W, int N, bf16_t* __restrict__ WT, int ldk, LAS float* scr, int item, int lane, const float* __restrict__ kscale) {
    const int nblk = N / 32, kb = item / nblk, nb = item % nblk, k0 = 64 * kb, n0 = 32 * nb;
#pragma unroll 8
    for (int i = 0; i < 32; ++i) { const int kk = 2 * i + (lane >> 5); float v = W[(size_t)(k0 + kk) * N + n0 + (lane & 31)]; if (MODE != 0) v *= kscale[k0 + kk]; scr[kk * 33 + (lane & 31)] = v; }
    asm volatile("s_waitcnt lgkmcnt(0)" ::: "memory");
    const int c = lane & 7;
#pragma unroll
    for (int j = 0; j < 4; ++j) { const int nl = (lane >> 3) + 8 * j, n = n0 + nl; const LAS float* s = scr + (8 * c) * 33 + nl;
        int row = n;
        if (MODE == 1) { const int f = n & 1023, up = n >> 10; row = (f >> 7) * 256 + up * 128 + (f & 127); }
        u32x4 o; o.x = f2bf(s[0 * 33]) | (f2bf(s[1 * 33]) << 16); o.y = f2bf(s[2 * 33]) | (f2bf(s[3 * 33]) << 16); o.z = f2bf(s[4 * 33]) | (f2bf(s[5 * 33]) << 16); o.w = f2bf(s[6 * 33]) | (f2bf(s[7 * 33]) << 16);
        *(u32x4*)(WT + (size_t)row * ldk + k0 + 8 * c) = o; }
    asm volatile("s_waitcnt lgkmcnt(0)" ::: "memory");
}
template <int MODE>
__device__ __forceinline__ void p0_transpose_item_fp8(const float* __restrict__ W, int N, unsigned char* __restrict__ WT, int ldk, LAS float* scr, int item, int lane, const float* __restrict__ kscale, float sc) {
    const int nblk = N / 32, kb = item / nblk, nb = item % nblk, k0 = 64 * kb, n0 = 32 * nb;
#pragma unroll 8
    for (int i = 0; i < 32; ++i) { const int kk = 2 * i + (lane >> 5); float v = W[(size_t)(k0 + kk) * N + n0 + (lane & 31)] * sc; if (MODE == 1) v *= kscale[k0 + kk]; scr[kk * 33 + (lane & 31)] = v; }
    asm volatile("s_waitcnt lgkmcnt(0)" ::: "memory");
    const int c = lane & 3;
#pragma unroll
    for (int j = 0; j < 2; ++j) { const int nl = (lane >> 2) + 16 * j, n = n0 + nl; const LAS float* s = scr + (16 * c) * 33 + nl;
        int row = n;
        if (MODE == 1) { const int f = n & 1023, up = n >> 10; row = (f >> 7) * 256 + up * 128 + (f & 127); }
        u32x4 o;
#pragma unroll
        for (int q = 0; q < 4; ++q) o[q] = pk4_fp8(s[(4 * q) * 33], s[(4 * q + 1) * 33], s[(4 * q + 2) * 33], s[(4 * q + 3) * 33]);
        *(u32x4*)(WT + (size_t)row * ldk + k0 + 16 * c) = o; }
    asm volatile("s_waitcnt lgkmcnt(0)" ::: "memory");
}
__device__ __forceinline__ void xbf_row(const float* __restrict__ xrow, bf16_t* __restrict__ orow, float* __restrict__ rstd_out, int lane) {
    const f32x4* xr = (const f32x4*)xrow + lane;
    f32x4 v[4]; float s = 0.f;
#pragma unroll
    for (int j = 0; j < 4; ++j) { v[j] = xr[64 * j]; s += v[j].x * v[j].x + v[j].y * v[j].y + v[j].z * v[j].z + v[j].w * v[j].w; }
    unsigned long long* o8 = (unsigned long long*)orow + lane;
#pragma unroll
    for (int j = 0; j < 4; ++j) { const unsigned lo = f2bf(v[j].x) | (f2bf(v[j].y) << 16), hi = f2bf(v[j].z) | (f2bf(v[j].w) << 16); o8[64 * j] = (unsigned long long)lo | ((unsigned long long)hi << 32); }
    const float rstd = 1.0f / sqrtf(wave_sum(s) * (1.f / D) + EPS);
    if (lane == 0) *rstd_out = rstd;
}
__device__ __forceinline__ void rmsnorm_row_bf16(const float* __restrict__ xrow, const float* __restrict__ w, bf16_t* __restrict__ orow, int lane) {
    const f32x4* xr = (const f32x4*)xrow + lane;
    f32x4 v[4]; float s = 0.f;
#pragma unroll
    for (int j = 0; j < 4; ++j) { v[j] = xr[64 * j]; s += v[j].x * v[j].x + v[j].y * v[j].y + v[j].z * v[j].z + v[j].w * v[j].w; }
    const float rstd = 1.0f / sqrtf(wave_sum(s) * (1.f / D) + EPS);
    unsigned long long* o8 = (unsigned long long*)orow + lane;
#pragma unroll
    for (int j = 0; j < 4; ++j) { const f32x4 ww = ((const f32x4*)w)[64 * j + lane];
        const unsigned lo = f2bf(v[j].x * rstd * ww.x) | (f2bf(v[j].y * rstd * ww.y) << 16), hi = f2bf(v[j].z * rstd * ww.z) | (f2bf(v[j].w * rstd * ww.w) << 16);
        o8[64 * j] = (unsigned long long)lo | ((unsigned long long)hi << 32); }
}

__device__ __forceinline__ void final_row(float* __restrict__ out, const bf16_t* __restrict__ XB, const unsigned char* __restrict__ YP, const LAS int* tb, const int* slot, const float* __restrict__ lgate, const float* __restrict__ w, int t, int lane) {
    int rows[4]; float gk[4];
#pragma unroll
    for (int k = 0; k < 4; ++k) { const int sl = slot[t * 4 + k]; rows[k] = tb[sl >> 16] + (sl & 0xffff); gk[k] = lgate[(size_t)(sl >> 16) * TC + (sl & 0xffff)] * (1.0f / FP8_SY); }
    float v[16];
    { const u32x4 a0 = *(const u32x4*)(XB + (size_t)t * D + 16 * lane), a1 = *(const u32x4*)(XB + (size_t)t * D + 16 * lane + 8);
#pragma unroll
      for (int e = 0; e < 4; ++e) { v[2 * e] = __uint_as_float(a0[e] << 16); v[2 * e + 1] = __uint_as_float(a0[e] & 0xffff0000u); v[8 + 2 * e] = __uint_as_float(a1[e] << 16); v[8 + 2 * e + 1] = __uint_as_float(a1[e] & 0xffff0000u); } }
    float y[16];
#pragma unroll
    for (int e = 0; e < 16; ++e) y[e] = 0.f;
#pragma unroll
    for (int k = 0; k < 4; ++k) { const u32x4 q = *(const u32x4*)(YP + (size_t)rows[k] * D + 16 * lane);
#pragma unroll
        for (int e = 0; e < 4; ++e) { y[4 * e] += gk[k] * __builtin_amdgcn_cvt_f32_fp8(q[e], 0); y[4 * e + 1] += gk[k] * __builtin_amdgcn_cvt_f32_fp8(q[e], 1); y[4 * e + 2] += gk[k] * __builtin_amdgcn_cvt_f32_fp8(q[e], 2); y[4 * e + 3] += gk[k] * __builtin_amdgcn_cvt_f32_fp8(q[e], 3); } }
    float s = 0.f;
#pragma unroll
    for (int e = 0; e < 16; ++e) { v[e] += y[e]; s += v[e] * v[e]; }
    const float rstd = 1.0f / sqrtf(wave_sum(s) * (1.f / D) + EPS);
    float* op = out + (size_t)t * D + 16 * lane; const float* wp = w + 16 * lane;
#pragma unroll
    for (int e = 0; e < 4; ++e) { const f32x4 ww = *(const f32x4*)(wp + 4 * e); *(f32x4*)(op + 4 * e) = (f32x4){v[4 * e] * rstd * ww.x, v[4 * e + 1] * rstd * ww.y, v[4 * e + 2] * rstd * ww.z, v[4 * e + 3] * rstd * ww.w}; }
}

typedef const MArgs __attribute__((address_space(4)))* KArgP;
__device__ __forceinline__ KArgP kargs() { KArgP p = (KArgP)__builtin_amdgcn_kernarg_segment_ptr(); asm volatile("" : "+s"(p)); return p; }
#define WSP(T_, off) ((T_*)(ws + (off)))
__global__ __launch_bounds__(NTHREADS, 2) void mega_fwd(MArgs a_unused) {
    extern __shared__ __attribute__((aligned(16))) unsigned char lds_raw[];
    LAS unsigned char* lds = (LAS unsigned char*)lds_raw;
    const int G = gridDim.x, bid = blockIdx.x, gsz = G * NTHREADS, ngw = G * NWAVES;
    if (threadIdx.x < 16) ((LAS unsigned*)(lds + XB_LDS))[threadIdx.x] = 0u;
    __syncthreads();
    (void)xcd_barrier_post((unsigned*)(kargs()->ws + WS_BAR), (volatile LAS unsigned*)(lds + XB_LDS));
#define GRID_SYNC() do { XcdBarrier xb_; xb_.bar = (unsigned*)(kargs()->ws + WS_BAR); xb_.x = xb_xcc_id(); xb_.st = (volatile LAS unsigned*)(lds + XB_LDS); xcd_barrier(xb_); } while (0)
#define PHASE_IDX() const int tid = otid(), lane = tid & 63, wid = __builtin_amdgcn_readfirstlane(tid >> 6), gtid = bid * NTHREADS + tid, gw = bid * NWAVES + wid; (void)lane; (void)gtid; (void)gw

    {
        PHASE_IDX(); KArgP a = kargs(); unsigned char* ws = a->ws; int* cnt = WSP(int, WS_CTL); float* rope = WSP(float, WS_ROPE); bf16_t* Win_t = WSP(bf16_t, WS_WIN); bf16_t* Wo_t = WSP(bf16_t, WS_WO); bf16_t* Wd_t = WSP(bf16_t, WS_WD); bf16_t* Wgu_t = WSP(bf16_t, WS_WGU); bf16_t* XN = WSP(bf16_t, WS_XN);
        if (gtid < NCHUNK * 32) cnt[gtid] = 0;
        LAS float* scr = (LAS float*)(lds + wid * 8448);
        constexpr int I_IN = (D / 64) * (INW / 32), I_WO = (512 / 64) * (D / 32), I_GU = (D / 64) * (2048 / 32), I_DN = (FF / 64) * (D / 32);
        constexpr int NITEMS = I_IN + I_WO + NE * I_GU + NE * I_DN;
        for (int it = gw; it < NITEMS; it += ngw) {
            int r = it;
            if (r < I_IN) { p0_transpose_item<2>(a->w_in, INW, Win_t, D, scr, r, lane, a->attn_norm_w); continue; } r -= I_IN;
            if (r < I_WO) { p0_transpose_item<0>(a->w_out, D, Wo_t, D, scr, r, lane, nullptr); continue; } r -= I_WO;
            if (r < NE * I_GU) { const int e = r / I_GU; p0_transpose_item_fp8<1>(a->w_gu + (size_t)e * D * 2048, 2048, (unsigned char*)Wgu_t + (size_t)e * 2048 * D, D, scr, r % I_GU, lane, a->ffn_norm_w, FP8_SW); continue; } r -= NE * I_GU;
            { const int e = r / I_DN; p0_transpose_item_fp8<0>(a->w_down + (size_t)e * FF * D, D, (unsigned char*)Wd_t + (size_t)e * D * FF, FF, scr, r % I_DN, lane, nullptr, FP8_SW); }
        }
        for (int idx = gtid; idx < 512 * 1024; idx += gsz) {
            const int n = idx & 1023, gc = idx >> 10, g = gc >> 7; float acc = 0.f;
            for (int d = 0; d < 128; ++d) acc += a->pool_w[(size_t)gc * 128 + d] * a->pool_scale[g * 128 + d] * a->w_out[(size_t)(512 + g * 128 + d) * 1024 + n];
            Wo_t[(size_t)n * 1024 + 512 + gc] = (bf16_t)f2bf(acc);
        }
        for (int idx = gtid; idx < T * 8; idx += gsz) {
            const int t = idx >> 3, j = idx & 7;
            const double inv = exp(-(double)(2 * j) / 16.0 * log(500000.0)); const double ang = (double)a->positions[t] * inv;
            rope[(size_t)t * 16 + j] = (float)cos(ang); rope[(size_t)t * 16 + 8 + j] = (float)sin(ang);
        }
        for (int row = gw; row < T; row += ngw) xbf_row(a->x + (size_t)row * D, XN + (size_t)row * D, WSP(float, WS_RSTD) + row, lane);
    }
    GRID_SYNC();
    { PHASE_IDX(); KArgP a = kargs(); unsigned char* ws = a->ws; bf16_t* Win_t = WSP(bf16_t, WS_WIN); bf16_t* XN = WSP(bf16_t, WS_XN); bf16_t* PROJ = WSP(bf16_t, WS_PROJ); const float* rope = WSP(float, WS_ROPE);
      pg8::DensePlan S; S.init(T, INW, G, bid); pg8::EpiBf16 E{PROJ, INW, rope, 4, WSP(float, WS_RSTD)}; pg8::gemm_phase<2048, false>(lds, XN, Win_t, S, E); }
    GRID_SYNC();
    {
        PHASE_IDX(); KArgP a = kargs(); unsigned char* ws = a->ws; bf16_t* PROJ = WSP(bf16_t, WS_PROJ); bf16_t* CAT = WSP(bf16_t, WS_CAT);
        const float lam = expf(wave_sum(a->lq1[lane] * a->lk1[lane])) - expf(wave_sum(a->lq2[lane] * a->lk2[lane])) + 0.2f;
        dattn::phase((char*)lds_raw, PROJ, CAT, lam, a->subln_w, G, bid);
        for (int item = gtid; item < (T / 32) * 64; item += gsz) {
            const int chunk = item & 63, tb = item >> 6, c0 = chunk * 8, w = 2 << (c0 >> 7), t0 = tb * 32, s0 = t0 % SEQ;
            const bf16_t* up = PROJ + (size_t)t0 * INW + 1536 + c0; bf16_t* op = CAT + (size_t)t0 * D + 512 + c0;
            float sum[8];
#pragma unroll
            for (int e = 0; e < 8; ++e) sum[e] = 0.f;
            if (s0 > 0) for (int i = 1; i < w; ++i) { const u32x4 v = *(const u32x4*)(up - (size_t)i * INW);
#pragma unroll
                for (int e = 0; e < 4; ++e) { sum[2 * e] += __uint_as_float(v[e] << 16); sum[2 * e + 1] += __uint_as_float(v[e] & 0xffff0000u); } }
            for (int tt = 0; tt < 32; ++tt) {
                const u32x4 v = *(const u32x4*)(up + (size_t)tt * INW); float f[8];
#pragma unroll
                for (int e = 0; e < 4; ++e) { f[2 * e] = __uint_as_float(v[e] << 16); f[2 * e + 1] = __uint_as_float(v[e] & 0xffff0000u); }
                const int s = s0 + tt; const float rn = 1.0f / (float)((s + 1 < w) ? s + 1 : w);
                u32x4 o;
#pragma unroll
                for (int e = 0; e < 4; ++e) { sum[2 * e] += f[2 * e]; sum[2 * e + 1] += f[2 * e + 1]; o[e] = pg8::cvt_pk_bf16(sum[2 * e] * rn - f[2 * e], sum[2 * e + 1] * rn - f[2 * e + 1]); }
                *(u32x4*)(op + (size_t)tt * D) = o;
                if (s + 1 >= w) { const u32x4 ov = *(const u32x4*)(up + (size_t)(tt - w + 1) * INW);
#pragma unroll
                    for (int e = 0; e < 4; ++e) { sum[2 * e] -= __uint_as_float(ov[e] << 16); sum[2 * e + 1] -= __uint_as_float(ov[e] & 0xffff0000u); } }
            }
        }
    }
    GRID_SYNC();
    { PHASE_IDX(); KArgP a = kargs(); unsigned char* ws = a->ws; bf16_t* Wo_t = WSP(bf16_t, WS_WO); bf16_t* CAT = WSP(bf16_t, WS_CAT);
      pg8::DensePlan S; S.init(T, D, G, bid); pg8::EpiResBf16 E{WSP(bf16_t, WS_XB), WSP(bf16_t, WS_XN), D}; pg8::gemm_phase<2048, false>(lds, CAT, Wo_t, S, E); }
    GRID_SYNC();
    { PHASE_IDX(); KArgP a = kargs(); unsigned char* ws = a->ws;
      rtr::phase(lds, WSP(bf16_t, WS_XB), a->ffn_norm_w, a->router_w, a->router_b, WSP(int, WS_CTL), WSP(int, WS_LTOK), WSP(float, WS_LGATE), WSP(int, WS_SLOT), WSP(unsigned char, WS_XN), G, bid); }
    GRID_SYNC();
    for (int ch = 0; ch < NCHUNK; ++ch) {
        PHASE_IDX(); KArgP a = kargs(); unsigned char* ws = a->ws; int* cnt = WSP(int, WS_CTL); int* ltok = WSP(int, WS_LTOK); float* lgate = WSP(float, WS_LGATE); int* slot = WSP(int, WS_SLOT); bf16_t* Wd_t = WSP(bf16_t, WS_WD); bf16_t* Wgu_t = WSP(bf16_t, WS_WGU); bf16_t* XN = WSP(bf16_t, WS_XN); bf16_t* HM = WSP(bf16_t, WS_HM); bf16_t* YP = WSP(bf16_t, WS_YP); float* out = a->out;
        const int* cc = cnt + ch * 32; const int* lt = ltok + (size_t)ch * 32 * TC; const float* lg = lgate + (size_t)ch * 32 * TC;
        { pg8::MoePlan<true> S = pg8::moe_plan_setup<true>(lds + pg8::STAGE_BYTES, cc, lt, 8, G, bid); pg8::EpiGLU E{HM, a->b_gu, 8}; pg8::gemm_phase<1024, true>(lds, XN, Wgu_t, S, E); }
        GRID_SYNC();
        { pg8::MoePlan<false> S = pg8::moe_plan_setup<false>(lds + pg8::STAGE_BYTES, cc, lt, 4, G, bid); pg8::EpiDown E{YP, a->b_down, 4}; pg8::gemm_phase<1024, true>(lds, HM, Wd_t, S, E); }
        GRID_SYNC();
        { LAS int* tb = (LAS int*)(lds + pg8::STAGE_BYTES);
          if (tid < 64) { int v = (lane < 32) ? (__hip_atomic_load(cc + (lane & 31), __ATOMIC_RELAXED, __HIP_MEMORY_SCOPE_AGENT) + TM - 1) / TM : 0, incl = v;
#pragma unroll
              for (int o = 1; o < 32; o <<= 1) { const int up = __shfl_up(incl, o); if (lane >= o) incl += up; }
              if (lane < 32) tb[lane] = (incl - v) * TM; }
          __syncthreads();
          for (int t = ch * TC + gw; t < (ch + 1) * TC; t += ngw) final_row(out, WSP(bf16_t, WS_XB), (const unsigned char*)YP, tb, slot, lg, a->final_w, t, lane);
          __syncthreads(); }
    }
}

extern "C" void kernel_launch(void* const* d_in, const int* in_sizes, int n_in, void* d_out, int out_size, void* d_ws, size_t ws_size, hipStream_t stream) {
    if (n_in != 20 || in_sizes[0] != T * D || out_size != T * D || ws_size < WS_END) { fprintf(stderr, "kernel_launch: unexpected shapes / workspace (%d, %d, %d, %zu)\n", n_in, n_in > 0 ? in_sizes[0] : -1, out_size, ws_size); return; }
    static int grid_blocks = 0;
    if (!grid_blocks) {
        int dev = 0, cus = 0, per_cu = 0;
        (void)hipGetDevice(&dev); (void)hipDeviceGetAttribute(&cus, hipDeviceAttributeMultiprocessorCount, dev);
        (void)hipFuncSetAttribute((const void*)mega_fwd, hipFuncAttributeMaxDynamicSharedMemorySize, MK_LDS);
        (void)hipOccupancyMaxActiveBlocksPerMultiprocessor(&per_cu, (const void*)mega_fwd, NTHREADS, MK_LDS);
        if (per_cu < 1) { fprintf(stderr, "kernel_launch: occupancy query says %d blocks per CU\n", per_cu); per_cu = 1; }
        grid_blocks = cus * 1;
        if (grid_blocks % 8 != 0) grid_blocks -= grid_blocks % 8;
    }
    (void)hipMemsetAsync((char*)d_ws + WS_BAR, 0, XCD_BAR_WORDS * 4, stream);
    MArgs a{};
    a.x = (const float*)d_in[0]; a.positions = (const int*)d_in[1]; a.attn_norm_w = (const float*)d_in[2]; a.w_in = (const float*)d_in[3];
    a.lq1 = (const float*)d_in[4]; a.lk1 = (const float*)d_in[5]; a.lq2 = (const float*)d_in[6]; a.lk2 = (const float*)d_in[7];
    a.subln_w = (const float*)d_in[8]; a.pool_w = (const float*)d_in[9]; a.pool_scale = (const float*)d_in[10]; a.w_out = (const float*)d_in[11];
    a.ffn_norm_w = (const float*)d_in[12]; a.router_w = (const float*)d_in[13]; a.router_b = (const float*)d_in[14];
    a.w_gu = (const float*)d_in[15]; a.b_gu = (const float*)d_in[16]; a.w_down = (const float*)d_in[17]; a.b_down = (const float*)d_in[18]; a.final_w = (const float*)d_in[19];
    a.out = (float*)d_out; a.ws = (unsigned char*)d_ws;
    void* args[] = {&a};
    hipError_t e = hipLaunchCooperativeKernel((const void*)mega_fwd, dim3(grid_blocks), dim3(NTHREADS), args, MK_LDS, stream);
    if (e != hipSuccess) fprintf(stderr, "cooperative launch failed: %s (grid %d)\n", hipGetErrorString(e), grid_blocks);
}
```

```cpp
#include <hip/hip_runtime.h>
#include <cstdint>
#include <cstdio>

typedef unsigned short bf16_t;
typedef short bf16x8 __attribute__((ext_vector_type(8)));
typedef float f32x4 __attribute__((ext_vector_type(4)));
typedef unsigned u32x4 __attribute__((ext_vector_type(4)));

constexpr int T = 65536, D = 1024, SEQ = 2048, INW = 2048, NE = 32, FF = 1024, TOPK = 4;
constexpr int NCHUNK = 1, TC = T / NCHUNK;
constexpr int TM = 256;
constexpr int PC = TC * TOPK + NE * TM;
constexpr float EPS = 1e-5f;

constexpr size_t MiB = 1u << 20;
constexpr size_t WS_CTL = 0;
constexpr size_t WS_RSTD = 524288;
constexpr size_t WS_BAR = 65536;
constexpr size_t WS_LTOK = 1 * MiB;
constexpr size_t WS_LGATE = 9 * MiB;
constexpr size_t WS_SLOT = 17 * MiB;
constexpr size_t WS_ROPE = 18 * MiB;
constexpr size_t WS_WIN = 22 * MiB;
constexpr size_t WS_WO = 26 * MiB;
constexpr size_t WS_WD = 28 * MiB;
constexpr size_t WS_WGU = 92 * MiB;
constexpr size_t WS_XN = 220 * MiB;
constexpr size_t WS_PROJ = 348 * MiB;
constexpr size_t WS_CAT = 604 * MiB;
constexpr size_t WS_HM = 348 * MiB;
constexpr size_t WS_YP = 612 * MiB;
constexpr size_t WS_XB = 876 * MiB;
constexpr size_t WS_END = 1004 * MiB;
static_assert(WS_HM + (size_t)PC * 1024 <= WS_YP && WS_YP + (size_t)PC * 1024 <= WS_XB && WS_XB + (size_t)T * 1024 * 2 <= WS_END && WS_CAT + (size_t)T * 1024 * 2 <= WS_XB, "ws map");

__device__ __forceinline__ int otid() { int t = threadIdx.x; asm volatile("" : "+v"(t)); return t; }
__device__ __forceinline__ unsigned f2bf(float f) { unsigned u = __float_as_uint(f); return (u + 0x7fffu + ((u >> 16) & 1u)) >> 16; }
__device__ __forceinline__ unsigned pk4_fp8(float a, float b, float c, float d) {
    a = fminf(fmaxf(a, -448.f), 448.f); b = fminf(fmaxf(b, -448.f), 448.f); c = fminf(fmaxf(c, -448.f), 448.f); d = fminf(fmaxf(d, -448.f), 448.f);
    unsigned w = 0; w = __builtin_amdgcn_cvt_pk_fp8_f32(a, b, w, false); w = __builtin_amdgcn_cvt_pk_fp8_f32(c, d, w, true); return w; }
constexpr float FP8_SX = 16.f, FP8_SW = 512.f, FP8_SH = 4.f, FP8_SY = 32.f;
__device__ __forceinline__ float bf2f(unsigned h) { return __uint_as_float(h << 16); }
__device__ __forceinline__ float wave_sum(float v) {
#pragma unroll
    for (int o = 1; o < 64; o <<= 1) v += __shfl_xor(v, o);
    return v;
}
__device__ __forceinline__ float wave_max(float v) {
#pragma unroll
    for (int o = 1; o < 64; o <<= 1) v = fmaxf(v, __shfl_xor(v, o));
    return v;
}

namespace pg8 {
#define PG8_LAS __attribute__((address_space(3)))
constexpr int BM = 256, BK = 64, HALF = 128, HTB = HALF * BK * 2  , STAGE_BYTES = 8 * HTB;
constexpr int MAXU = 36, PLAN_BYTES = MAXU * 32 + MAXU * 512, EPI_LDS = STAGE_BYTES + PLAN_BYTES + 64;
__host__ __device__ __forceinline__ int lds_byte(int r, int c) { return r * 128 + ((((c >> 3) ^ ((r >> 1) & 7))) << 4); }
__host__ __device__ __forceinline__ void stage_rc(int b, int& R, int& C) { R = b >> 7; C = ((((b >> 4) & 7) ^ ((R >> 1) & 7))) << 3; }
__host__ __device__ __forceinline__ int perm32(int rho) { const int n = rho >> 4, i = rho & 15; return 8 * (i >> 2) + 4 * n + (i & 3); }
__device__ __forceinline__ unsigned cvt_pk_bf16(float lo, float hi) { unsigned r; asm volatile("v_cvt_pk_bf16_f32 %0, %1, %2" : "=v"(r) : "v"(lo), "v"(hi)); return r; }

template <int IMM = 0>
__device__ __forceinline__ void glds16s(const void* sbase, unsigned voff, unsigned lds_dst) { unsigned keep;
    asm volatile("s_mov_b32 %0, m0\n\ts_mov_b32 m0, %3\n\ts_nop 0\n\tglobal_load_lds_dwordx4 %1, %2 offset:%4\n\ts_mov_b32 m0, %0" : "=&s"(keep) : "v"(voff), "s"(sbase), "s"(lds_dst), "i"(IMM) : "memory"); }
typedef int v4i_t __attribute__((ext_vector_type(4)));
typedef int v8i_t __attribute__((ext_vector_type(8)));
__device__ __forceinline__ v8i_t cat8(bf16x8 lo, bf16x8 hi) { return __builtin_shufflevector(__builtin_bit_cast(v4i_t, lo), __builtin_bit_cast(v4i_t, hi), 0, 1, 2, 3, 4, 5, 6, 7); }
__device__ __forceinline__ void mfma_fp8_inplace(f32x4& acc, v8i_t a, v8i_t b) {
    asm volatile("v_mfma_scale_f32_16x16x128_f8f6f4 %0, %1, %2, %0, %3, %3 op_sel_hi:[0,0,0]" : "+v"(acc) : "v"(a), "v"(b), "v"(0x7F7F7F7F)); }
struct Unit { int pm, pn, e, lt, ne; };

template <int ROWB, bool FP8, class Epi, class Plan>
__device__ __forceinline__ void gemm_phase(PG8_LAS unsigned char* lds, const bf16_t* gA_, const bf16_t* gBt_, const Plan& S, const Epi& E) {
    const int tid = otid(), wid = __builtin_amdgcn_readfirstlane(tid >> 6), lane = tid & 63, wr = wid >> 2, wc = wid & 3, fr = lane & 15, fq = lane >> 4;
    constexpr int nt = ROWB / 128;
    unsigned voffB[2];
#pragma unroll
    for (int i = 0; i < 2; ++i) { int R, C; stage_rc(tid * 16 + i * 8192, R, C); const int Rb = Epi::PERM ? ((R & ~31) + perm32(R & 31)) : R; voffB[i] = (unsigned)(Rb * ROWB + C * 2); }
    const size_t kstep = (size_t)(BK * 2);
    const size_t hstep = (size_t)HALF * ROWB;
    const size_t tstep = 2 * hstep;
    const unsigned ldsb_epi0 = (unsigned)__builtin_amdgcn_readfirstlane((unsigned)(__UINTPTR_TYPE__)lds + (unsigned)EPI_LDS);
    const unsigned ldsb = (unsigned)__builtin_amdgcn_readfirstlane((unsigned)(__UINTPTR_TYPE__)lds + (unsigned)wid * 1024u);
    const int aoff0 = lds_byte(wr * 64 + fr, fq * 8), aoff1 = lds_byte(wr * 64 + fr, 32 + fq * 8), boff0 = lds_byte(wc * 32 + fr, fq * 8), boff1 = lds_byte(wc * 32 + fr, 32 + fq * 8);
#define PG8_SA(b, h) (((b) * 2 + (h)) * HTB)
#define PG8_SB(b, h) ((4 + (b) * 2 + (h)) * HTB)
#define PG8_STAGE(bufoff, gbase, voff) do { _Pragma("unroll") for (int _i = 0; _i < 2; ++_i) glds16s<0>((gbase), (voff)[_i], ldsb + (unsigned)((bufoff) + _i * 8192)); } while (0)
#define PG8_STAGEK(bufoff, gbase, voff) do { _Pragma("unroll") for (int _i = 0; _i < 2; ++_i) glds16s<BK * 2>((gbase), (voff)[_i], ldsb + (unsigned)((bufoff) + _i * 8192)); } while (0)
#define PG8_LDA(dst, b, h) do { _Pragma("unroll") for (int m = 0; m < 4; ++m) { \
        if constexpr (FP8) dst##8[m] = cat8(*(const PG8_LAS bf16x8*)(lds + PG8_SA(b, h) + aoff0 + m * 2048), *(const PG8_LAS bf16x8*)(lds + PG8_SA(b, h) + aoff1 + m * 2048)); \
        else { dst[m][0] = *(const PG8_LAS bf16x8*)(lds + PG8_SA(b, h) + aoff0 + m * 2048); dst[m][1] = *(const PG8_LAS bf16x8*)(lds + PG8_SA(b, h) + aoff1 + m * 2048); } } } while (0)
#define PG8_LDB(dst, b, h) do { _Pragma("unroll") for (int n = 0; n < 2; ++n) { \
        if constexpr (FP8) dst##8[n] = cat8(*(const PG8_LAS bf16x8*)(lds + PG8_SB(b, h) + boff0 + n * 2048), *(const PG8_LAS bf16x8*)(lds + PG8_SB(b, h) + boff1 + n * 2048)); \
        else { dst[n][0] = *(const PG8_LAS bf16x8*)(lds + PG8_SB(b, h) + boff0 + n * 2048); dst[n][1] = *(const PG8_LAS bf16x8*)(lds + PG8_SB(b, h) + boff1 + n * 2048); } } } while (0)
#define PG8_MMA(ai, bj, At, Bt) do { __builtin_amdgcn_s_setprio(1); _Pragma("unroll") for (int m = 0; m < 4; ++m) _Pragma("unroll") for (int n = 0; n < 2; ++n) { \
        if constexpr (FP8) mfma_fp8_inplace(acc[ai][bj][m][n], Bt##8[n], At##8[m]); \
        else { _Pragma("unroll") for (int k = 0; k < 2; ++k) acc[ai][bj][m][n] = __builtin_amdgcn_mfma_f32_16x16x32_bf16(Bt[n][k], At[m][k], acc[ai][bj][m][n], 0, 0, 0); } } \
        __builtin_amdgcn_s_setprio(0); } while (0)
#define PG8_WAIT_V(n) asm volatile("s_waitcnt vmcnt(" #n ")" ::: "memory")
#define PG8_WAIT_L(n) asm volatile("s_waitcnt lgkmcnt(" #n ")" ::: "memory")
#define PG8_BAR __builtin_amdgcn_s_barrier()
#define PG8_SCHED __builtin_amdgcn_sched_barrier(0)
#define PG8_VOFF(dst, U, UI) do { const int _tv = otid(); _Pragma("unroll") for (int _i = 0; _i < 2; ++_i) { int _R, _C; stage_rc(_tv * 16 + _i * 8192, _R, _C); \
        _Pragma("unroll") for (int _h = 0; _h < 2; ++_h) dst[_h][_i] = S.rowA(U, UI, _h * HALF + _R) * (unsigned)ROWB + (unsigned)(_C * 2); } } while (0)
#define PG8_SP1A(A1) do { \
          \
        PG8_LDB(B0, 0, 0); PG8_LDB(B1, 0, 1); PG8_SCHED; PG8_LDA(At, 0, 0); PG8_STAGE(PG8_SA(1, 1), (A1), vc[1]); \
        PG8_WAIT_V(8); PG8_WAIT_L(0); PG8_BAR; PG8_MMA(0, 0, At, B0); PG8_MMA(0, 1, At, B1); PG8_BAR; PG8_SCHED; } while (0)
#define PG8_REST(A2, B2) do { \
          \
        PG8_LDA(At, 0, 1); PG8_STAGE(PG8_SB(0, 0), (B2), voffB); PG8_STAGE(PG8_SB(0, 1), (B2) + hstep, voffB); PG8_STAGE(PG8_SA(0, 0), (A2), vc[0]); \
        PG8_WAIT_V(8); PG8_WAIT_L(0); PG8_BAR; PG8_MMA(1, 0, At, B0); PG8_MMA(1, 1, At, B1); PG8_BAR; PG8_SCHED; \
          \
        PG8_LDB(B0, 1, 0); PG8_LDB(B1, 1, 1); PG8_SCHED; PG8_LDA(At, 1, 0); PG8_STAGE(PG8_SA(0, 1), (A2), vc[1]); \
        PG8_WAIT_V(8); PG8_WAIT_L(0); PG8_BAR; PG8_MMA(0, 0, At, B0); PG8_MMA(0, 1, At, B1); PG8_BAR; PG8_SCHED; \
          \
        PG8_LDA(At, 1, 1); PG8_STAGE(PG8_SB(1, 0), (B2) + kstep, voffB); PG8_STAGE(PG8_SB(1, 1), (B2) + kstep + hstep, voffB); PG8_STAGE(PG8_SA(1, 0), (A2) + kstep, vc[0]); \
        PG8_WAIT_V(8); PG8_WAIT_L(0); PG8_BAR; PG8_MMA(1, 0, At, B0); PG8_MMA(1, 1, At, B1); PG8_BAR; PG8_SCHED; } while (0)
    Unit cur, nxt; int ui = 0;
    if (!S.next(0, cur)) return;
    f32x4 acc[2][2][4][2];
#pragma unroll
    for (int a = 0; a < 2; ++a)
#pragma unroll
        for (int b = 0; b < 2; ++b)
#pragma unroll
            for (int m = 0; m < 4; ++m)
#pragma unroll
                for (int n = 0; n < 2; ++n) acc[a][b][m][n] = (f32x4){0.f, 0.f, 0.f, 0.f};
    bf16x8 At[4][2], B0[2][2], B1[2][2]; v8i_t At8[4], B08[2], B18[2];
    unsigned vc[2][2];
    PG8_VOFF(vc, cur, 0);
    if (wid == 0) E.prefetch(cur, ldsb_epi0, lane);
    const char* gA = (const char*)gA_; const char* cB = (const char*)gBt_ + (size_t)cur.pn * tstep;
    PG8_STAGE(PG8_SB(0, 0), cB, voffB); PG8_STAGE(PG8_SB(0, 1), cB + hstep, voffB); PG8_STAGE(PG8_SA(0, 0), gA, vc[0]); PG8_STAGE(PG8_SA(0, 1), gA, vc[1]);
    if (wr == 1) PG8_BAR;
    PG8_WAIT_V(2); PG8_BAR;
    PG8_STAGE(PG8_SB(1, 0), cB + kstep, voffB); PG8_STAGE(PG8_SA(1, 0), gA + kstep, vc[0]); PG8_STAGE(PG8_SB(1, 1), cB + hstep + kstep, voffB);
    PG8_WAIT_V(6); PG8_BAR;
    for (;;) {
        const bool has_next = S.next(ui + 1, nxt);
        const char* nB = has_next ? (const char*)gBt_ + (size_t)nxt.pn * tstep : cB;
#pragma clang loop unroll(disable)
        for (int t = 0; t < nt - 2; t += 2) { PG8_SP1A(gA + (size_t)(t + 1) * kstep); PG8_REST(gA + (size_t)(t + 2) * kstep, cB + (size_t)(t + 2) * kstep); }
        PG8_SP1A(gA + (size_t)(nt - 1) * kstep);
        if (has_next) PG8_VOFF(vc, nxt, ui + 1);
        PG8_REST(gA, nB);
        if constexpr (FP8) {
            asm volatile("s_nop 15\n\ts_nop 15" ::: "memory");
#pragma unroll
            for (int a = 0; a < 2; ++a)
#pragma unroll
                for (int b = 0; b < 2; ++b)
#pragma unroll
                    for (int m = 0; m < 4; ++m)
#pragma unroll
                        for (int n = 0; n < 2; ++n) asm volatile("" : "+v"(acc[a][b][m][n]));
        }
        if (wr == 0) PG8_BAR;
        E(acc, cur, lds + EPI_LDS + (ui & 1) * 1024);
        if (!has_next) break;
#pragma unroll
        for (int a = 0; a < 2; ++a)
#pragma unroll
            for (int b = 0; b < 2; ++b)
#pragma unroll
                for (int m = 0; m < 4; ++m)
#pragma unroll
                    for (int n = 0; n < 2; ++n) acc[a][b][m][n] = (f32x4){0.f, 0.f, 0.f, 0.f};
        cur = nxt; cB = nB; ++ui;
        if (wid == 0) E.prefetch(cur, ldsb_epi0 + (unsigned)((ui & 1) * 1024), lane);
        if (wr == 1) PG8_BAR;
    }
    PG8_WAIT_V(0);
    PG8_BAR;
#undef PG8_SA
#undef PG8_SB
#undef PG8_STAGE
#undef PG8_STAGEK
#undef PG8_LDA
#undef PG8_LDB
#undef PG8_MMA
#undef PG8_WAIT_V
#undef PG8_WAIT_L
#undef PG8_BAR
#undef PG8_SCHED
#undef PG8_VOFF
#undef PG8_SP1A
#undef PG8_REST
}

struct DensePlan {
    int nM, nN, nwg, G, c;
    __device__ void init(int M, int N, int G_, int c_) { nM = M / BM; nN = N / BM; nwg = nM * nN; G = G_; c = c_; }
    __device__ __forceinline__ bool next(int i, Unit& u) const {
        const long L = (long)i * G + c; if (L >= nwg) return false;
        int wgid = (int)L; { const int q = nwg / 8, r = nwg % 8, xcd = wgid % 8, off = wgid / 8; wgid = (xcd < r ? xcd * (q + 1) : r * (q + 1) + (xcd - r) * q) + off; }
        const int nig = 8 * nN, gid = wgid / nig, fm = gid * 8, gsz = (nM - fm) < 8 ? (nM - fm) : 8;
        u.pm = fm + ((wgid % nig) % gsz); u.pn = (wgid % nig) / gsz; u.e = 0; u.lt = 0; u.ne = 0; return true;
    }
    __device__ __forceinline__ unsigned rowA(const Unit& u, int, int r) const { return (unsigned)(u.pm * BM + r); }
};
template <bool GATHER>
struct MoePlan {
    const PG8_LAS int* desc; const PG8_LAS unsigned short* rowtab;
    __device__ __forceinline__ bool next(int i, Unit& u) const {
        if (i >= MAXU) return false;
        const PG8_LAS int* d = desc + i * 8;
        const int v = __builtin_amdgcn_readfirstlane(d[0]); u.pm = __builtin_amdgcn_readfirstlane(d[1]); u.pn = __builtin_amdgcn_readfirstlane(d[2]);
        u.e = __builtin_amdgcn_readfirstlane(d[3]); u.lt = __builtin_amdgcn_readfirstlane(d[4]); u.ne = __builtin_amdgcn_readfirstlane(d[5]); return v != 0;
    }
    __device__ __forceinline__ unsigned rowA(const Unit& u, int ui, int r) const { return GATHER ? (unsigned)rowtab[ui * 256 + r] : (unsigned)(u.pm * BM + r); }
};
template <bool GATHER>
__device__ __forceinline__ MoePlan<GATHER> moe_plan_setup(PG8_LAS unsigned char* tab, const int* cnt, const int* ltok, int NT, int G, int c) {
    PG8_LAS int* desc = (PG8_LAS int*)tab; PG8_LAS unsigned short* rowtab = (PG8_LAS unsigned short*)(tab + MAXU * 32);
    PG8_LAS int* cs = (PG8_LAS int*)rowtab;
    PG8_LAS int* bs = cs + 32;
    const int tid = otid(), xcd = c & 7, j = c >> 3;
    if (tid < 32) cs[tid] = __hip_atomic_load(cnt + tid, __ATOMIC_RELAXED, __HIP_MEMORY_SCOPE_AGENT);
    __syncthreads();
    if (tid < 64) { const int ln = tid & 63; int v = (ln < 32) ? (cs[ln & 31] + BM - 1) / BM : 0, incl = v;
#pragma unroll
        for (int o = 1; o < 32; o <<= 1) { const int up = __shfl_up(incl, o); if (ln >= o) incl += up; }
        if (ln < 32) bs[ln] = incl - v; if (ln == 31) bs[32] = incl; }
    __syncthreads();
    if (tid < MAXU) {
        const int q = tid * (G >> 3) + j, mt = (q / NT) * 8 + xcd, pnl = q % NT;
        int e = -1;
        for (int k = 0; k < 32; ++k) if (mt >= bs[k] && mt < bs[k + 1]) e = k;
        desc[tid * 8 + 0] = e >= 0 ? 1 : 0; desc[tid * 8 + 1] = mt; desc[tid * 8 + 2] = (e >= 0 ? e : 0) * NT + pnl; desc[tid * 8 + 3] = e;
        desc[tid * 8 + 4] = e >= 0 ? mt - bs[e] : 0; desc[tid * 8 + 5] = e >= 0 ? cs[e] : 0;
    }
    __syncthreads();
    if (GATHER && tid < 256) {
        for (int i = 0; i < MAXU; ++i) {
            const PG8_LAS int* d = desc + i * 8; const int valid = d[0], e = d[3], lt = d[4], ne = d[5];
            const int p = lt * BM + tid; rowtab[i * 256 + tid] = (unsigned short)((valid && p < ne) ? ltok[(size_t)e * TC + p] : 0);
        }
    }
    __syncthreads();
    MoePlan<GATHER> S; S.desc = desc; S.rowtab = rowtab; return S;
}

struct EpiBf16 {
    __device__ __forceinline__ void prefetch(const Unit& u, unsigned lds_dst, int lane) const { glds16s<0>(rstd + (size_t)u.pm * BM, (unsigned)(lane * 16), lds_dst); }
    static constexpr bool PERM = true;
    bf16_t* O; int ldc; const float* rope; int rope_tiles; const float* rstd;
    __device__ __forceinline__ void operator()(const f32x4 (&acc)[2][2][4][2], const Unit& u, const PG8_LAS unsigned char* el) const {
        const int tv_ = otid();
        const int wr = tv_ >> 8, wc = (tv_ >> 6) & 3, fr = tv_ & 15, fq = (tv_ >> 4) & 3;
        const int row0 = u.pm * BM + wr * 64 + fr, col0 = u.pn * BM + wc * 32 + 8 * fq;
        const bool rot = (u.pn < rope_tiles) && ((__builtin_amdgcn_readfirstlane(tv_ >> 6) & 1) == 0);
#pragma unroll
        for (int ai = 0; ai < 2; ++ai) {
            f32x4 rc[4][4];
            if (rot) {
#pragma unroll
                for (int m = 0; m < 4; ++m) { const float* rp = rope + (size_t)(row0 + ai * HALF + m * 16) * 16;
#pragma unroll
                    for (int q = 0; q < 4; ++q) rc[m][q] = *(const f32x4*)(rp + 4 * q); }
                asm volatile("" ::: "memory");
            }
#pragma unroll
            for (int m = 0; m < 4; ++m) { const int row = row0 + ai * HALF + m * 16; bf16_t* rowp = O + (size_t)row * ldc + col0;
                const float rsd = ((const PG8_LAS float*)el)[wr * 64 + fr + ai * HALF + m * 16];
                f32x4 cs0, cs1, sn0, sn1;
                if (rot) { cs0 = rc[m][0]; cs1 = rc[m][1]; sn0 = rc[m][2]; sn1 = rc[m][3];
                    if (fq == 0) { sn0 = -sn0; sn1 = -sn1; } }
#pragma unroll
                for (int bj = 0; bj < 2; ++bj) { f32x4 v0 = acc[ai][bj][m][0] * rsd, v1 = acc[ai][bj][m][1] * rsd;
                    if (rot) { f32x4 p0, p1;
#pragma unroll
                        for (int j = 0; j < 4; ++j) { p0[j] = __shfl_xor(v0[j], 16); p1[j] = __shfl_xor(v1[j], 16); }
                        if (fq < 2) { v0 = v0 * cs0 + p0 * sn0; v1 = v1 * cs1 + p1 * sn1; } }
                    u32x4 w; w.x = cvt_pk_bf16(v0[0], v0[1]); w.y = cvt_pk_bf16(v0[2], v0[3]); w.z = cvt_pk_bf16(v1[0], v1[1]); w.w = cvt_pk_bf16(v1[2], v1[3]);
                    *(u32x4*)(rowp + bj * HALF) = w; } }
        }
    }
};
struct EpiResBf16 {
    __device__ __forceinline__ void prefetch(const Unit&, unsigned, int) const {}
    static constexpr bool PERM = true;
    bf16_t* XB; const bf16_t* resid; int ldc;
    __device__ __forceinline__ void operator()(const f32x4 (&acc)[2][2][4][2], const Unit& u, const PG8_LAS unsigned char* el) const {
        const int tv_ = otid();
        const int wr = tv_ >> 8, wc = (tv_ >> 6) & 3, fr = tv_ & 15, fq = (tv_ >> 4) & 3;
        const int row0 = u.pm * BM + wr * 64 + fr, col0 = u.pn * BM + wc * 32 + 8 * fq;
        u32x4 xr[2][4][2];
#pragma unroll
        for (int ai = 0; ai < 2; ++ai)
#pragma unroll
            for (int m = 0; m < 4; ++m)
#pragma unroll
                for (int bj = 0; bj < 2; ++bj) xr[ai][m][bj] = *(const u32x4*)(resid + (size_t)(row0 + ai * HALF + m * 16) * ldc + col0 + bj * HALF);
        asm volatile("" ::: "memory");
#pragma unroll
        for (int ai = 0; ai < 2; ++ai)
#pragma unroll
            for (int m = 0; m < 4; ++m) { const size_t off = (size_t)(row0 + ai * HALF + m * 16) * ldc + col0;
#pragma unroll
                for (int bj = 0; bj < 2; ++bj) { const u32x4 x4 = xr[ai][m][bj];
                    const f32x4 v0 = (f32x4){__uint_as_float(x4.x << 16), __uint_as_float(x4.x & 0xffff0000u), __uint_as_float(x4.y << 16), __uint_as_float(x4.y & 0xffff0000u)} + acc[ai][bj][m][0],
                                v1 = (f32x4){__uint_as_float(x4.z << 16), __uint_as_float(x4.z & 0xffff0000u), __uint_as_float(x4.w << 16), __uint_as_float(x4.w & 0xffff0000u)} + acc[ai][bj][m][1];
                    u32x4 w; w.x = cvt_pk_bf16(v0[0], v0[1]); w.y = cvt_pk_bf16(v0[2], v0[3]); w.z = cvt_pk_bf16(v1[0], v1[1]); w.w = cvt_pk_bf16(v1[2], v1[3]);
                    *(u32x4*)(XB + off + bj * HALF) = w; } }
    }
};
struct EpiGLU {
    static constexpr bool PERM = true;
    bf16_t* HM; const float* b_gu; int NT;
    __device__ __forceinline__ void prefetch(const Unit& u, unsigned lds_dst, int lane) const {
        const int pnl = u.pn - u.e * NT; glds16s<0>(b_gu + (size_t)u.e * 2048 + pnl * HALF, (unsigned)((lane & 31) * 16 + (lane >> 5) * 4096), lds_dst); }
    __device__ __forceinline__ void operator()(const f32x4 (&acc)[2][2][4][2], const Unit& u, const PG8_LAS unsigned char* el) const {
        const int tv_ = otid();
        const int wr = tv_ >> 8, wc = (tv_ >> 6) & 3, fr = tv_ & 15, fq = (tv_ >> 4) & 3;
        const int pnl = u.pn - u.e * NT, f0 = pnl * HALF + wc * 32 + 8 * fq, row0 = u.pm * BM + wr * 64 + fr;
        const PG8_LAS float* bl = (const PG8_LAS float*)el + wc * 32 + 8 * fq;
        f32x4 bgt[2], bup[2];
#pragma unroll
        for (int n = 0; n < 2; ++n) { bgt[n] = *(const PG8_LAS f32x4*)(bl + 4 * n); bup[n] = *(const PG8_LAS f32x4*)(bl + 128 + 4 * n); }
        constexpr float rs = 1.0f / (FP8_SX * FP8_SW);
#pragma unroll
        for (int ai = 0; ai < 2; ++ai)
#pragma unroll
            for (int m = 0; m < 4; ++m) { float h[8];
#pragma unroll
                for (int n = 0; n < 2; ++n)
#pragma unroll
                    for (int j = 0; j < 4; ++j) { const float gv = fminf(acc[ai][0][m][n][j] * rs + bgt[n][j], 7.0f), uv = fminf(fmaxf(acc[ai][1][m][n][j] * rs + bup[n][j], -7.0f), 7.0f);
                        h[4 * n + j] = (uv + 1.0f) * gv * __builtin_amdgcn_rcpf(1.0f + __expf(-1.702f * gv)); }
                const unsigned long long w = (unsigned long long)pk4_fp8(h[0] * FP8_SH, h[1] * FP8_SH, h[2] * FP8_SH, h[3] * FP8_SH) | ((unsigned long long)pk4_fp8(h[4] * FP8_SH, h[5] * FP8_SH, h[6] * FP8_SH, h[7] * FP8_SH) << 32);
                *(unsigned long long*)((unsigned char*)HM + (size_t)(row0 + ai * HALF + m * 16) * FF + f0) = w; }
    }
};
struct EpiDown {
    static constexpr bool PERM = true;
    bf16_t* YP; const float* b_d; int NT;
    __device__ __forceinline__ void prefetch(const Unit& u, unsigned lds_dst, int lane) const {
        const int pnl = u.pn - u.e * NT; glds16s<0>(b_d + (size_t)u.e * 1024 + pnl * BM, (unsigned)(lane * 16), lds_dst); }
    __device__ __forceinline__ void operator()(const f32x4 (&acc)[2][2][4][2], const Unit& u, const PG8_LAS unsigned char* el) const {
        const int tv_ = otid();
        const int wr = tv_ >> 8, wc = (tv_ >> 6) & 3, fr = tv_ & 15, fq = (tv_ >> 4) & 3;
        const int pnl = u.pn - u.e * NT, col0 = pnl * BM + wc * 32 + 8 * fq, rl0 = wr * 64 + fr;
        const PG8_LAS float* bl = (const PG8_LAS float*)el + wc * 32 + 8 * fq;
        f32x4 bv[2][2];
#pragma unroll
        for (int bj = 0; bj < 2; ++bj)
#pragma unroll
            for (int n = 0; n < 2; ++n) bv[bj][n] = *(const PG8_LAS f32x4*)(bl + bj * HALF + 4 * n);
        constexpr float sa = FP8_SY / (FP8_SH * FP8_SW);
#pragma unroll
        for (int ai = 0; ai < 2; ++ai)
#pragma unroll
            for (int m = 0; m < 4; ++m) { const int rl = rl0 + ai * HALF + m * 16;
                unsigned char* rowp = (unsigned char*)YP + (size_t)(u.pm * BM + rl) * D + col0;
#pragma unroll
                for (int bj = 0; bj < 2; ++bj) { const f32x4 v0 = acc[ai][bj][m][0] * sa + bv[bj][0] * FP8_SY, v1 = acc[ai][bj][m][1] * sa + bv[bj][1] * FP8_SY;
                    *(unsigned long long*)(rowp + bj * HALF) = (unsigned long long)pk4_fp8(v0[0], v0[1], v0[2], v0[3]) | ((unsigned long long)pk4_fp8(v1[0], v1[1], v1[2], v1[3]) << 32); } }
    }
};
}


namespace dattn {
typedef float f32x16 __attribute__((ext_vector_type(16)));
typedef short s16x4 __attribute__((ext_vector_type(4)));
constexpr int NW = 8, QBLK = 32, KVBLK = 64, QB = NW * QBLK, DK = 64, DV = 128, RS = INW;
constexpr int SHM_V = KVBLK * DV * 2, SHM_K = KVBLK * DK * 2;
constexpr int NVB = 4;
constexpr int LDS_V = 0, LDS_K = NVB * SHM_V, LDS_WS = LDS_K + 2 * SHM_K, LDS_OST = LDS_WS + NW * 64 * 4, LDS_BYTES = LDS_OST + NW * 8192;
constexpr float SCALE = 0.125f, THR = 8.f;
#define KSWZ64(row, colB) ((row) * 128 + ((colB) ^ ((((row) >> 1) & 7) << 4)))
#define SBAR() __builtin_amdgcn_sched_barrier(0)
__device__ __forceinline__ int v_slot_key(int p) { const int kk = ((p >> 7) << 3) | ((p & 31) >> 2); return (kk & ~0xC) | ((kk & 4) << 1) | ((kk & 8) >> 1); }
__device__ __forceinline__ int v_slot_col(int p) { return ((p >> 5) & 3) * 32 + (p & 3) * 8; }
__device__ __forceinline__ int v_rd_base(int lane) { return ((lane & 3) << 3) | (((lane >> 2) & 3) << 6) | (((lane >> 4) & 1) << 5) | (((lane >> 5) & 1) << 8); }
constexpr int v_rd_off(int d0, int ks, int half) { return d0 * 512 + ks * 4096 + half * 2048; }
__device__ __forceinline__ int crow(int r, int hi) { return (r & 3) + 8 * (r >> 2) + 4 * hi; }
__device__ __forceinline__ unsigned cvtpk(float lo, float hi) { unsigned r; asm volatile("v_cvt_pk_bf16_f32 %0, %1, %2" : "=v"(r) : "v"(lo), "v"(hi)); return r; }
__device__ __forceinline__ bf16x8 load8(const bf16_t* p) { return *reinterpret_cast<const bf16x8*>(p); }
__device__ __forceinline__ void mask_tile(f32x16& p0, f32x16& p1, int dq) {
    const float NEG = -__builtin_inff();
#pragma unroll
    for (int r = 0; r < 16; ++r) { const int c = (r & 3) + 8 * (r >> 2); if (dq - c < 0) p0[r] = NEG; if (dq - c - 32 < 0) p1[r] = NEG; }
}
__device__ __forceinline__ void partialSM(f32x16& p0, f32x16& p1, float& m_reg, float& mn, float& alpha) {
    float pmax = p0[0];
#pragma unroll
    for (int r = 1; r < 16; ++r) pmax = fmaxf(pmax, p0[r]);
#pragma unroll
    for (int r = 0; r < 16; ++r) pmax = fmaxf(pmax, p1[r]);
    { auto rr = __builtin_amdgcn_permlane32_swap(__float_as_uint(pmax), __float_as_uint(pmax), false, false); pmax = fmaxf(__uint_as_float(rr[0]), __uint_as_float(rr[1])); }
    constexpr float C2 = 1.4426950408889634f * SCALE;
    if (__builtin_expect(__all((pmax - m_reg) * SCALE <= THR), 1)) { mn = m_reg; alpha = 1.f; }
    else { mn = fmaxf(m_reg, pmax); alpha = __builtin_amdgcn_exp2f((m_reg - mn) * C2); m_reg = mn; }
    const float mnL = -mn * C2;
#pragma unroll
    for (int r = 0; r < 16; ++r) p0[r] = fmaf(p0[r], C2, mnL);
#pragma unroll
    for (int r = 0; r < 16; ++r) p1[r] = fmaf(p1[r], C2, mnL);
#pragma unroll
    for (int r = 0; r < 16; ++r) p0[r] = __builtin_amdgcn_exp2f(p0[r]);
}
__device__ __forceinline__ void finishSM(f32x16& p0, f32x16& p1, float alpha, float& l_reg, bf16x8& pa0, bf16x8& pa1, bf16x8& pa2, bf16x8& pa3) {
#pragma unroll
    for (int r = 0; r < 16; ++r) p1[r] = __builtin_amdgcn_exp2f(p1[r]);
    float ps = 0;
#pragma unroll
    for (int r = 0; r < 16; ++r) ps += p0[r];
#pragma unroll
    for (int r = 0; r < 16; ++r) ps += p1[r];
    { auto rr = __builtin_amdgcn_permlane32_swap(__float_as_uint(ps), __float_as_uint(ps), false, false); ps = __uint_as_float(rr[0]) + __uint_as_float(rr[1]); }
    l_reg = l_reg * alpha + ps;
#define PK4(P, B_, OUT) do { unsigned a0 = cvtpk(P[B_+0], P[B_+1]), a1 = cvtpk(P[B_+2], P[B_+3]);                          \
        unsigned b0 = cvtpk(P[B_+4], P[B_+5]), b1 = cvtpk(P[B_+6], P[B_+7]);                                             \
        auto r0 = __builtin_amdgcn_permlane32_swap(a0, b0, false, false); auto r1 = __builtin_amdgcn_permlane32_swap(a1, b1, false, false); \
        u32x4 w = {r0[0], r1[0], r0[1], r1[1]}; OUT = *reinterpret_cast<bf16x8*>(&w); } while (0)
    PK4(p0, 0, pa0); PK4(p0, 8, pa1); PK4(p1, 0, pa2); PK4(p1, 8, pa3);
#undef PK4
}
template <int KB>
__device__ __forceinline__ void qkt(f32x16& p0, f32x16& p1, const char* K_lds, int r32, int hi, const bf16x8* qr) {
    p0 = f32x16{}; p1 = f32x16{};
#pragma unroll
    for (int d0 = 0; d0 < 4; ++d0) { const char* a = K_lds + KB * SHM_K + KSWZ64(r32, (d0 * 16 + hi * 8) * 2);
        bf16x8 b0 = *reinterpret_cast<const bf16x8*>(a);
        bf16x8 b1 = *reinterpret_cast<const bf16x8*>(a + 32 * 128);
        p0 = __builtin_amdgcn_mfma_f32_32x32x16_bf16(b0, qr[d0], p0, 0, 0, 0);
        p1 = __builtin_amdgcn_mfma_f32_32x32x16_bf16(b1, qr[d0], p1, 0, 0, 0); }
}
template <int VB>
__device__ __forceinline__ void pv_tile(f32x16* o, int vb0, bf16x8 pa0, bf16x8 pa1, bf16x8 pa2, bf16x8 pa3) {
#define TRRD(dst, off) asm volatile("ds_read_b64_tr_b16 %0, %1 offset:%2" : "=&v"(dst) : "v"(vb0), "i"(off) : "memory")
#define PV_RD(S, d0) do { constexpr int b_ = LDS_V + VB * SHM_V + v_rd_off(d0, 0, 0); \
        TRRD(S##l0, b_); TRRD(S##h0, b_ + 2048); TRRD(S##l1, b_ + 4096); TRRD(S##h1, b_ + 6144); TRRD(S##l2, b_ + 8192); TRRD(S##h2, b_ + 10240); TRRD(S##l3, b_ + 12288); TRRD(S##h3, b_ + 14336); } while (0)
#define PV_MM(S, d0) do { \
        o[d0] = __builtin_amdgcn_mfma_f32_32x32x16_bf16(pa0, (bf16x8){S##l0[0], S##l0[1], S##l0[2], S##l0[3], S##h0[0], S##h0[1], S##h0[2], S##h0[3]}, o[d0], 0, 0, 0);   \
        o[d0] = __builtin_amdgcn_mfma_f32_32x32x16_bf16(pa1, (bf16x8){S##l1[0], S##l1[1], S##l1[2], S##l1[3], S##h1[0], S##h1[1], S##h1[2], S##h1[3]}, o[d0], 0, 0, 0);   \
        o[d0] = __builtin_amdgcn_mfma_f32_32x32x16_bf16(pa2, (bf16x8){S##l2[0], S##l2[1], S##l2[2], S##l2[3], S##h2[0], S##h2[1], S##h2[2], S##h2[3]}, o[d0], 0, 0, 0);   \
        o[d0] = __builtin_amdgcn_mfma_f32_32x32x16_bf16(pa3, (bf16x8){S##l3[0], S##l3[1], S##l3[2], S##l3[3], S##h3[0], S##h3[1], S##h3[2], S##h3[3]}, o[d0], 0, 0, 0); } while (0)
#define LGK(n) do { asm volatile("s_waitcnt lgkmcnt(" #n ")" ::: "memory"); SBAR(); } while (0)
    s16x4 Al0, Al1, Al2, Al3, Ah0, Ah1, Ah2, Ah3, Bl0, Bl1, Bl2, Bl3, Bh0, Bh1, Bh2, Bh3;
    PV_RD(A, 0); PV_RD(B, 1); LGK(8); PV_MM(A, 0); SBAR();
    PV_RD(A, 2); LGK(8); PV_MM(B, 1); SBAR();
    PV_RD(B, 3); LGK(8); PV_MM(A, 2); SBAR();
    LGK(0); PV_MM(B, 3);
#undef PV_RD
#undef PV_MM
#undef LGK
#undef TRRD
}
struct BlockRef { const bf16_t* Q; const bf16_t* K; const bf16_t* V; bf16_t* OUT; int P0, c; };
struct Seam { bf16x8 qr[4]; };
#define DA_VMW() asm volatile("s_waitcnt vmcnt(0)" ::: "memory")
#define DA_KDMA(Kp, k0, bf) pg8::glds16s<0>((Kp) + (size_t)(k0) * RS, kvo, kdst + (unsigned)((bf) * SHM_K))
#define DA_VDMA(Vp, k0, bf) do { pg8::glds16s<0>((Vp) + (size_t)(k0) * RS, vvo0, vdst + (unsigned)((bf) * SHM_V)); pg8::glds16s<0>((Vp) + (size_t)(k0) * RS, vvo1, vdst + (unsigned)((bf) * SHM_V + 8192)); } while (0)
#define DA_ADDR() \
    const int kr = tid >> 3; \
    const unsigned kvo = (unsigned)(kr * RS + (((tid & 7) ^ ((kr >> 1) & 7)) * 8)) * 2u, kdst = (unsigned)__builtin_amdgcn_readfirstlane((unsigned)(uintptr_t)lds + LDS_K + wid * 1024); \
    const unsigned vvo0 = (unsigned)(v_slot_key(tid) * RS + v_slot_col(tid)) * 2u, vvo1 = (unsigned)(v_slot_key(tid + 512) * RS + v_slot_col(tid + 512)) * 2u, \
                   vdst = (unsigned)__builtin_amdgcn_readfirstlane((unsigned)(uintptr_t)lds + LDS_V + wid * 1024)
__device__ __forceinline__ void prime(const BlockRef& cur, char* lds, Seam& S) {
    const int tid = otid(), wid = __builtin_amdgcn_readfirstlane(tid >> 6), lane = tid & 63, r32 = lane & 31, hi = lane >> 5;
    DA_ADDR();
#pragma unroll
    for (int d0 = 0; d0 < 4; ++d0) S.qr[d0] = load8(cur.Q + (size_t)(wid * QBLK + r32) * RS + d0 * 16 + hi * 8);
    DA_KDMA(cur.K, 0, 0); DA_VDMA(cur.V, 0, 0); DA_VMW();
    __syncthreads();
}
__device__ __forceinline__ void block(const BlockRef& cur, const BlockRef& nxt, char* lds, Seam& S, float lam, const float* __restrict__ subln_w) {
    const int tid = otid(), wid = __builtin_amdgcn_readfirstlane(tid >> 6), lane = tid & 63, r32 = lane & 31, hi = lane >> 5;
    const int NT = (cur.P0 + QB) / KVBLK;
    const int qlo = cur.P0 + wid * QBLK, qm = qlo + r32 - 4 * hi;
    char* K_lds = lds + LDS_K;
    float* ws = (float*)(lds + LDS_WS) + wid * 64; float* li_l = ws; float* al_l = ws + 32;
    float m_reg = -1e30f, l_reg = 0; f32x16 o[4] = {};
    DA_ADDR();
    const int vb0 = (int)(uintptr_t)lds + v_rd_base(lane);
    const bf16_t* Kh = cur.K; const bf16_t* Vh = cur.V;
#define RESC(a) do { if (__any((a) < 1.f)) { if (hi == 0) al_l[r32] = (a); asm volatile("s_waitcnt lgkmcnt(0)" ::: "memory");              \
                     _Pragma("unroll") for (int d_ = 0; d_ < 4; ++d_) _Pragma("unroll") for (int r = 0; r < 16; ++r) o[d_][r] *= al_l[crow(r, hi)]; } } while (0)
#define KBASE(t) ((t) * KVBLK)
#define MASKT(P0_, P1_, t) do { const int kb_ = KBASE(t); if (kb_ + KVBLK - 1 > qlo) mask_tile(P0_, P1_, qm - kb_); } while (0)
    f32x16 pA0, pA1, pB0, pB1; float mnA, mnB, alA, alB; bf16x8 pa0, pa1, pa2, pa3;
    DA_KDMA(Kh, KBASE(1), 1); DA_VDMA(Vh, KBASE(1), 1);
    SBAR(); qkt<0>(pA0, pA1, K_lds, r32, hi, S.qr);
    MASKT(pA0, pA1, 0); partialSM(pA0, pA1, m_reg, mnA, alA);
    DA_VMW(); __syncthreads();
#define HALF_STEP(PX0, PX1, mnX, alX, PY0, PY1, alY, t, KB, VBP, KBN, VBN) do {                                               \
        SBAR(); qkt<KB>(PX0, PX1, K_lds, r32, hi, S.qr);                                                                      \
        finishSM(PY0, PY1, alY, l_reg, pa0, pa1, pa2, pa3); SBAR();                                                           \
        DA_KDMA(Kh, KBASE((t) + 1), KBN); DA_VDMA(Vh, KBASE((t) + 1), VBN); SBAR();                                          \
        pv_tile<VBP>(o, vb0, pa0, pa1, pa2, pa3); MASKT(PX0, PX1, (t)); partialSM(PX0, PX1, m_reg, mnX, alX);                  \
        RESC(alX); DA_VMW(); __syncthreads(); } while (0)
    HALF_STEP(pB0, pB1, mnB, alB, pA0, pA1, alA, 1, 1, 0, 0, 2);
    HALF_STEP(pA0, pA1, mnA, alA, pB0, pB1, alB, 2, 0, 1, 1, 3);
    for (int t = 3; t + 1 < NT; t += 4) {
        HALF_STEP(pB0, pB1, mnB, alB, pA0, pA1, alA, t, 1, 2, 0, 0);
        HALF_STEP(pA0, pA1, mnA, alA, pB0, pB1, alB, t + 1, 0, 3, 1, 1);
        HALF_STEP(pB0, pB1, mnB, alB, pA0, pA1, alA, t + 2, 1, 0, 0, 2);
        HALF_STEP(pA0, pA1, mnA, alA, pB0, pB1, alB, t + 3, 0, 1, 1, 3);
    }
    SBAR(); qkt<1>(pB0, pB1, K_lds, r32, hi, S.qr); SBAR();
    DA_KDMA(nxt.K, 0, 0); DA_VDMA(nxt.V, 0, 0); SBAR();
#pragma unroll
    for (int d0 = 0; d0 < 4; ++d0) S.qr[d0] = load8(nxt.Q + (size_t)(wid * QBLK + r32) * RS + d0 * 16 + hi * 8);
    SBAR();
    finishSM(pA0, pA1, alA, l_reg, pa0, pa1, pa2, pa3); SBAR();
    pv_tile<2>(o, vb0, pa0, pa1, pa2, pa3);
    MASKT(pB0, pB1, NT - 1); partialSM(pB0, pB1, m_reg, mnB, alB); RESC(alB);
    finishSM(pB0, pB1, alB, l_reg, pa0, pa1, pa2, pa3); SBAR(); pv_tile<3>(o, vb0, pa0, pa1, pa2, pa3);
    SBAR();
    if (hi == 0) li_l[r32] = l_reg;
    asm volatile("s_waitcnt lgkmcnt(0)" ::: "memory");
    float rli[16];
#pragma unroll
    for (int r = 0; r < 16; ++r) rli[r] = __builtin_amdgcn_rcpf(li_l[crow(r, hi)]);
    unsigned* ostw = (unsigned*)(lds + LDS_OST + wid * 8192);
    if (cur.c == 1) {
#pragma unroll
        for (int d0 = 0; d0 < 4; ++d0)
#pragma unroll
            for (int r = 0; r < 16; r += 2) ostw[(d0 * 8 + (r >> 1)) * 64 + lane] = cvtpk(o[d0][r] * rli[r], o[d0][r + 1] * rli[r + 1]);
    } else {
        float ss[16];
#pragma unroll
        for (int r = 0; r < 16; ++r) ss[r] = 0.f;
#pragma unroll
        for (int d0 = 0; d0 < 4; ++d0)
#pragma unroll
            for (int r = 0; r < 16; r += 2) { const unsigned u = ostw[(d0 * 8 + (r >> 1)) * 64 + lane];
                const float v0 = o[d0][r] * rli[r] - lam * __uint_as_float(u << 16), v1 = o[d0][r + 1] * rli[r + 1] - lam * __uint_as_float(u & 0xffff0000u);
                o[d0][r] = v0; o[d0][r + 1] = v1; ss[r] += v0 * v0; ss[r + 1] += v1 * v1; }
#pragma unroll
        for (int msk = 1; msk < 32; msk <<= 1)
#pragma unroll
            for (int r = 0; r < 16; ++r) ss[r] += __shfl_xor(ss[r], msk);
        float sw[4];
#pragma unroll
        for (int d0 = 0; d0 < 4; ++d0) sw[d0] = subln_w[d0 * 32 + r32] * 0.8f;
        asm volatile("s_waitcnt lgkmcnt(0)" ::: "memory");
        bf16_t* stg = (bf16_t*)ostw;
#pragma unroll
        for (int r = 0; r < 16; ++r) { const float rs = 1.0f / sqrtf(ss[r] * (1.f / 128.f) + EPS); const int orow = crow(r, hi);
#pragma unroll
            for (int d0 = 0; d0 < 4; ++d0) stg[orow * 128 + d0 * 32 + r32] = (bf16_t)f2bf(o[d0][r] * rs * sw[d0]); }
        asm volatile("s_waitcnt lgkmcnt(0)" ::: "memory");
        bf16_t* Ow = cur.OUT + (size_t)(wid * QBLK) * D;
#pragma unroll
        for (int i = 0; i < 8; ++i) { const int row = i * 4 + (lane >> 4), ch = lane & 15; const u32x4 v = *(const u32x4*)(stg + row * 128 + ch * 8); *(u32x4*)(Ow + (size_t)row * D + ch * 8) = v; }
    }
    DA_VMW();
    __syncthreads();
#undef RESC
#undef KBASE
#undef MASKT
#undef HALF_STEP
}
#undef DA_VMW
#undef DA_KDMA
#undef DA_VDMA
#undef DA_ADDR
__device__ __forceinline__ BlockRef ref_of(int L, int seq, const bf16_t* PROJ, bf16_t* CAT) {
    const int bh = L >> 2, y = L & 3, b = bh >> 2, h = bh & 3, qb = (seq < 2) ? y : 7 - y, c = (seq & 1) ? 0 : 1;
    BlockRef r; const size_t row0 = (size_t)b * SEQ;
    r.Q = PROJ + (row0 + (size_t)qb * QB) * RS + h * 128 + c * 64; r.K = PROJ + row0 * RS + 512 + h * 128 + c * 64; r.V = PROJ + row0 * RS + 1024 + h * 128;
    r.OUT = CAT + (row0 + (size_t)qb * QB) * D + h * 128; r.P0 = qb * QB; r.c = c; return r;
}
__device__ __forceinline__ void phase(char* lds, const bf16_t* PROJ, bf16_t* CAT, float lam, const float* subln_w, int G, int bid) {
    constexpr int TOTAL = (T / SEQ) * 4 * 4;
    const int v = (G % 8 == 0) ? (bid & 7) * (G >> 3) + (bid >> 3) : bid;
    int L = v; if (L >= TOTAL) return;
    int seq = 0; BlockRef cur = ref_of(L, 0, PROJ, CAT);
    Seam S; prime(cur, lds, S);
    for (;;) {
        int Ln = L, seqn = seq + 1; if (seqn == 4) { seqn = 0; Ln = L + G; }
        const bool last = Ln >= TOTAL;
        const BlockRef nxt = last ? cur : ref_of(Ln, seqn, PROJ, CAT);
        block(cur, nxt, lds, S, lam, subln_w);
        if (last) break;
        cur = nxt; L = Ln; seq = seqn;
    }
}
#undef KSWZ64
#undef SBAR
}


#define LAS __attribute__((address_space(3)))
constexpr int NWAVES = 8, NTHREADS = 512;
namespace rtr {
typedef float f32x2 __attribute__((ext_vector_type(2)));
constexpr int LDS_W = 0, LDS_LG = 131072, LDS_CNT = LDS_LG + 8 * 16 * 33 * 4, LDS_BYTES = LDS_CNT + 256;
__device__ __forceinline__ void phase(LAS unsigned char* lds, const bf16_t* __restrict__ x1, const float* __restrict__ fw, const float* __restrict__ rw, const float* __restrict__ rb,
                                      int* cnt, int* ltok, float* lgate, int* slot, unsigned char* __restrict__ XQ, int G, int bid) {
    const int tid = otid(), lane = tid & 63, wid = __builtin_amdgcn_readfirstlane(tid >> 6), r = lane & 15, q = lane >> 4;
    LAS float* Wl = (LAS float*)(lds + LDS_W); LAS float* lg = (LAS float*)(lds + LDS_LG) + wid * (16 * 33); LAS int* lcount = (LAS int*)(lds + LDS_CNT); LAS int* lbase = lcount + 32;
    for (int idx = tid; idx < 1024 * 32; idx += NTHREADS) { const int k = idx >> 5, e = idx & 31; Wl[k * 32 + 2 * (e & 15) + (e >> 4)] = rw[idx] * fw[k]; }
    if (tid < 32) lcount[tid] = 0;
    __syncthreads();
    const float rb0 = rb[r], rb1 = rb[16 + r];
    for (int tile = bid; tile < T / 128; tile += G) {
        const int t0 = tile * 128 + wid * 16, ch = (tile * 128) / TC;
        const bf16_t* xrow = x1 + (size_t)(t0 + r) * D + 8 * q;
        f32x4 acc0 = {0.f, 0.f, 0.f, 0.f}, acc1 = {0.f, 0.f, 0.f, 0.f}; float ssq = 0.f;
#pragma unroll 4
        for (int j = 0; j < 32; ++j) {
            const u32x4 xw = *(const u32x4*)(xrow + 32 * j);
            const f32x4 xa = {__uint_as_float(xw[0] << 16), __uint_as_float(xw[0] & 0xffff0000u), __uint_as_float(xw[1] << 16), __uint_as_float(xw[1] & 0xffff0000u)},
                        xb = {__uint_as_float(xw[2] << 16), __uint_as_float(xw[2] & 0xffff0000u), __uint_as_float(xw[3] << 16), __uint_as_float(xw[3] & 0xffff0000u)};
            ssq += xa[0] * xa[0] + xa[1] * xa[1] + xa[2] * xa[2] + xa[3] * xa[3] + xb[0] * xb[0] + xb[1] * xb[1] + xb[2] * xb[2] + xb[3] * xb[3];
            const LAS float* wp = Wl + (32 * j + 8 * q) * 32 + 2 * r;
#pragma unroll
            for (int i = 0; i < 8; ++i) { const f32x2 w2 = *(const LAS f32x2*)(wp + i * 32); const float xv = i < 4 ? xa[i] : xb[i - 4];
                acc0 = __builtin_amdgcn_mfma_f32_16x16x4f32(xv, w2[0], acc0, 0, 0, 0); acc1 = __builtin_amdgcn_mfma_f32_16x16x4f32(xv, w2[1], acc1, 0, 0, 0); }
        }
        ssq += __shfl_xor(ssq, 16); ssq += __shfl_xor(ssq, 32);
        const float rstd = 1.0f / sqrtf(ssq * (1.f / D) + EPS);
        { const float sx = rstd * FP8_SX;
#pragma unroll 4
          for (int j = 0; j < 32; ++j) { const u32x4 xw = *(const u32x4*)(xrow + 32 * j);
              *(unsigned long long*)(XQ + (size_t)(t0 + r) * D + 32 * j + 8 * q) =
                  (unsigned long long)pk4_fp8(__uint_as_float(xw[0] << 16) * sx, __uint_as_float(xw[0] & 0xffff0000u) * sx, __uint_as_float(xw[1] << 16) * sx, __uint_as_float(xw[1] & 0xffff0000u) * sx)
                | ((unsigned long long)pk4_fp8(__uint_as_float(xw[2] << 16) * sx, __uint_as_float(xw[2] & 0xffff0000u) * sx, __uint_as_float(xw[3] << 16) * sx, __uint_as_float(xw[3] & 0xffff0000u) * sx) << 32); } }
        asm volatile("s_waitcnt lgkmcnt(0)" ::: "memory");
#pragma unroll
        for (int g4 = 0; g4 < 4; ++g4) { const float rs = __shfl(rstd, q * 4 + g4); lg[(q * 4 + g4) * 33 + r] = acc0[g4] * rs + rb0; lg[(q * 4 + g4) * 33 + 16 + r] = acc1[g4] * rs + rb1; }
        asm volatile("s_waitcnt lgkmcnt(0)" ::: "memory");
        int ti[4]; float gt[4]; int lpos[4];
        if (lane < 16) {
            float v[32];
#pragma unroll
            for (int e = 0; e < 32; ++e) v[e] = lg[lane * 33 + e];
            unsigned used = 0u; float tv[4];
#pragma unroll
            for (int k = 0; k < 4; ++k) { float best = -INFINITY; int bi = -1;
#pragma unroll
                for (int e = 0; e < 32; ++e) { const bool take = !((used >> e) & 1u) && (bi < 0 || v[e] > best); best = take ? v[e] : best; bi = take ? e : bi; }
                tv[k] = best; ti[k] = bi; used |= 1u << bi; }
            const float e1 = expf(tv[1] - tv[0]), e2 = expf(tv[2] - tv[0]), e3 = expf(tv[3] - tv[0]), inv = 1.f / (1.f + e1 + e2 + e3);
            gt[0] = inv; gt[1] = e1 * inv; gt[2] = e2 * inv; gt[3] = e3 * inv;
#pragma unroll
            for (int k = 0; k < 4; ++k) lpos[k] = __hip_atomic_fetch_add(lcount + ti[k], 1, __ATOMIC_RELAXED, __HIP_MEMORY_SCOPE_WORKGROUP);
        }
        __syncthreads();
        if (tid < 32) { const int c = lcount[tid]; lbase[tid] = c ? atomicAdd(&cnt[ch * 32 + tid], c) : 0; lcount[tid] = 0; }
        __syncthreads();
        if (lane < 16) { const int t = t0 + lane;
#pragma unroll
            for (int k = 0; k < 4; ++k) { const int pos = lbase[ti[k]] + lpos[k]; const size_t idx = ((size_t)ch * 32 + ti[k]) * TC + pos;
                ltok[idx] = t; lgate[idx] = gt[k]; slot[t * 4 + k] = (ti[k] << 16) | pos; } }
    }
    __syncthreads();
}
}

typedef unsigned gu32_t;
#define XB_TMO      128
#define XB_XCNT(j)  (256  + 64 * (j))
#define XB_XSUB(j)  (1280 + 64 * (j))
#define XB_XGEN(j)  (2304 + 64 * (j))
#define XB_TOP      3328
#define XB_TOPGEN   3392
#define XCD_BAR_WORDS 3456
#define XB_SPIN_CAP (1u << 18)

__device__ __forceinline__ unsigned xb_ld(unsigned* p)              { return __hip_atomic_load(p, __ATOMIC_RELAXED, __HIP_MEMORY_SCOPE_AGENT); }
__device__ __forceinline__ unsigned xb_add(unsigned* p, unsigned v) { return __hip_atomic_fetch_add(p, v, __ATOMIC_RELAXED, __HIP_MEMORY_SCOPE_AGENT); }
__device__ __forceinline__ unsigned xb_xcc_id() { return (unsigned)__builtin_amdgcn_s_getreg((3 << 11) | 20) & 0xFu; }
#define XB_SPIN(cond, bar) do { unsigned _sp = 0; while (cond) { __builtin_amdgcn_s_sleep(1); \
    if ((++_sp & 255u) == 0u) { if (xb_ld(&(bar)[XB_TMO])) break; if (_sp > XB_SPIN_CAP) { atomicAdd(&(bar)[XB_TMO], 1u); break; } } } } while (0)

struct XcdBarrier {
    unsigned* bar; unsigned x;
    volatile LAS unsigned* st;
};

__device__ __forceinline__ XcdBarrier xcd_barrier_post(unsigned* bar, volatile LAS unsigned* st) {
    XcdBarrier b; b.bar = bar; b.x = xb_xcc_id(); b.st = st;
    if (threadIdx.x == 0) (void)xb_add(&bar[XB_XCNT(b.x)], 1u);
    return b;
}
__device__ __forceinline__ void xcd_barrier_complete(unsigned* bar, unsigned x, unsigned& nloc, unsigned& nx) {
    const unsigned G = gridDim.x * gridDim.y * gridDim.z;
    unsigned sum, cnt, mine, sp = 0u;
    for (;;) {
        sum = 0u; cnt = 0u; mine = 0u;
#pragma unroll
        for (unsigned j = 0; j < 16; ++j) { const unsigned c = xb_ld(&bar[XB_XCNT(j)]); sum += c; cnt += (c > 0u) ? 1u : 0u; mine = (j == x) ? c : mine; }
        if (sum == G) break;
        __builtin_amdgcn_s_sleep(1);
        if ((++sp & 255u) == 0u) { if (xb_ld(&bar[XB_TMO])) break; if (sp > XB_SPIN_CAP) { atomicAdd(&bar[XB_TMO], 1u); break; } }
    }
    nloc = mine > 0u ? mine : 1u; nx = cnt > 0u ? cnt : 1u;
}

__device__ __forceinline__ void xcd_barrier(const XcdBarrier& b) {
    asm volatile("s_waitcnt vmcnt(0)" ::: "memory");
    __syncthreads();
    if (threadIdx.x == 0) {
        unsigned* bar = b.bar;
        __builtin_amdgcn_s_waitcnt(0);
        unsigned nloc = b.st[0], nx = b.st[1];
        if (nloc == 0u) { xcd_barrier_complete(bar, b.x, nloc, nx); b.st[0] = nloc; b.st[1] = nx; }
        const unsigned old = xb_add(&bar[XB_XSUB(b.x)], 1u);
        const unsigned gen = old / nloc;
        if (old + 1u == (gen + 1u) * nloc) {
            __builtin_amdgcn_fence(__ATOMIC_RELEASE, "agent");
            asm volatile("s_waitcnt vmcnt(0)" ::: "memory");
            const unsigned og = xb_add(&bar[XB_TOP], 1u);
            const unsigned tg = og / nx;
            if (og + 1u == (tg + 1u) * nx) xb_add(&bar[XB_TOPGEN], 1u);
            else XB_SPIN(xb_ld(&bar[XB_TOPGEN]) == tg, bar);
            __builtin_amdgcn_fence(__ATOMIC_ACQUIRE, "agent");
            xb_add(&bar[XB_XGEN(b.x)], 1u);
            asm volatile("s_waitcnt vmcnt(0)" ::: "memory");
        } else {
            XB_SPIN(xb_ld(&bar[XB_XGEN(b.x)]) == gen, bar);
            __builtin_amdgcn_fence(__ATOMIC_ACQUIRE, "agent");
            asm volatile("s_waitcnt vmcnt(0)" ::: "memory");
        }
    }
    __syncthreads();
}


constexpr int XB_LDS = pg8::STAGE_BYTES + pg8::PLAN_BYTES;
constexpr int MK_LDS = pg8::STAGE_BYTES + pg8::PLAN_BYTES + 64 + 2048;

struct MArgs {
    const float* x; const int* positions; const float* attn_norm_w; const float* w_in; const float* lq1; const float* lk1; const float* lq2; const float* lk2;
    const float* subln_w; const float* pool_w; const float* pool_scale; const float* w_out; const float* ffn_norm_w; const float* router_w; const float* router_b;
    const float* w_gu; const float* b_gu; const float* w_down; const float* b_down; const float* final_w; float* out; unsigned char* ws;
};

template <int MODE>
__device__ __forceinline__ void p0_transpose_item(const float* __restrict__ W, int N, bf16_t* __restrict__ WT, int ldk, LAS float* scr, int item, int lane, const float* __restrict__ kscale) {
    const int nblk = N / 32, kb = item / nblk, nb = item % nblk, k0 = 64 * kb, n0 = 32 * nb;
#pragma unroll 8
    for (int i = 0; i < 32; ++i) { const int kk = 2 * i + (lane >> 5); float v = W[(size_t)(k0 + kk) * N + n0 + (lane & 31)]; if (MODE != 0) v *= kscale[k0 + kk]; scr[kk * 33 + (lane & 31)] = v; }
    asm volatile("s_waitcnt lgkmcnt(0)" ::: "memory");
    const int c = lane & 7;
#pragma unroll
    for (int j = 0; j < 4; ++j) { const int nl = (lane >> 3) + 8 * j, n = n0 + nl; const LAS float* s = scr + (8 * c) * 33 + nl;
        int row = n;
        if (MODE == 1) { const int f = n & 1023, up = n >> 10; row = (f >> 7) * 256 + up * 128 + (f & 127); }
        u32x4 o; o.x = f2bf(s[0 * 33]) | (f2bf(s[1 * 33]) << 16); o.y = f2bf(s[2 * 33]) | (f2bf(s[3 * 33]) << 16); o.z = f2bf(s[4 * 33]) | (f2bf(s[5 * 33]) << 16); o.w = f2bf(s[6 * 33]) | (f2bf(s[7 * 33]) << 16);
        *(u32x4*)(WT + (size_t)row * ldk + k0 + 8 * c) = o; }
    asm volatile("s_waitcnt lgkmcnt(0)" ::: "memory");
}
template <int MODE>
__device__ __forceinline__ void p0_transpose_item_fp8(const float* __restrict__ W, int N, unsigned char* __restrict__ WT, int ldk, LAS float* scr, int item, int lane, const float* __restrict__ kscale, float sc) {
    const int nblk = N / 32, kb = item / nblk, nb = item % nblk, k0 = 64 * kb, n0 = 32 * nb;
#pragma unroll 8
    for (int i = 0; i < 32; ++i) { const int kk = 2 * i + (lane >> 5); float v = W[(size_t)(k0 + kk) * N + n0 + (lane & 31)] * sc; if (MODE == 1) v *= kscale[k0 + kk]; scr[kk * 33 + (lane & 31)] = v; }
    asm volatile("s_waitcnt lgkmcnt(0)" ::: "memory");
    const int c = lane & 3;
#pragma unroll
    for (int j = 0; j < 2; ++j) { const int nl = (lane >> 2) + 16 * j, n = n0 + nl; const LAS float* s = scr + (16 * c) * 33 + nl;
        int row = n;
        if (MODE == 1) { const int f = n & 1023, up = n >> 10; row = (f >> 7) * 256 + up * 128 + (f & 127); }
        u32x4 o;
#pragma unroll
        for (int q = 0; q < 4; ++q) o[q] = pk4_fp8(s[(4 * q) * 33], s[(4 * q + 1) * 33], s[(4 * q + 2) * 33], s[(4 * q + 3) * 33]);
        *(u32x4*)(WT + (size_t)row * ldk + k0 + 16 * c) = o; }
    asm volatile("s_waitcnt lgkmcnt(0)" ::: "memory");
}
__device__ __forceinline__ void xbf_row(const float* __restrict__ xrow, bf16_t* __restrict__ orow, float* __restrict__ rstd_out, int lane) {
    const f32x4* xr = (const f32x4*)xrow + lane;
    f32x4 v[4]; float s = 0.f;
#pragma unroll
    for (int j = 0; j < 4; ++j) { v[j] = xr[64 * j]; s += v[j].x * v[j].x + v[j].y * v[j].y + v[j].z * v[j].z + v[j].w * v[j].w; }
    unsigned long long* o8 = (unsigned long long*)orow + lane;
#pragma unroll
    for (int j = 0; j < 4; ++j) { const unsigned lo = f2bf(v[j].x) | (f2bf(v[j].y) << 16), hi = f2bf(v[j].z) | (f2bf(v[j].w) << 16); o8[64 * j] = (unsigned long long)lo | ((unsigned long long)hi << 32); }
    const float rstd = 1.0f / sqrtf(wave_sum(s) * (1.f / D) + EPS);
    if (lane == 0) *rstd_out = rstd;
}
__device__ __forceinline__ void rmsnorm_row_bf16(const float* __restrict__ xrow, const float* __restrict__ w, bf16_t* __restrict__ orow, int lane) {
    const f32x4* xr = (const f32x4*)xrow + lane;
    f32x4 v[4]; float s = 0.f;
#pragma unroll
    for (int j = 0; j < 4; ++j) { v[j] = xr[64 * j]; s += v[j].x * v[j].x + v[j].y * v[j].y + v[j].z * v[j].z + v[j].w * v[j].w; }
    const float rstd = 1.0f / sqrtf(wave_sum(s) * (1.f / D) + EPS);
    unsigned long long* o8 = (unsigned long long*)orow + lane;
#pragma unroll
    for (int j = 0; j < 4; ++j) { const f32x4 ww = ((const f32x4*)w)[64 * j + lane];
        const unsigned lo = f2bf(v[j].x * rstd * ww.x) | (f2bf(v[j].y * rstd * ww.y) << 16), hi = f2bf(v[j].z * rstd * ww.z) | (f2bf(v[j].w * rstd * ww.w) << 16);
        o8[64 * j] = (unsigned long long)lo | ((unsigned long long)hi << 32); }
}

__device__ __forceinline__ void final_row(float* __restrict__ out, const bf16_t* __restrict__ XB, const unsigned char* __restrict__ YP, const LAS int* tb, const int* slot, const float* __restrict__ lgate, const float* __restrict__ w, int t, int lane) {
    int rows[4]; float gk[4];
#pragma unroll
    for (int k = 0; k < 4; ++k) { const int sl = slot[t * 4 + k]; rows[k] = tb[sl >> 16] + (sl & 0xffff); gk[k] = lgate[(size_t)(sl >> 16) * TC + (sl & 0xffff)] * (1.0f / FP8_SY); }
    float v[16];
    { const u32x4 a0 = *(const u32x4*)(XB + (size_t)t * D + 16 * lane), a1 = *(const u32x4*)(XB + (size_t)t * D + 16 * lane + 8);
#pragma unroll
      for (int e = 0; e < 4; ++e) { v[2 * e] = __uint_as_float(a0[e] << 16); v[2 * e + 1] = __uint_as_float(a0[e] & 0xffff0000u); v[8 + 2 * e] = __uint_as_float(a1[e] << 16); v[8 + 2 * e + 1] = __uint_as_float(a1[e] & 0xffff0000u); } }
    float y[16];
#pragma unroll
    for (int e = 0; e < 16; ++e) y[e] = 0.f;
#pragma unroll
    for (int k = 0; k < 4; ++k) { const u32x4 q = *(const u32x4*)(YP + (size_t)rows[k] * D + 16 * lane);
#pragma unroll
        for (int e = 0; e < 4; ++e) { y[4 * e] += gk[k] * __builtin_amdgcn_cvt_f32_fp8(q[e], 0); y[4 * e + 1] += gk[k] * __builtin_amdgcn_cvt_f32_fp8(q[e], 1); y[4 * e + 2] += gk[k] * __builtin_amdgcn_cvt_f32_fp8(q[e], 2); y[4 * e + 3] += gk[k] * __builtin_amdgcn_cvt_f32_fp8(q[e], 3); } }
    float s = 0.f;
#pragma unroll
    for (int e = 0; e < 16; ++e) { v[e] += y[e]; s += v[e] * v[e]; }
    const float rstd = 1.0f / sqrtf(wave_sum(s) * (1.f / D) + EPS);
    float* op = out + (size_t)t * D + 16 * lane; const float* wp = w + 16 * lane;
#pragma unroll
    for (int e = 0; e < 4; ++e) { const f32x4 ww = *(const f32x4*)(wp + 4 * e); *(f32x4*)(op + 4 * e) = (f32x4){v[4 * e] * rstd * ww.x, v[4 * e + 1] * rstd * ww.y, v[4 * e + 2] * rstd * ww.z, v[4 * e + 3] * rstd * ww.w}; }
}

typedef const MArgs __attribute__((address_space(4)))* KArgP;
__device__ __forceinline__ KArgP kargs() { KArgP p = (KArgP)__builtin_amdgcn_kernarg_segment_ptr(); asm volatile("" : "+s"(p)); return p; }
#define WSP(T_, off) ((T_*)(ws + (off)))
__global__ __launch_bounds__(NTHREADS, 2) void mega_fwd(MArgs a_unused) {
    extern __shared__ __attribute__((aligned(16))) unsigned char lds_raw[];
    LAS unsigned char* lds = (LAS unsigned char*)lds_raw;
    const int G = gridDim.x, bid = blockIdx.x, gsz = G * NTHREADS, ngw = G * NWAVES;
    if (threadIdx.x < 16) ((LAS unsigned*)(lds + XB_LDS))[threadIdx.x] = 0u;
    __syncthreads();
    (void)xcd_barrier_post((unsigned*)(kargs()->ws + WS_BAR), (volatile LAS unsigned*)(lds + XB_LDS));
#define GRID_SYNC() do { XcdBarrier xb_; xb_.bar = (unsigned*)(kargs()->ws + WS_BAR); xb_.x = xb_xcc_id(); xb_.st = (volatile LAS unsigned*)(lds + XB_LDS); xcd_barrier(xb_); } while (0)
#define PHASE_IDX() const int tid = otid(), lane = tid & 63, wid = __builtin_amdgcn_readfirstlane(tid >> 6), gtid = bid * NTHREADS + tid, gw = bid * NWAVES + wid; (void)lane; (void)gtid; (void)gw

    {
        PHASE_IDX(); KArgP a = kargs(); unsigned char* ws = a->ws; int* cnt = WSP(int, WS_CTL); float* rope = WSP(float, WS_ROPE); bf16_t* Win_t = WSP(bf16_t, WS_WIN); bf16_t* Wo_t = WSP(bf16_t, WS_WO); bf16_t* Wd_t = WSP(bf16_t, WS_WD); bf16_t* Wgu_t = WSP(bf16_t, WS_WGU); bf16_t* XN = WSP(bf16_t, WS_XN);
        if (gtid < NCHUNK * 32) cnt[gtid] = 0;
        LAS float* scr = (LAS float*)(lds + wid * 8448);
        constexpr int I_IN = (D / 64) * (INW / 32), I_WO = (512 / 64) * (D / 32), I_GU = (D / 64) * (2048 / 32), I_DN = (FF / 64) * (D / 32);
        constexpr int NITEMS = I_IN + I_WO + NE * I_GU + NE * I_DN;
        for (int it = gw; it < NITEMS; it += ngw) {
            int r = it;
            if (r < I_IN) { p0_transpose_item<2>(a->w_in, INW, Win_t, D, scr, r, lane, a->attn_norm_w); continue; } r -= I_IN;
            if (r < I_WO) { p0_transpose_item<0>(a->w_out, D, Wo_t, D, scr, r, lane, nullptr); continue; } r -= I_WO;
            if (r < NE * I_GU) { const int e = r / I_GU; p0_transpose_item_fp8<1>(a->w_gu + (size_t)e * D * 2048, 2048, (unsigned char*)Wgu_t + (size_t)e * 2048 * D, D, scr, r % I_GU, lane, a->ffn_norm_w, FP8_SW); continue; } r -= NE * I_GU;
            { const int e = r / I_DN; p0_transpose_item_fp8<0>(a->w_down + (size_t)e * FF * D, D, (unsigned char*)Wd_t + (size_t)e * D * FF, FF, scr, r % I_DN, lane, nullptr, FP8_SW); }
        }
        for (int idx = gtid; idx < 512 * 1024; idx += gsz) {
            const int n = idx & 1023, gc = idx >> 10, g = gc >> 7; float acc = 0.f;
            for (int d = 0; d < 128; ++d) acc += a->pool_w[(size_t)gc * 128 + d] * a->pool_scale[g * 128 + d] * a->w_out[(size_t)(512 + g * 128 + d) * 1024 + n];
            Wo_t[(size_t)n * 1024 + 512 + gc] = (bf16_t)f2bf(acc);
        }
        for (int idx = gtid; idx < T * 8; idx += gsz) {
            const int t = idx >> 3, j = idx & 7;
            const double inv = exp(-(double)(2 * j) / 16.0 * log(500000.0)); const double ang = (double)a->positions[t] * inv;
            rope[(size_t)t * 16 + j] = (float)cos(ang); rope[(size_t)t * 16 + 8 + j] = (float)sin(ang);
        }
        for (int row = gw; row < T; row += ngw) xbf_row(a->x + (size_t)row * D, XN + (size_t)row * D, WSP(float, WS_RSTD) + row, lane);
    }
    GRID_SYNC();
    { PHASE_IDX(); KArgP a = kargs(); unsigned char* ws = a->ws; bf16_t* Win_t = WSP(bf16_t, WS_WIN); bf16_t* XN = WSP(bf16_t, WS_XN); bf16_t* PROJ = WSP(bf16_t, WS_PROJ); const float* rope = WSP(float, WS_ROPE);
      pg8::DensePlan S; S.init(T, INW, G, bid); pg8::EpiBf16 E{PROJ, INW, rope, 4, WSP(float, WS_RSTD)}; pg8::gemm_phase<2048, false>(lds, XN, Win_t, S, E); }
    GRID_SYNC();
    {
        PHASE_IDX(); KArgP a = kargs(); unsigned char* ws = a->ws; bf16_t* PROJ = WSP(bf16_t, WS_PROJ); bf16_t* CAT = WSP(bf16_t, WS_CAT);
        const float lam = expf(wave_sum(a->lq1[lane] * a->lk1[lane])) - expf(wave_sum(a->lq2[lane] * a->lk2[lane])) + 0.2f;
        dattn::phase((char*)lds_raw, PROJ, CAT, lam, a->subln_w, G, bid);
        for (int item = gtid; item < (T / 32) * 64; item += gsz) {
            const int chunk = item & 63, tb = item >> 6, c0 = chunk * 8, w = 2 << (c0 >> 7), t0 = tb * 32, s0 = t0 % SEQ;
            const bf16_t* up = PROJ + (size_t)t0 * INW + 1536 + c0; bf16_t* op = CAT + (size_t)t0 * D + 512 + c0;
            float sum[8];
#pragma unroll
            for (int e = 0; e < 8; ++e) sum[e] = 0.f;
            if (s0 > 0) for (int i = 1; i < w; ++i) { const u32x4 v = *(const u32x4*)(up - (size_t)i * INW);
#pragma unroll
                for (int e = 0; e < 4; ++e) { sum[2 * e] += __uint_as_float(v[e] << 16); sum[2 * e + 1] += __uint_as_float(v[e] & 0xffff0000u); } }
            for (int tb8 = 0; tb8 < 32; tb8 += 8) {
                u32x4 vin[8], vout[8];
#pragma unroll
                for (int i = 0; i < 8; ++i) vin[i] = *(const u32x4*)(up + (size_t)(tb8 + i) * INW);
#pragma unroll
                for (int i = 0; i < 8; ++i) { const int tt = tb8 + i; const bool has = s0 + tt + 1 >= w; vout[i] = *(const u32x4*)(up + (size_t)(has ? tt - w + 1 : tt) * INW); }
                asm volatile("" ::: "memory");
#pragma unroll
                for (int i = 0; i < 8; ++i) { const int tt = tb8 + i; float f[8];
#pragma unroll
                    for (int e = 0; e < 4; ++e) { f[2 * e] = __uint_as_float(vin[i][e] << 16); f[2 * e + 1] = __uint_as_float(vin[i][e] & 0xffff0000u); }
                    const int s = s0 + tt; const float rn = 1.0f / (float)((s + 1 < w) ? s + 1 : w);
                    u32x4 o;
#pragma unroll
                    for (int e = 0; e < 4; ++e) { sum[2 * e] += f[2 * e]; sum[2 * e + 1] += f[2 * e + 1]; o[e] = pg8::cvt_pk_bf16(sum[2 * e] * rn - f[2 * e], sum[2 * e + 1] * rn - f[2 * e + 1]); }
                    *(u32x4*)(op + (size_t)tt * D) = o;
                    const float hm = (s + 1 >= w) ? 1.f : 0.f;
#pragma unroll
                    for (int e = 0; e < 4; ++e) { sum[2 * e] -= hm * __uint_as_float(vout[i][e] << 16); sum[2 * e + 1] -= hm * __uint_as_float(vout[i][e] & 0xffff0000u); } }
            }
        }
    }
    GRID_SYNC();
    { PHASE_IDX(); KArgP a = kargs(); unsigned char* ws = a->ws; bf16_t* Wo_t = WSP(bf16_t, WS_WO); bf16_t* CAT = WSP(bf16_t, WS_CAT);
      pg8::DensePlan S; S.init(T, D, G, bid); pg8::EpiResBf16 E{WSP(bf16_t, WS_XB), WSP(bf16_t, WS_XN), D}; pg8::gemm_phase<2048, false>(lds, CAT, Wo_t, S, E); }
    GRID_SYNC();
    { PHASE_IDX(); KArgP a = kargs(); unsigned char* ws = a->ws;
      rtr::phase(lds, WSP(bf16_t, WS_XB), a->ffn_norm_w, a->router_w, a->router_b, WSP(int, WS_CTL), WSP(int, WS_LTOK), WSP(float, WS_LGATE), WSP(int, WS_SLOT), WSP(unsigned char, WS_XN), G, bid); }
    GRID_SYNC();
    for (int ch = 0; ch < NCHUNK; ++ch) {
        PHASE_IDX(); KArgP a = kargs(); unsigned char* ws = a->ws; int* cnt = WSP(int, WS_CTL); int* ltok = WSP(int, WS_LTOK); float* lgate = WSP(float, WS_LGATE); int* slot = WSP(int, WS_SLOT); bf16_t* Wd_t = WSP(bf16_t, WS_WD); bf16_t* Wgu_t = WSP(bf16_t, WS_WGU); bf16_t* XN = WSP(bf16_t, WS_XN); bf16_t* HM = WSP(bf16_t, WS_HM); bf16_t* YP = WSP(bf16_t, WS_YP); float* out = a->out;
        const int* cc = cnt + ch * 32; const int* lt = ltok + (size_t)ch * 32 * TC; const float* lg = lgate + (size_t)ch * 32 * TC;
        { pg8::MoePlan<true> S = pg8::moe_plan_setup<true>(lds + pg8::STAGE_BYTES, cc, lt, 8, G, bid); pg8::EpiGLU E{HM, a->b_gu, 8}; pg8::gemm_phase<1024, true>(lds, XN, Wgu_t, S, E); }
        GRID_SYNC();
        { pg8::MoePlan<false> S = pg8::moe_plan_setup<false>(lds + pg8::STAGE_BYTES, cc, lt, 4, G, bid); pg8::EpiDown E{YP, a->b_down, 4}; pg8::gemm_phase<1024, true>(lds, HM, Wd_t, S, E); }
        GRID_SYNC();
        { LAS int* tb = (LAS int*)(lds + pg8::STAGE_BYTES);
          if (tid < 64) { int v = (lane < 32) ? (__hip_atomic_load(cc + (lane & 31), __ATOMIC_RELAXED, __HIP_MEMORY_SCOPE_AGENT) + TM - 1) / TM : 0, incl = v;
#pragma unroll
              for (int o = 1; o < 32; o <<= 1) { const int up = __shfl_up(incl, o); if (lane >= o) incl += up; }
              if (lane < 32) tb[lane] = (incl - v) * TM; }
          __syncthreads();
          for (int t = ch * TC + gw; t < (ch + 1) * TC; t += ngw) final_row(out, WSP(bf16_t, WS_XB), (const unsigned char*)YP, tb, slot, lg, a->final_w, t, lane);
          __syncthreads(); }
    }
}

extern "C" void kernel_launch(void* const* d_in, const int* in_sizes, int n_in, void* d_out, int out_size, void* d_ws, size_t ws_size, hipStream_t stream) {
    if (n_in != 20 || in_sizes[0] != T * D || out_size != T * D || ws_size < WS_END) { fprintf(stderr, "kernel_launch: unexpected shapes / workspace (%d, %d, %d, %zu)\n", n_in, n_in > 0 ? in_sizes[0] : -1, out_size, ws_size); return; }
    static int grid_blocks = 0;
    if (!grid_blocks) {
        int dev = 0, cus = 0, per_cu = 0;
        (void)hipGetDevice(&dev); (void)hipDeviceGetAttribute(&cus, hipDeviceAttributeMultiprocessorCount, dev);
        (void)hipFuncSetAttribute((const void*)mega_fwd, hipFuncAttributeMaxDynamicSharedMemorySize, MK_LDS);
        (void)hipOccupancyMaxActiveBlocksPerMultiprocessor(&per_cu, (const void*)mega_fwd, NTHREADS, MK_LDS);
        if (per_cu < 1) { fprintf(stderr, "kernel_launch: occupancy query says %d blocks per CU\n", per_cu); per_cu = 1; }
        grid_blocks = cus * 1;
        if (grid_blocks % 8 != 0) grid_blocks -= grid_blocks % 8;
    }
    (void)hipMemsetAsync((char*)d_ws + WS_BAR, 0, XCD_BAR_WORDS * 4, stream);
    MArgs a{};
    a.x = (const float*)d_in[0]; a.positions = (const int*)d_in[1]; a.attn_norm_w = (const float*)d_in[2]; a.w_in = (const float*)d_in[3];
    a.lq1 = (const float*)d_in[4]; a.lk1 = (const float*)d_in[5]; a.lq2 = (const float*)d_in[6]; a.lk2 = (const float*)d_in[7];
    a.subln_w = (const float*)d_in[8]; a.pool_w = (const float*)d_in[9]; a.pool_scale = (const float*)d_in[10]; a.w_out = (const float*)d_in[11];
    a.ffn_norm_w = (const float*)d_in[12]; a.router_w = (const float*)d_in[13]; a.router_b = (const float*)d_in[14];
    a.w_gu = (const float*)d_in[15]; a.b_gu = (const float*)d_in[16]; a.w_down = (const float*)d_in[17]; a.b_down = (const float*)d_in[18]; a.final_w = (const float*)d_in[19];
    a.out = (float*)d_out; a.ws = (unsigned char*)d_ws;
    void* args[] = {&a};
    hipError_t e = hipLaunchCooperativeKernel((const void*)mega_fwd, dim3(grid_blocks), dim3(NTHREADS), args, MK_LDS, stream);
    if (e != hipSuccess) fprintf(stderr, "cooperative launch failed: %s (grid %d)\n", hipGetErrorString(e), grid_blocks);
}
```

```cpp
#include <hip/hip_runtime.h>
#include <cstdint>
#include <cstdio>

typedef unsigned short bf16_t;
typedef short bf16x8 __attribute__((ext_vector_type(8)));
typedef float f32x4 __attribute__((ext_vector_type(4)));
typedef unsigned u32x4 __attribute__((ext_vector_type(4)));

constexpr int T = 65536, D = 1024, SEQ = 2048, INW = 2048, NE = 32, FF = 1024, TOPK = 4;
constexpr int NCHUNK = 1, TC = T / NCHUNK;
constexpr int TM = 256;
constexpr int PC = TC * TOPK + NE * TM;
constexpr float EPS = 1e-5f;

constexpr size_t MiB = 1u << 20;
constexpr size_t WS_CTL = 0;
constexpr size_t WS_RSTD = 524288;
constexpr size_t WS_BAR = 65536;
constexpr size_t WS_LTOK = 1 * MiB;
constexpr size_t WS_LGATE = 9 * MiB;
constexpr size_t WS_SLOT = 17 * MiB;
constexpr size_t WS_ROPE = 18 * MiB;
constexpr size_t WS_WIN = 22 * MiB;
constexpr size_t WS_WO = 26 * MiB;
constexpr size_t WS_WD = 28 * MiB;
constexpr size_t WS_WGU = 92 * MiB;
constexpr size_t WS_XN = 220 * MiB;
constexpr size_t WS_PROJ = 348 * MiB;
constexpr size_t WS_CAT = 604 * MiB;
constexpr size_t WS_HM = 348 * MiB;
constexpr size_t WS_YP = 612 * MiB;
constexpr size_t WS_XB = 876 * MiB;
constexpr size_t WS_END = 1004 * MiB;
static_assert(WS_HM + (size_t)PC * 1024 <= WS_YP && WS_YP + (size_t)PC * 1024 <= WS_XB && WS_XB + (size_t)T * 1024 * 2 <= WS_END && WS_CAT + (size_t)T * 1024 * 2 <= WS_XB, "ws map");

__device__ __forceinline__ int otid() { int t = threadIdx.x; asm volatile("" : "+v"(t)); return t; }
__device__ __forceinline__ unsigned f2bf(float f) { unsigned u = __float_as_uint(f); return (u + 0x7fffu + ((u >> 16) & 1u)) >> 16; }
__device__ __forceinline__ unsigned pk4_fp8(float a, float b, float c, float d) {
    a = fminf(fmaxf(a, -448.f), 448.f); b = fminf(fmaxf(b, -448.f), 448.f); c = fminf(fmaxf(c, -448.f), 448.f); d = fminf(fmaxf(d, -448.f), 448.f);
    unsigned w = 0; w = __builtin_amdgcn_cvt_pk_fp8_f32(a, b, w, false); w = __builtin_amdgcn_cvt_pk_fp8_f32(c, d, w, true); return w; }
constexpr float FP8_SX = 16.f, FP8_SW = 512.f, FP8_SH = 4.f, FP8_SY = 32.f;
__device__ __forceinline__ float bf2f(unsigned h) { return __uint_as_float(h << 16); }
__device__ __forceinline__ float wave_sum(float v) {
#pragma unroll
    for (int o = 1; o < 64; o <<= 1) v += __shfl_xor(v, o);
    return v;
}
__device__ __forceinline__ float wave_max(float v) {
#pragma unroll
    for (int o = 1; o < 64; o <<= 1) v = fmaxf(v, __shfl_xor(v, o));
    return v;
}

namespace pg8 {
#define PG8_LAS __attribute__((address_space(3)))
constexpr int BM = 256, BK = 64, HALF = 128, HTB = HALF * BK * 2  , STAGE_BYTES = 8 * HTB;
constexpr int MAXU = 36, PLAN_BYTES = MAXU * 32 + MAXU * 512, EPI_LDS = STAGE_BYTES + PLAN_BYTES + 64;
__host__ __device__ __forceinline__ int lds_byte(int r, int c) { return r * 128 + ((((c >> 3) ^ ((r >> 1) & 7))) << 4); }
__host__ __device__ __forceinline__ void stage_rc(int b, int& R, int& C) { R = b >> 7; C = ((((b >> 4) & 7) ^ ((R >> 1) & 7))) << 3; }
__host__ __device__ __forceinline__ int perm32(int rho) { const int n = rho >> 4, i = rho & 15; return 8 * (i >> 2) + 4 * n + (i & 3); }
__device__ __forceinline__ unsigned cvt_pk_bf16(float lo, float hi) { unsigned r; asm volatile("v_cvt_pk_bf16_f32 %0, %1, %2" : "=v"(r) : "v"(lo), "v"(hi)); return r; }

template <int IMM = 0>
__device__ __forceinline__ void glds16s(const void* sbase, unsigned voff, unsigned lds_dst) { unsigned keep;
    asm volatile("s_mov_b32 %0, m0\n\ts_mov_b32 m0, %3\n\ts_nop 0\n\tglobal_load_lds_dwordx4 %1, %2 offset:%4\n\ts_mov_b32 m0, %0" : "=&s"(keep) : "v"(voff), "s"(sbase), "s"(lds_dst), "i"(IMM) : "memory"); }
typedef int v4i_t __attribute__((ext_vector_type(4)));
typedef int v8i_t __attribute__((ext_vector_type(8)));
__device__ __forceinline__ v8i_t cat8(bf16x8 lo, bf16x8 hi) { return __builtin_shufflevector(__builtin_bit_cast(v4i_t, lo), __builtin_bit_cast(v4i_t, hi), 0, 1, 2, 3, 4, 5, 6, 7); }
__device__ __forceinline__ void mfma_fp8_inplace(f32x4& acc, v8i_t a, v8i_t b) {
    asm volatile("v_mfma_scale_f32_16x16x128_f8f6f4 %0, %1, %2, %0, %3, %3 op_sel_hi:[0,0,0]" : "+v"(acc) : "v"(a), "v"(b), "v"(0x7F7F7F7F)); }
struct Unit { int pm, pn, e, lt, ne; };

template <int ROWB, bool FP8, class Epi, class Plan>
__device__ __forceinline__ void gemm_phase(PG8_LAS unsigned char* lds, const bf16_t* gA_, const bf16_t* gBt_, const Plan& S, const Epi& E) {
    const int tid = otid(), wid = __builtin_amdgcn_readfirstlane(tid >> 6), lane = tid & 63, wr = wid >> 2, wc = wid & 3, fr = lane & 15, fq = lane >> 4;
    constexpr int nt = ROWB / 128;
    unsigned voffB[2];
#pragma unroll
    for (int i = 0; i < 2; ++i) { int R, C; stage_rc(tid * 16 + i * 8192, R, C); const int Rb = Epi::PERM ? ((R & ~31) + perm32(R & 31)) : R; voffB[i] = (unsigned)(Rb * ROWB + C * 2); }
    const size_t kstep = (size_t)(BK * 2);
    const size_t hstep = (size_t)HALF * ROWB;
    const size_t tstep = 2 * hstep;
    const unsigned ldsb_epi0 = (unsigned)__builtin_amdgcn_readfirstlane((unsigned)(__UINTPTR_TYPE__)lds + (unsigned)EPI_LDS);
    const unsigned ldsb = (unsigned)__builtin_amdgcn_readfirstlane((unsigned)(__UINTPTR_TYPE__)lds + (unsigned)wid * 1024u);
    const int aoff0 = lds_byte(wr * 64 + fr, fq * 8), aoff1 = lds_byte(wr * 64 + fr, 32 + fq * 8), boff0 = lds_byte(wc * 32 + fr, fq * 8), boff1 = lds_byte(wc * 32 + fr, 32 + fq * 8);
#define PG8_SA(b, h) (((b) * 2 + (h)) * HTB)
#define PG8_SB(b, h) ((4 + (b) * 2 + (h)) * HTB)
#define PG8_STAGE(bufoff, gbase, voff) do { _Pragma("unroll") for (int _i = 0; _i < 2; ++_i) glds16s<0>((gbase), (voff)[_i], ldsb + (unsigned)((bufoff) + _i * 8192)); } while (0)
#define PG8_STAGEK(bufoff, gbase, voff) do { _Pragma("unroll") for (int _i = 0; _i < 2; ++_i) glds16s<BK * 2>((gbase), (voff)[_i], ldsb + (unsigned)((bufoff) + _i * 8192)); } while (0)
#define PG8_LDA(dst, b, h) do { _Pragma("unroll") for (int m = 0; m < 4; ++m) { \
        if constexpr (FP8) dst##8[m] = cat8(*(const PG8_LAS bf16x8*)(lds + PG8_SA(b, h) + aoff0 + m * 2048), *(const PG8_LAS bf16x8*)(lds + PG8_SA(b, h) + aoff1 + m * 2048)); \
        else { dst[m][0] = *(const PG8_LAS bf16x8*)(lds + PG8_SA(b, h) + aoff0 + m * 2048); dst[m][1] = *(const PG8_LAS bf16x8*)(lds + PG8_SA(b, h) + aoff1 + m * 2048); } } } while (0)
#define PG8_LDB(dst, b, h) do { _Pragma("unroll") for (int n = 0; n < 2; ++n) { \
        if constexpr (FP8) dst##8[n] = cat8(*(const PG8_LAS bf16x8*)(lds + PG8_SB(b, h) + boff0 + n * 2048), *(const PG8_LAS bf16x8*)(lds + PG8_SB(b, h) + boff1 + n * 2048)); \
        else { dst[n][0] = *(const PG8_LAS bf16x8*)(lds + PG8_SB(b, h) + boff0 + n * 2048); dst[n][1] = *(const PG8_LAS bf16x8*)(lds + PG8_SB(b, h) + boff1 + n * 2048); } } } while (0)
#define PG8_MMA(ai, bj, At, Bt) do { __builtin_amdgcn_s_setprio(1); _Pragma("unroll") for (int m = 0; m < 4; ++m) _Pragma("unroll") for (int n = 0; n < 2; ++n) { \
        if constexpr (FP8) mfma_fp8_inplace(acc[ai][bj][m][n], Bt##8[n], At##8[m]); \
        else { _Pragma("unroll") for (int k = 0; k < 2; ++k) acc[ai][bj][m][n] = __builtin_amdgcn_mfma_f32_16x16x32_bf16(Bt[n][k], At[m][k], acc[ai][bj][m][n], 0, 0, 0); } } \
        __builtin_amdgcn_s_setprio(0); } while (0)
#define PG8_WAIT_V(n) asm volatile("s_waitcnt vmcnt(" #n ")" ::: "memory")
#define PG8_WAIT_L(n) asm volatile("s_waitcnt lgkmcnt(" #n ")" ::: "memory")
#define PG8_BAR __builtin_amdgcn_s_barrier()
#define PG8_SCHED __builtin_amdgcn_sched_barrier(0)
#define PG8_VOFF(dst, U, UI) do { const int _tv = otid(); _Pragma("unroll") for (int _i = 0; _i < 2; ++_i) { int _R, _C; stage_rc(_tv * 16 + _i * 8192, _R, _C); \
        _Pragma("unroll") for (int _h = 0; _h < 2; ++_h) dst[_h][_i] = S.rowA(U, UI, _h * HALF + _R) * (unsigned)ROWB + (unsigned)(_C * 2); } } while (0)
#define PG8_SP1A(A1) do { \
          \
        PG8_LDB(B0, 0, 0); PG8_LDB(B1, 0, 1); PG8_SCHED; PG8_LDA(At, 0, 0); PG8_STAGE(PG8_SA(1, 1), (A1), vc[1]); \
        PG8_WAIT_V(8); PG8_WAIT_L(0); PG8_BAR; PG8_MMA(0, 0, At, B0); PG8_MMA(0, 1, At, B1); PG8_BAR; PG8_SCHED; } while (0)
#define PG8_REST(A2, B2) do { \
          \
        PG8_LDA(At, 0, 1); PG8_STAGE(PG8_SB(0, 0), (B2), voffB); PG8_STAGE(PG8_SB(0, 1), (B2) + hstep, voffB); PG8_STAGE(PG8_SA(0, 0), (A2), vc[0]); \
        PG8_WAIT_V(8); PG8_WAIT_L(0); PG8_BAR; PG8_MMA(1, 0, At, B0); PG8_MMA(1, 1, At, B1); PG8_BAR; PG8_SCHED; \
          \
        PG8_LDB(B0, 1, 0); PG8_LDB(B1, 1, 1); PG8_SCHED; PG8_LDA(At, 1, 0); PG8_STAGE(PG8_SA(0, 1), (A2), vc[1]); \
        PG8_WAIT_V(8); PG8_WAIT_L(0); PG8_BAR; PG8_MMA(0, 0, At, B0); PG8_MMA(0, 1, At, B1); PG8_BAR; PG8_SCHED; \
          \
        PG8_LDA(At, 1, 1); PG8_STAGE(PG8_SB(1, 0), (B2) + kstep, voffB); PG8_STAGE(PG8_SB(1, 1), (B2) + kstep + hstep, voffB); PG8_STAGE(PG8_SA(1, 0), (A2) + kstep, vc[0]); \
        PG8_WAIT_V(8); PG8_WAIT_L(0); PG8_BAR; PG8_MMA(1, 0, At, B0); PG8_MMA(1, 1, At, B1); PG8_BAR; PG8_SCHED; } while (0)
    Unit cur, nxt; int ui = 0;
    if (!S.next(0, cur)) return;
    f32x4 acc[2][2][4][2];
#pragma unroll
    for (int a = 0; a < 2; ++a)
#pragma unroll
        for (int b = 0; b < 2; ++b)
#pragma unroll
            for (int m = 0; m < 4; ++m)
#pragma unroll
                for (int n = 0; n < 2; ++n) acc[a][b][m][n] = (f32x4){0.f, 0.f, 0.f, 0.f};
    bf16x8 At[4][2], B0[2][2], B1[2][2]; v8i_t At8[4], B08[2], B18[2];
    unsigned vc[2][2];
    PG8_VOFF(vc, cur, 0);
    if (wid == 0) E.prefetch(cur, ldsb_epi0, lane);
    const char* gA = (const char*)gA_; const char* cB = (const char*)gBt_ + (size_t)cur.pn * tstep;
    PG8_STAGE(PG8_SB(0, 0), cB, voffB); PG8_STAGE(PG8_SB(0, 1), cB + hstep, voffB); PG8_STAGE(PG8_SA(0, 0), gA, vc[0]); PG8_STAGE(PG8_SA(0, 1), gA, vc[1]);
    if (wr == 1) PG8_BAR;
    PG8_WAIT_V(2); PG8_BAR;
    PG8_STAGE(PG8_SB(1, 0), cB + kstep, voffB); PG8_STAGE(PG8_SA(1, 0), gA + kstep, vc[0]); PG8_STAGE(PG8_SB(1, 1), cB + hstep + kstep, voffB);
    PG8_WAIT_V(6); PG8_BAR;
    for (;;) {
        const bool has_next = S.next(ui + 1, nxt);
        const char* nB = has_next ? (const char*)gBt_ + (size_t)nxt.pn * tstep : cB;
#pragma clang loop unroll(disable)
        for (int t = 0; t < nt - 2; t += 2) { PG8_SP1A(gA + (size_t)(t + 1) * kstep); PG8_REST(gA + (size_t)(t + 2) * kstep, cB + (size_t)(t + 2) * kstep); }
        PG8_SP1A(gA + (size_t)(nt - 1) * kstep);
        if (has_next) PG8_VOFF(vc, nxt, ui + 1);
        PG8_REST(gA, nB);
        if constexpr (FP8) {
            asm volatile("s_nop 15\n\ts_nop 15" ::: "memory");
#pragma unroll
            for (int a = 0; a < 2; ++a)
#pragma unroll
                for (int b = 0; b < 2; ++b)
#pragma unroll
                    for (int m = 0; m < 4; ++m)
#pragma unroll
                        for (int n = 0; n < 2; ++n) asm volatile("" : "+v"(acc[a][b][m][n]));
        }
        if (wr == 0) PG8_BAR;
        E(acc, cur, lds + EPI_LDS + (ui & 1) * 1024);
        if (!has_next) break;
#pragma unroll
        for (int a = 0; a < 2; ++a)
#pragma unroll
            for (int b = 0; b < 2; ++b)
#pragma unroll
                for (int m = 0; m < 4; ++m)
#pragma unroll
                    for (int n = 0; n < 2; ++n) acc[a][b][m][n] = (f32x4){0.f, 0.f, 0.f, 0.f};
        cur = nxt; cB = nB; ++ui;
        if (wid == 0) E.prefetch(cur, ldsb_epi0 + (unsigned)((ui & 1) * 1024), lane);
        if (wr == 1) PG8_BAR;
    }
    PG8_WAIT_V(0);
    PG8_BAR;
#undef PG8_SA
#undef PG8_SB
#undef PG8_STAGE
#undef PG8_STAGEK
#undef PG8_LDA
#undef PG8_LDB
#undef PG8_MMA
#undef PG8_WAIT_V
#undef PG8_WAIT_L
#undef PG8_BAR
#undef PG8_SCHED
#undef PG8_VOFF
#undef PG8_SP1A
#undef PG8_REST
}

struct DensePlan {
    int nM, nN, nwg, G, c;
    __device__ void init(int M, int N, int G_, int c_) { nM = M / BM; nN = N / BM; nwg = nM * nN; G = G_; c = c_; }
    __device__ __forceinline__ bool next(int i, Unit& u) const {
        const long L = (long)i * G + c; if (L >= nwg) return false;
        int wgid = (int)L; { const int q = nwg / 8, r = nwg % 8, xcd = wgid % 8, off = wgid / 8; wgid = (xcd < r ? xcd * (q + 1) : r * (q + 1) + (xcd - r) * q) + off; }
        const int nig = 8 * nN, gid = wgid / nig, fm = gid * 8, gsz = (nM - fm) < 8 ? (nM - fm) : 8;
        u.pm = fm + ((wgid % nig) % gsz); u.pn = (wgid % nig) / gsz; u.e = 0; u.lt = 0; u.ne = 0; return true;
    }
    __device__ __forceinline__ unsigned rowA(const Unit& u, int, int r) const { return (unsigned)(u.pm * BM + r); }
};
template <bool GATHER>
struct MoePlan {
    const PG8_LAS int* desc; const PG8_LAS unsigned short* rowtab;
    __device__ __forceinline__ bool next(int i, Unit& u) const {
        if (i >= MAXU) return false;
        const PG8_LAS int* d = desc + i * 8;
        const int v = __builtin_amdgcn_readfirstlane(d[0]); u.pm = __builtin_amdgcn_readfirstlane(d[1]); u.pn = __builtin_amdgcn_readfirstlane(d[2]);
        u.e = __builtin_amdgcn_readfirstlane(d[3]); u.lt = __builtin_amdgcn_readfirstlane(d[4]); u.ne = __builtin_amdgcn_readfirstlane(d[5]); return v != 0;
    }
    __device__ __forceinline__ unsigned rowA(const Unit& u, int ui, int r) const { return GATHER ? (unsigned)rowtab[ui * 256 + r] : (unsigned)(u.pm * BM + r); }
};
template <bool GATHER>
__device__ __forceinline__ MoePlan<GATHER> moe_plan_setup(PG8_LAS unsigned char* tab, const int* cnt, const int* ltok, int NT, int G, int c) {
    PG8_LAS int* desc = (PG8_LAS int*)tab; PG8_LAS unsigned short* rowtab = (PG8_LAS unsigned short*)(tab + MAXU * 32);
    PG8_LAS int* cs = (PG8_LAS int*)rowtab;
    PG8_LAS int* bs = cs + 32;
    const int tid = otid(), xcd = c & 7, j = c >> 3;
    if (tid < 32) cs[tid] = __hip_atomic_load(cnt + tid, __ATOMIC_RELAXED, __HIP_MEMORY_SCOPE_AGENT);
    __syncthreads();
    if (tid < 64) { const int ln = tid & 63; int v = (ln < 32) ? (cs[ln & 31] + BM - 1) / BM : 0, incl = v;
#pragma unroll
        for (int o = 1; o < 32; o <<= 1) { const int up = __shfl_up(incl, o); if (ln >= o) incl += up; }
        if (ln < 32) bs[ln] = incl - v; if (ln == 31) bs[32] = incl; }
    __syncthreads();
    if (tid < MAXU) {
        const int q = tid * (G >> 3) + j, mt = (q / NT) * 8 + xcd, pnl = q % NT;
        int e = -1;
        for (int k = 0; k < 32; ++k) if (mt >= bs[k] && mt < bs[k + 1]) e = k;
        desc[tid * 8 + 0] = e >= 0 ? 1 : 0; desc[tid * 8 + 1] = mt; desc[tid * 8 + 2] = (e >= 0 ? e : 0) * NT + pnl; desc[tid * 8 + 3] = e;
        desc[tid * 8 + 4] = e >= 0 ? mt - bs[e] : 0; desc[tid * 8 + 5] = e >= 0 ? cs[e] : 0;
    }
    __syncthreads();
    if (GATHER && tid < 256) {
        for (int i = 0; i < MAXU; ++i) {
            const PG8_LAS int* d = desc + i * 8; const int valid = d[0], e = d[3], lt = d[4], ne = d[5];
            const int p = lt * BM + tid; rowtab[i * 256 + tid] = (unsigned short)((valid && p < ne) ? ltok[(size_t)e * TC + p] : 0);
        }
    }
    __syncthreads();
    MoePlan<GATHER> S; S.desc = desc; S.rowtab = rowtab; return S;
}

struct EpiBf16 {
    __device__ __forceinline__ void prefetch(const Unit& u, unsigned lds_dst, int lane) const { glds16s<0>(rstd + (size_t)u.pm * BM, (unsigned)(lane * 16), lds_dst); }
    static constexpr bool PERM = true;
    bf16_t* O; int ldc; const float* rope; int rope_tiles; const float* rstd;
    __device__ __forceinline__ void operator()(const f32x4 (&acc)[2][2][4][2], const Unit& u, const PG8_LAS unsigned char* el) const {
        const int tv_ = otid();
        const int wr = tv_ >> 8, wc = (tv_ >> 6) & 3, fr = tv_ & 15, fq = (tv_ >> 4) & 3;
        const int row0 = u.pm * BM + wr * 64 + fr, col0 = u.pn * BM + wc * 32 + 8 * fq;
        const bool rot = (u.pn < rope_tiles) && ((__builtin_amdgcn_readfirstlane(tv_ >> 6) & 1) == 0);
#pragma unroll
        for (int ai = 0; ai < 2; ++ai) {
            f32x4 rc[4][4];
            if (rot) {
#pragma unroll
                for (int m = 0; m < 4; ++m) { const float* rp = rope + (size_t)(row0 + ai * HALF + m * 16) * 16;
#pragma unroll
                    for (int q = 0; q < 4; ++q) rc[m][q] = *(const f32x4*)(rp + 4 * q); }
                asm volatile("" ::: "memory");
            }
#pragma unroll
            for (int m = 0; m < 4; ++m) { const int row = row0 + ai * HALF + m * 16; bf16_t* rowp = O + (size_t)row * ldc + col0;
                const float rsd = ((const PG8_LAS float*)el)[wr * 64 + fr + ai * HALF + m * 16];
                f32x4 cs0, cs1, sn0, sn1;
                if (rot) { cs0 = rc[m][0]; cs1 = rc[m][1]; sn0 = rc[m][2]; sn1 = rc[m][3];
                    if (fq == 0) { sn0 = -sn0; sn1 = -sn1; } }
#pragma unroll
                for (int bj = 0; bj < 2; ++bj) { f32x4 v0 = acc[ai][bj][m][0] * rsd, v1 = acc[ai][bj][m][1] * rsd;
                    if (rot) { f32x4 p0, p1;
#pragma unroll
                        for (int j = 0; j < 4; ++j) { p0[j] = __shfl_xor(v0[j], 16); p1[j] = __shfl_xor(v1[j], 16); }
                        if (fq < 2) { v0 = v0 * cs0 + p0 * sn0; v1 = v1 * cs1 + p1 * sn1; } }
                    u32x4 w; w.x = cvt_pk_bf16(v0[0], v0[1]); w.y = cvt_pk_bf16(v0[2], v0[3]); w.z = cvt_pk_bf16(v1[0], v1[1]); w.w = cvt_pk_bf16(v1[2], v1[3]);
                    *(u32x4*)(rowp + bj * HALF) = w; } }
        }
    }
};
struct EpiResBf16 {
    __device__ __forceinline__ void prefetch(const Unit&, unsigned, int) const {}
    static constexpr bool PERM = true;
    bf16_t* XB; const bf16_t* resid; int ldc;
    __device__ __forceinline__ void operator()(const f32x4 (&acc)[2][2][4][2], const Unit& u, const PG8_LAS unsigned char* el) const {
        const int tv_ = otid();
        const int wr = tv_ >> 8, wc = (tv_ >> 6) & 3, fr = tv_ & 15, fq = (tv_ >> 4) & 3;
        const int row0 = u.pm * BM + wr * 64 + fr, col0 = u.pn * BM + wc * 32 + 8 * fq;
        u32x4 xr[2][4][2];
#pragma unroll
        for (int ai = 0; ai < 2; ++ai)
#pragma unroll
            for (int m = 0; m < 4; ++m)
#pragma unroll
                for (int bj = 0; bj < 2; ++bj) xr[ai][m][bj] = *(const u32x4*)(resid + (size_t)(row0 + ai * HALF + m * 16) * ldc + col0 + bj * HALF);
        asm volatile("" ::: "memory");
#pragma unroll
        for (int ai = 0; ai < 2; ++ai)
#pragma unroll
            for (int m = 0; m < 4; ++m) { const size_t off = (size_t)(row0 + ai * HALF + m * 16) * ldc + col0;
#pragma unroll
                for (int bj = 0; bj < 2; ++bj) { const u32x4 x4 = xr[ai][m][bj];
                    const f32x4 v0 = (f32x4){__uint_as_float(x4.x << 16), __uint_as_float(x4.x & 0xffff0000u), __uint_as_float(x4.y << 16), __uint_as_float(x4.y & 0xffff0000u)} + acc[ai][bj][m][0],
                                v1 = (f32x4){__uint_as_float(x4.z << 16), __uint_as_float(x4.z & 0xffff0000u), __uint_as_float(x4.w << 16), __uint_as_float(x4.w & 0xffff0000u)} + acc[ai][bj][m][1];
                    u32x4 w; w.x = cvt_pk_bf16(v0[0], v0[1]); w.y = cvt_pk_bf16(v0[2], v0[3]); w.z = cvt_pk_bf16(v1[0], v1[1]); w.w = cvt_pk_bf16(v1[2], v1[3]);
                    *(u32x4*)(XB + off + bj * HALF) = w; } }
    }
};
struct EpiGLU {
    static constexpr bool PERM = true;
    bf16_t* HM; const float* b_gu; int NT;
    __device__ __forceinline__ void prefetch(const Unit& u, unsigned lds_dst, int lane) const {
        const int pnl = u.pn - u.e * NT; glds16s<0>(b_gu + (size_t)u.e * 2048 + pnl * HALF, (unsigned)((lane & 31) * 16 + (lane >> 5) * 4096), lds_dst); }
    __device__ __forceinline__ void operator()(const f32x4 (&acc)[2][2][4][2], const Unit& u, const PG8_LAS unsigned char* el) const {
        const int tv_ = otid();
        const int wr = tv_ >> 8, wc = (tv_ >> 6) & 3, fr = tv_ & 15, fq = (tv_ >> 4) & 3;
        const int pnl = u.pn - u.e * NT, f0 = pnl * HALF + wc * 32 + 8 * fq, row0 = u.pm * BM + wr * 64 + fr;
        const PG8_LAS float* bl = (const PG8_LAS float*)el + wc * 32 + 8 * fq;
        f32x4 bgt[2], bup[2];
#pragma unroll
        for (int n = 0; n < 2; ++n) { bgt[n] = *(const PG8_LAS f32x4*)(bl + 4 * n); bup[n] = *(const PG8_LAS f32x4*)(bl + 128 + 4 * n); }
        constexpr float rs = 1.0f / (FP8_SX * FP8_SW);
#pragma unroll
        for (int ai = 0; ai < 2; ++ai)
#pragma unroll
            for (int m = 0; m < 4; ++m) { float h[8];
#pragma unroll
                for (int n = 0; n < 2; ++n)
#pragma unroll
                    for (int j = 0; j < 4; ++j) { const float gv = fminf(acc[ai][0][m][n][j] * rs + bgt[n][j], 7.0f), uv = fminf(fmaxf(acc[ai][1][m][n][j] * rs + bup[n][j], -7.0f), 7.0f);
                        h[4 * n + j] = (uv + 1.0f) * gv * __builtin_amdgcn_rcpf(1.0f + __expf(-1.702f * gv)); }
                const unsigned long long w = (unsigned long long)pk4_fp8(h[0] * FP8_SH, h[1] * FP8_SH, h[2] * FP8_SH, h[3] * FP8_SH) | ((unsigned long long)pk4_fp8(h[4] * FP8_SH, h[5] * FP8_SH, h[6] * FP8_SH, h[7] * FP8_SH) << 32);
                *(unsigned long long*)((unsigned char*)HM + (size_t)(row0 + ai * HALF + m * 16) * FF + f0) = w; }
    }
};
struct EpiDown {
    static constexpr bool PERM = true;
    bf16_t* YP; const float* b_d; int NT;
    __device__ __forceinline__ void prefetch(const Unit& u, unsigned lds_dst, int lane) const {
        const int pnl = u.pn - u.e * NT; glds16s<0>(b_d + (size_t)u.e * 1024 + pnl * BM, (unsigned)(lane * 16), lds_dst); }
    __device__ __forceinline__ void operator()(const f32x4 (&acc)[2][2][4][2], const Unit& u, const PG8_LAS unsigned char* el) const {
        const int tv_ = otid();
        const int wr = tv_ >> 8, wc = (tv_ >> 6) & 3, fr = tv_ & 15, fq = (tv_ >> 4) & 3;
        const int pnl = u.pn - u.e * NT, col0 = pnl * BM + wc * 32 + 8 * fq, rl0 = wr * 64 + fr;
        const PG8_LAS float* bl = (const PG8_LAS float*)el + wc * 32 + 8 * fq;
        f32x4 bv[2][2];
#pragma unroll
        for (int bj = 0; bj < 2; ++bj)
#pragma unroll
            for (int n = 0; n < 2; ++n) bv[bj][n] = *(const PG8_LAS f32x4*)(bl + bj * HALF + 4 * n);
        constexpr float sa = FP8_SY / (FP8_SH * FP8_SW);
#pragma unroll
        for (int ai = 0; ai < 2; ++ai)
#pragma unroll
            for (int m = 0; m < 4; ++m) { const int rl = rl0 + ai * HALF + m * 16;
                unsigned char* rowp = (unsigned char*)YP + (size_t)(u.pm * BM + rl) * D + col0;
#pragma unroll
                for (int bj = 0; bj < 2; ++bj) { const f32x4 v0 = acc[ai][bj][m][0] * sa + bv[bj][0] * FP8_SY, v1 = acc[ai][bj][m][1] * sa + bv[bj][1] * FP8_SY;
                    *(unsigned long long*)(rowp + bj * HALF) = (unsigned long long)pk4_fp8(v0[0], v0[1], v0[2], v0[3]) | ((unsigned long long)pk4_fp8(v1[0], v1[1], v1[2], v1[3]) << 32); } }
    }
};
}


namespace dattn {
typedef float f32x16 __attribute__((ext_vector_type(16)));
typedef short s16x4 __attribute__((ext_vector_type(4)));
constexpr int NW = 8, QBLK = 32, KVBLK = 64, QB = NW * QBLK, DK = 64, DV = 128, RS = INW;
constexpr int SHM_V = KVBLK * DV * 2, SHM_K = KVBLK * DK * 2;
constexpr int NVB = 4;
constexpr int LDS_V = 0, LDS_K = NVB * SHM_V, LDS_WS = LDS_K + 2 * SHM_K, LDS_OST = LDS_WS + NW * 64 * 4, LDS_BYTES = LDS_OST + NW * 8192;
constexpr float SCALE = 0.125f, THR = 8.f;
#define KSWZ64(row, colB) ((row) * 128 + ((colB) ^ ((((row) >> 1) & 7) << 4)))
#define SBAR() __builtin_amdgcn_sched_barrier(0)
__device__ __forceinline__ int v_slot_key(int p) { const int kk = ((p >> 7) << 3) | ((p & 31) >> 2); return (kk & ~0xC) | ((kk & 4) << 1) | ((kk & 8) >> 1); }
__device__ __forceinline__ int v_slot_col(int p) { return ((p >> 5) & 3) * 32 + (p & 3) * 8; }
__device__ __forceinline__ int v_rd_base(int lane) { return ((lane & 3) << 3) | (((lane >> 2) & 3) << 6) | (((lane >> 4) & 1) << 5) | (((lane >> 5) & 1) << 8); }
constexpr int v_rd_off(int d0, int ks, int half) { return d0 * 512 + ks * 4096 + half * 2048; }
__device__ __forceinline__ int crow(int r, int hi) { return (r & 3) + 8 * (r >> 2) + 4 * hi; }
__device__ __forceinline__ unsigned cvtpk(float lo, float hi) { unsigned r; asm volatile("v_cvt_pk_bf16_f32 %0, %1, %2" : "=v"(r) : "v"(lo), "v"(hi)); return r; }
__device__ __forceinline__ bf16x8 load8(const bf16_t* p) { return *reinterpret_cast<const bf16x8*>(p); }
__device__ __forceinline__ void mask_tile(f32x16& p0, f32x16& p1, int dq) {
    const float NEG = -__builtin_inff();
#pragma unroll
    for (int r = 0; r < 16; ++r) { const int c = (r & 3) + 8 * (r >> 2); if (dq - c < 0) p0[r] = NEG; if (dq - c - 32 < 0) p1[r] = NEG; }
}
__device__ __forceinline__ void partialSM(f32x16& p0, f32x16& p1, float& m_reg, float& mn, float& alpha) {
    float pmax = p0[0];
#pragma unroll
    for (int r = 1; r < 16; ++r) pmax = fmaxf(pmax, p0[r]);
#pragma unroll
    for (int r = 0; r < 16; ++r) pmax = fmaxf(pmax, p1[r]);
    { auto rr = __builtin_amdgcn_permlane32_swap(__float_as_uint(pmax), __float_as_uint(pmax), false, false); pmax = fmaxf(__uint_as_float(rr[0]), __uint_as_float(rr[1])); }
    constexpr float C2 = 1.4426950408889634f * SCALE;
    if (__builtin_expect(__all((pmax - m_reg) * SCALE <= THR), 1)) { mn = m_reg; alpha = 1.f; }
    else { mn = fmaxf(m_reg, pmax); alpha = __builtin_amdgcn_exp2f((m_reg - mn) * C2); m_reg = mn; }
    const float mnL = -mn * C2;
#pragma unroll
    for (int r = 0; r < 16; ++r) p0[r] = fmaf(p0[r], C2, mnL);
#pragma unroll
    for (int r = 0; r < 16; ++r) p1[r] = fmaf(p1[r], C2, mnL);
#pragma unroll
    for (int r = 0; r < 16; ++r) p0[r] = __builtin_amdgcn_exp2f(p0[r]);
}
__device__ __forceinline__ void finishSM(f32x16& p0, f32x16& p1, float alpha, float& l_reg, bf16x8& pa0, bf16x8& pa1, bf16x8& pa2, bf16x8& pa3) {
#pragma unroll
    for (int r = 0; r < 16; ++r) p1[r] = __builtin_amdgcn_exp2f(p1[r]);
    float ps = 0;
#pragma unroll
    for (int r = 0; r < 16; ++r) ps += p0[r];
#pragma unroll
    for (int r = 0; r < 16; ++r) ps += p1[r];
    { auto rr = __builtin_amdgcn_permlane32_swap(__float_as_uint(ps), __float_as_uint(ps), false, false); ps = __uint_as_float(rr[0]) + __uint_as_float(rr[1]); }
    l_reg = l_reg * alpha + ps;
#define PK4(P, B_, OUT) do { unsigned a0 = cvtpk(P[B_+0], P[B_+1]), a1 = cvtpk(P[B_+2], P[B_+3]);                          \
        unsigned b0 = cvtpk(P[B_+4], P[B_+5]), b1 = cvtpk(P[B_+6], P[B_+7]);                                             \
        auto r0 = __builtin_amdgcn_permlane32_swap(a0, b0, false, false); auto r1 = __builtin_amdgcn_permlane32_swap(a1, b1, false, false); \
        u32x4 w = {r0[0], r1[0], r0[1], r1[1]}; OUT = *reinterpret_cast<bf16x8*>(&w); } while (0)
    PK4(p0, 0, pa0); PK4(p0, 8, pa1); PK4(p1, 0, pa2); PK4(p1, 8, pa3);
#undef PK4
}
template <int KB>
__device__ __forceinline__ void qkt(f32x16& p0, f32x16& p1, const char* K_lds, int r32, int hi, const bf16x8* qr) {
    p0 = f32x16{}; p1 = f32x16{};
#pragma unroll
    for (int d0 = 0; d0 < 4; ++d0) { const char* a = K_lds + KB * SHM_K + KSWZ64(r32, (d0 * 16 + hi * 8) * 2);
        bf16x8 b0 = *reinterpret_cast<const bf16x8*>(a);
        bf16x8 b1 = *reinterpret_cast<const bf16x8*>(a + 32 * 128);
        p0 = __builtin_amdgcn_mfma_f32_32x32x16_bf16(b0, qr[d0], p0, 0, 0, 0);
        p1 = __builtin_amdgcn_mfma_f32_32x32x16_bf16(b1, qr[d0], p1, 0, 0, 0); }
}
template <int VB>
__device__ __forceinline__ void pv_tile(f32x16* o, int vb0, bf16x8 pa0, bf16x8 pa1, bf16x8 pa2, bf16x8 pa3) {
#define TRRD(dst, off) asm volatile("ds_read_b64_tr_b16 %0, %1 offset:%2" : "=&v"(dst) : "v"(vb0), "i"(off) : "memory")
#define PV_RD(S, d0) do { constexpr int b_ = LDS_V + VB * SHM_V + v_rd_off(d0, 0, 0); \
        TRRD(S##l0, b_); TRRD(S##h0, b_ + 2048); TRRD(S##l1, b_ + 4096); TRRD(S##h1, b_ + 6144); TRRD(S##l2, b_ + 8192); TRRD(S##h2, b_ + 10240); TRRD(S##l3, b_ + 12288); TRRD(S##h3, b_ + 14336); } while (0)
#define PV_MM(S, d0) do { \
        o[d0] = __builtin_amdgcn_mfma_f32_32x32x16_bf16(pa0, (bf16x8){S##l0[0], S##l0[1], S##l0[2], S##l0[3], S##h0[0], S##h0[1], S##h0[2], S##h0[3]}, o[d0], 0, 0, 0);   \
        o[d0] = __builtin_amdgcn_mfma_f32_32x32x16_bf16(pa1, (bf16x8){S##l1[0], S##l1[1], S##l1[2], S##l1[3], S##h1[0], S##h1[1], S##h1[2], S##h1[3]}, o[d0], 0, 0, 0);   \
        o[d0] = __builtin_amdgcn_mfma_f32_32x32x16_bf16(pa2, (bf16x8){S##l2[0], S##l2[1], S##l2[2], S##l2[3], S##h2[0], S##h2[1], S##h2[2], S##h2[3]}, o[d0], 0, 0, 0);   \
        o[d0] = __builtin_amdgcn_mfma_f32_32x32x16_bf16(pa3, (bf16x8){S##l3[0], S##l3[1], S##l3[2], S##l3[3], S##h3[0], S##h3[1], S##h3[2], S##h3[3]}, o[d0], 0, 0, 0); } while (0)
#define LGK(n) do { asm volatile("s_waitcnt lgkmcnt(" #n ")" ::: "memory"); SBAR(); } while (0)
    s16x4 Al0, Al1, Al2, Al3, Ah0, Ah1, Ah2, Ah3, Bl0, Bl1, Bl2, Bl3, Bh0, Bh1, Bh2, Bh3;
    PV_RD(A, 0); PV_RD(B, 1); LGK(8); PV_MM(A, 0); SBAR();
    PV_RD(A, 2); LGK(8); PV_MM(B, 1); SBAR();
    PV_RD(B, 3); LGK(8); PV_MM(A, 2); SBAR();
    LGK(0); PV_MM(B, 3);
#undef PV_RD
#undef PV_MM
#undef LGK
#undef TRRD
}
struct BlockRef { const bf16_t* Q; const bf16_t* K; const bf16_t* V; bf16_t* OUT; int P0, c; };
struct Seam { bf16x8 qr[4]; };
#define DA_VMW() asm volatile("s_waitcnt vmcnt(0)" ::: "memory")
#define DA_KDMA(Kp, k0, bf) pg8::glds16s<0>((Kp) + (size_t)(k0) * RS, kvo, kdst + (unsigned)((bf) * SHM_K))
#define DA_VDMA(Vp, k0, bf) do { pg8::glds16s<0>((Vp) + (size_t)(k0) * RS, vvo0, vdst + (unsigned)((bf) * SHM_V)); pg8::glds16s<0>((Vp) + (size_t)(k0) * RS, vvo1, vdst + (unsigned)((bf) * SHM_V + 8192)); } while (0)
#define DA_ADDR() \
    const int kr = tid >> 3; \
    const unsigned kvo = (unsigned)(kr * RS + (((tid & 7) ^ ((kr >> 1) & 7)) * 8)) * 2u, kdst = (unsigned)__builtin_amdgcn_readfirstlane((unsigned)(uintptr_t)lds + LDS_K + wid * 1024); \
    const unsigned vvo0 = (unsigned)(v_slot_key(tid) * RS + v_slot_col(tid)) * 2u, vvo1 = (unsigned)(v_slot_key(tid + 512) * RS + v_slot_col(tid + 512)) * 2u, \
                   vdst = (unsigned)__builtin_amdgcn_readfirstlane((unsigned)(uintptr_t)lds + LDS_V + wid * 1024)
__device__ __forceinline__ void prime(const BlockRef& cur, char* lds, Seam& S) {
    const int tid = otid(), wid = __builtin_amdgcn_readfirstlane(tid >> 6), lane = tid & 63, r32 = lane & 31, hi = lane >> 5;
    DA_ADDR();
#pragma unroll
    for (int d0 = 0; d0 < 4; ++d0) S.qr[d0] = load8(cur.Q + (size_t)(wid * QBLK + r32) * RS + d0 * 16 + hi * 8);
    DA_KDMA(cur.K, 0, 0); DA_VDMA(cur.V, 0, 0); DA_VMW();
    __syncthreads();
}
__device__ __forceinline__ void block(const BlockRef& cur, const BlockRef& nxt, char* lds, Seam& S, float lam, const float* __restrict__ subln_w) {
    const int tid = otid(), wid = __builtin_amdgcn_readfirstlane(tid >> 6), lane = tid & 63, r32 = lane & 31, hi = lane >> 5;
    const int NT = (cur.P0 + QB) / KVBLK;
    const int qlo = cur.P0 + wid * QBLK, qm = qlo + r32 - 4 * hi;
    char* K_lds = lds + LDS_K;
    float* ws = (float*)(lds + LDS_WS) + wid * 64; float* li_l = ws; float* al_l = ws + 32;
    float m_reg = -1e30f, l_reg = 0; f32x16 o[4] = {};
    DA_ADDR();
    const int vb0 = (int)(uintptr_t)lds + v_rd_base(lane);
    const bf16_t* Kh = cur.K; const bf16_t* Vh = cur.V;
#define RESC(a) do { if (__any((a) < 1.f)) { if (hi == 0) al_l[r32] = (a); asm volatile("s_waitcnt lgkmcnt(0)" ::: "memory");              \
                     _Pragma("unroll") for (int d_ = 0; d_ < 4; ++d_) _Pragma("unroll") for (int r = 0; r < 16; ++r) o[d_][r] *= al_l[crow(r, hi)]; } } while (0)
#define KBASE(t) ((t) * KVBLK)
#define MASKT(P0_, P1_, t) do { const int kb_ = KBASE(t); if (kb_ + KVBLK - 1 > qlo) mask_tile(P0_, P1_, qm - kb_); } while (0)
    f32x16 pA0, pA1, pB0, pB1; float mnA, mnB, alA, alB; bf16x8 pa0, pa1, pa2, pa3;
    DA_KDMA(Kh, KBASE(1), 1); DA_VDMA(Vh, KBASE(1), 1);
    SBAR(); qkt<0>(pA0, pA1, K_lds, r32, hi, S.qr);
    MASKT(pA0, pA1, 0); partialSM(pA0, pA1, m_reg, mnA, alA);
    DA_VMW(); __syncthreads();
#define HALF_STEP(PX0, PX1, mnX, alX, PY0, PY1, alY, t, KB, VBP, KBN, VBN) do {                                               \
        SBAR(); qkt<KB>(PX0, PX1, K_lds, r32, hi, S.qr);                                                                      \
        finishSM(PY0, PY1, alY, l_reg, pa0, pa1, pa2, pa3); SBAR();                                                           \
        DA_KDMA(Kh, KBASE((t) + 1), KBN); DA_VDMA(Vh, KBASE((t) + 1), VBN); SBAR();                                          \
        pv_tile<VBP>(o, vb0, pa0, pa1, pa2, pa3); MASKT(PX0, PX1, (t)); partialSM(PX0, PX1, m_reg, mnX, alX);                  \
        RESC(alX); DA_VMW(); __syncthreads(); } while (0)
    HALF_STEP(pB0, pB1, mnB, alB, pA0, pA1, alA, 1, 1, 0, 0, 2);
    HALF_STEP(pA0, pA1, mnA, alA, pB0, pB1, alB, 2, 0, 1, 1, 3);
    for (int t = 3; t + 1 < NT; t += 4) {
        HALF_STEP(pB0, pB1, mnB, alB, pA0, pA1, alA, t, 1, 2, 0, 0);
        HALF_STEP(pA0, pA1, mnA, alA, pB0, pB1, alB, t + 1, 0, 3, 1, 1);
        HALF_STEP(pB0, pB1, mnB, alB, pA0, pA1, alA, t + 2, 1, 0, 0, 2);
        HALF_STEP(pA0, pA1, mnA, alA, pB0, pB1, alB, t + 3, 0, 1, 1, 3);
    }
    SBAR(); qkt<1>(pB0, pB1, K_lds, r32, hi, S.qr); SBAR();
    DA_KDMA(nxt.K, 0, 0); DA_VDMA(nxt.V, 0, 0); SBAR();
#pragma unroll
    for (int d0 = 0; d0 < 4; ++d0) S.qr[d0] = load8(nxt.Q + (size_t)(wid * QBLK + r32) * RS + d0 * 16 + hi * 8);
    SBAR();
    finishSM(pA0, pA1, alA, l_reg, pa0, pa1, pa2, pa3); SBAR();
    pv_tile<2>(o, vb0, pa0, pa1, pa2, pa3);
    MASKT(pB0, pB1, NT - 1); partialSM(pB0, pB1, m_reg, mnB, alB); RESC(alB);
    finishSM(pB0, pB1, alB, l_reg, pa0, pa1, pa2, pa3); SBAR(); pv_tile<3>(o, vb0, pa0, pa1, pa2, pa3);
    SBAR();
    if (hi == 0) li_l[r32] = l_reg;
    asm volatile("s_waitcnt lgkmcnt(0)" ::: "memory");
    float rli[16];
#pragma unroll
    for (int r = 0; r < 16; ++r) rli[r] = __builtin_amdgcn_rcpf(li_l[crow(r, hi)]);
    unsigned* ostw = (unsigned*)(lds + LDS_OST + wid * 8192);
    if (cur.c == 1) {
#pragma unroll
        for (int d0 = 0; d0 < 4; ++d0)
#pragma unroll
            for (int r = 0; r < 16; r += 2) ostw[(d0 * 8 + (r >> 1)) * 64 + lane] = cvtpk(o[d0][r] * rli[r], o[d0][r + 1] * rli[r + 1]);
    } else {
        float ss[16];
#pragma unroll
        for (int r = 0; r < 16; ++r) ss[r] = 0.f;
#pragma unroll
        for (int d0 = 0; d0 < 4; ++d0)
#pragma unroll
            for (int r = 0; r < 16; r += 2) { const unsigned u = ostw[(d0 * 8 + (r >> 1)) * 64 + lane];
                const float v0 = o[d0][r] * rli[r] - lam * __uint_as_float(u << 16), v1 = o[d0][r + 1] * rli[r + 1] - lam * __uint_as_float(u & 0xffff0000u);
                o[d0][r] = v0; o[d0][r + 1] = v1; ss[r] += v0 * v0; ss[r + 1] += v1 * v1; }
#pragma unroll
        for (int msk = 1; msk < 32; msk <<= 1)
#pragma unroll
            for (int r = 0; r < 16; ++r) ss[r] += __shfl_xor(ss[r], msk);
        float sw[4];
#pragma unroll
        for (int d0 = 0; d0 < 4; ++d0) sw[d0] = subln_w[d0 * 32 + r32] * 0.8f;
        asm volatile("s_waitcnt lgkmcnt(0)" ::: "memory");
        bf16_t* stg = (bf16_t*)ostw;
#pragma unroll
        for (int r = 0; r < 16; ++r) { const float rs = 1.0f / sqrtf(ss[r] * (1.f / 128.f) + EPS); const int orow = crow(r, hi);
#pragma unroll
            for (int d0 = 0; d0 < 4; ++d0) stg[orow * 128 + d0 * 32 + r32] = (bf16_t)f2bf(o[d0][r] * rs * sw[d0]); }
        asm volatile("s_waitcnt lgkmcnt(0)" ::: "memory");
        bf16_t* Ow = cur.OUT + (size_t)(wid * QBLK) * D;
#pragma unroll
        for (int i = 0; i < 8; ++i) { const int row = i * 4 + (lane >> 4), ch = lane & 15; const u32x4 v = *(const u32x4*)(stg + row * 128 + ch * 8); *(u32x4*)(Ow + (size_t)row * D + ch * 8) = v; }
    }
    DA_VMW();
    __syncthreads();
#undef RESC
#undef KBASE
#undef MASKT
#undef HALF_STEP
}
#undef DA_VMW
#undef DA_KDMA
#undef DA_VDMA
#undef DA_ADDR
__device__ __forceinline__ BlockRef ref_of(int L, int seq, const bf16_t* PROJ, bf16_t* CAT) {
    const int bh = L >> 2, y = L & 3, b = bh >> 2, h = bh & 3, qb = (seq < 2) ? y : 7 - y, c = (seq & 1) ? 0 : 1;
    BlockRef r; const size_t row0 = (size_t)b * SEQ;
    r.Q = PROJ + (row0 + (size_t)qb * QB) * RS + h * 128 + c * 64; r.K = PROJ + row0 * RS + 512 + h * 128 + c * 64; r.V = PROJ + row0 * RS + 1024 + h * 128;
    r.OUT = CAT + (row0 + (size_t)qb * QB) * D + h * 128; r.P0 = qb * QB; r.c = c; return r;
}
__device__ __forceinline__ void phase(char* lds, const bf16_t* PROJ, bf16_t* CAT, float lam, const float* subln_w, int G, int bid) {
    constexpr int TOTAL = (T / SEQ) * 4 * 4;
    const int v = (G % 8 == 0) ? (bid & 7) * (G >> 3) + (bid >> 3) : bid;
    int L = v; if (L >= TOTAL) return;
    int seq = 0; BlockRef cur = ref_of(L, 0, PROJ, CAT);
    Seam S; prime(cur, lds, S);
    for (;;) {
        int Ln = L, seqn = seq + 1; if (seqn == 4) { seqn = 0; Ln = L + G; }
        const bool last = Ln >= TOTAL;
        const BlockRef nxt = last ? cur : ref_of(Ln, seqn, PROJ, CAT);
        block(cur, nxt, lds, S, lam, subln_w);
        if (last) break;
        cur = nxt; L = Ln; seq = seqn;
    }
}
#undef KSWZ64
#undef SBAR
}


#define LAS __attribute__((address_space(3)))
constexpr int NWAVES = 8, NTHREADS = 512;
namespace rtr {
typedef float f32x2 __attribute__((ext_vector_type(2)));
constexpr int WPITCH = 2064;
constexpr int LDS_WHI = 0, LDS_WLO = 32 * WPITCH, LDS_LG = 64 * WPITCH, LDS_CNT = LDS_LG + 8 * 16 * 33 * 4, LDS_BYTES = LDS_CNT + 256;
static_assert(LDS_BYTES <= pg8::STAGE_BYTES + pg8::PLAN_BYTES, "router LDS overlaps the grid barrier's LDS words");
__device__ __forceinline__ void phase(LAS unsigned char* lds, const bf16_t* __restrict__ x1, const float* __restrict__ fw, const float* __restrict__ rw, const float* __restrict__ rb,
                                      int* cnt, int* ltok, float* lgate, int* slot, unsigned char* __restrict__ XQ, int G, int bid) {
    const int tid = otid(), lane = tid & 63, wid = __builtin_amdgcn_readfirstlane(tid >> 6), r = lane & 15, q = lane >> 4;
    LAS float* lg = (LAS float*)(lds + LDS_LG) + wid * (16 * 33); LAS int* lcount = (LAS int*)(lds + LDS_CNT); LAS int* lbase = lcount + 32;
    for (int idx = tid; idx < 1024 * 32; idx += NTHREADS) { const int k = idx >> 5, e = idx & 31; const float w = rw[idx] * fw[k];
        const unsigned hi = f2bf(w), lo = f2bf(w - __uint_as_float(hi << 16));
        *(LAS unsigned short*)(lds + LDS_WHI + e * WPITCH + 2 * k) = (unsigned short)hi; *(LAS unsigned short*)(lds + LDS_WLO + e * WPITCH + 2 * k) = (unsigned short)lo; }
    if (tid < 32) lcount[tid] = 0;
    __syncthreads();
    const float rb0 = rb[r], rb1 = rb[16 + r];
    const LAS unsigned char* whi = lds + LDS_WHI + r * WPITCH + 16 * q; const LAS unsigned char* wlo = lds + LDS_WLO + r * WPITCH + 16 * q;
    for (int tile = bid; tile < T / 128; tile += G) {
        const int t0 = tile * 128 + wid * 16, ch = (tile * 128) / TC;
        const bf16_t* xrow = x1 + (size_t)(t0 + r) * D + 8 * q;
        u32x4 xw[32];
#pragma unroll
        for (int j = 0; j < 32; ++j) xw[j] = *(const u32x4*)(xrow + 32 * j);
        f32x4 acc0 = {0.f, 0.f, 0.f, 0.f}, acc1 = {0.f, 0.f, 0.f, 0.f}; float ssq = 0.f;
#pragma unroll
        for (int j = 0; j < 32; ++j) {
            const bf16x8 av = *reinterpret_cast<const bf16x8*>(&xw[j]);
            const bf16x8 bh0 = *(const LAS bf16x8*)(whi + 64 * j), bh1 = *(const LAS bf16x8*)(whi + 16 * WPITCH + 64 * j), bl0 = *(const LAS bf16x8*)(wlo + 64 * j), bl1 = *(const LAS bf16x8*)(wlo + 16 * WPITCH + 64 * j);
            acc0 = __builtin_amdgcn_mfma_f32_16x16x32_bf16(av, bh0, acc0, 0, 0, 0); acc1 = __builtin_amdgcn_mfma_f32_16x16x32_bf16(av, bh1, acc1, 0, 0, 0);
            acc0 = __builtin_amdgcn_mfma_f32_16x16x32_bf16(av, bl0, acc0, 0, 0, 0); acc1 = __builtin_amdgcn_mfma_f32_16x16x32_bf16(av, bl1, acc1, 0, 0, 0);
#pragma unroll
            for (int i = 0; i < 4; ++i) { const float lo_ = __uint_as_float(xw[j][i] << 16), hi_ = __uint_as_float(xw[j][i] & 0xffff0000u); ssq += lo_ * lo_ + hi_ * hi_; }
            if ((j & 1) == 1) __builtin_amdgcn_sched_barrier(0);
        }
        ssq += __shfl_xor(ssq, 16); ssq += __shfl_xor(ssq, 32);
        const float rstd = 1.0f / sqrtf(ssq * (1.f / D) + EPS);
        { const float sx = rstd * FP8_SX;
#pragma unroll
          for (int j = 0; j < 32; ++j) { u32x4 xv = xw[j]; asm volatile("" : "+v"(xv));
              *(unsigned long long*)(XQ + (size_t)(t0 + r) * D + 32 * j + 8 * q) =
                  (unsigned long long)pk4_fp8(__uint_as_float(xv[0] << 16) * sx, __uint_as_float(xv[0] & 0xffff0000u) * sx, __uint_as_float(xv[1] << 16) * sx, __uint_as_float(xv[1] & 0xffff0000u) * sx)
                | ((unsigned long long)pk4_fp8(__uint_as_float(xv[2] << 16) * sx, __uint_as_float(xv[2] & 0xffff0000u) * sx, __uint_as_float(xv[3] << 16) * sx, __uint_as_float(xv[3] & 0xffff0000u) * sx) << 32); } }
        asm volatile("s_waitcnt lgkmcnt(0)" ::: "memory");
#pragma unroll
        for (int g4 = 0; g4 < 4; ++g4) { const float rs = __shfl(rstd, q * 4 + g4); lg[(q * 4 + g4) * 33 + r] = acc0[g4] * rs + rb0; lg[(q * 4 + g4) * 33 + 16 + r] = acc1[g4] * rs + rb1; }
        asm volatile("s_waitcnt lgkmcnt(0)" ::: "memory");
        int ti[4]; float gt[4]; int lpos[4];
        if (lane < 16) {
            float v[32];
#pragma unroll
            for (int e = 0; e < 32; ++e) v[e] = lg[lane * 33 + e];
            unsigned used = 0u; float tv[4];
#pragma unroll
            for (int k = 0; k < 4; ++k) { float best = -INFINITY; int bi = -1;
#pragma unroll
                for (int e = 0; e < 32; ++e) { const bool take = !((used >> e) & 1u) && (bi < 0 || v[e] > best); best = take ? v[e] : best; bi = take ? e : bi; }
                tv[k] = best; ti[k] = bi; used |= 1u << bi; }
            const float e1 = expf(tv[1] - tv[0]), e2 = expf(tv[2] - tv[0]), e3 = expf(tv[3] - tv[0]), inv = 1.f / (1.f + e1 + e2 + e3);
            gt[0] = inv; gt[1] = e1 * inv; gt[2] = e2 * inv; gt[3] = e3 * inv;
#pragma unroll
            for (int k = 0; k < 4; ++k) lpos[k] = __hip_atomic_fetch_add(lcount + ti[k], 1, __ATOMIC_RELAXED, __HIP_MEMORY_SCOPE_WORKGROUP);
        }
        __syncthreads();
        if (tid < 32) { const int c = lcount[tid]; lbase[tid] = c ? atomicAdd(&cnt[ch * 32 + tid], c) : 0; lcount[tid] = 0; }
        __syncthreads();
        if (lane < 16) { const int t = t0 + lane;
#pragma unroll
            for (int k = 0; k < 4; ++k) { const int pos = lbase[ti[k]] + lpos[k]; const size_t idx = ((size_t)ch * 32 + ti[k]) * TC + pos;
                ltok[idx] = t; lgate[idx] = gt[k]; slot[t * 4 + k] = (ti[k] << 16) | pos; } }
    }
    __syncthreads();
}
}

typedef unsigned gu32_t;
#define XB_TMO      128
#define XB_XCNT(j)  (256  + 64 * (j))
#define XB_XSUB(j)  (1280 + 64 * (j))
#define XB_XGEN(j)  (2304 + 64 * (j))
#define XB_TOP      3328
#define XB_TOPGEN   3392
#define XCD_BAR_WORDS 3456
#define XB_SPIN_CAP (1u << 18)

__device__ __forceinline__ unsigned xb_ld(unsigned* p)              { return __hip_atomic_load(p, __ATOMIC_RELAXED, __HIP_MEMORY_SCOPE_AGENT); }
__device__ __forceinline__ unsigned xb_add(unsigned* p, unsigned v) { return __hip_atomic_fetch_add(p, v, __ATOMIC_RELAXED, __HIP_MEMORY_SCOPE_AGENT); }
__device__ __forceinline__ unsigned xb_xcc_id() { return (unsigned)__builtin_amdgcn_s_getreg((3 << 11) | 20) & 0xFu; }
#define XB_SPIN(cond, bar) do { unsigned _sp = 0; while (cond) { __builtin_amdgcn_s_sleep(1); \
    if ((++_sp & 255u) == 0u) { if (xb_ld(&(bar)[XB_TMO])) break; if (_sp > XB_SPIN_CAP) { atomicAdd(&(bar)[XB_TMO], 1u); break; } } } } while (0)

struct XcdBarrier {
    unsigned* bar; unsigned x;
    volatile LAS unsigned* st;
};

__device__ __forceinline__ XcdBarrier xcd_barrier_post(unsigned* bar, volatile LAS unsigned* st) {
    XcdBarrier b; b.bar = bar; b.x = xb_xcc_id(); b.st = st;
    if (threadIdx.x == 0) (void)xb_add(&bar[XB_XCNT(b.x)], 1u);
    return b;
}
__device__ __forceinline__ void xcd_barrier_complete(unsigned* bar, unsigned x, unsigned& nloc, unsigned& nx) {
    const unsigned G = gridDim.x * gridDim.y * gridDim.z;
    unsigned sum, cnt, mine, sp = 0u;
    for (;;) {
        sum = 0u; cnt = 0u; mine = 0u;
#pragma unroll
        for (unsigned j = 0; j < 16; ++j) { const unsigned c = xb_ld(&bar[XB_XCNT(j)]); sum += c; cnt += (c > 0u) ? 1u : 0u; mine = (j == x) ? c : mine; }
        if (sum == G) break;
        __builtin_amdgcn_s_sleep(1);
        if ((++sp & 255u) == 0u) { if (xb_ld(&bar[XB_TMO])) break; if (sp > XB_SPIN_CAP) { atomicAdd(&bar[XB_TMO], 1u); break; } }
    }
    nloc = mine > 0u ? mine : 1u; nx = cnt > 0u ? cnt : 1u;
}

__device__ __forceinline__ void xcd_barrier(const XcdBarrier& b) {
    asm volatile("s_waitcnt vmcnt(0)" ::: "memory");
    __syncthreads();
    if (threadIdx.x == 0) {
        unsigned* bar = b.bar;
        __builtin_amdgcn_s_waitcnt(0);
        unsigned nloc = b.st[0], nx = b.st[1];
        if (nloc == 0u) { xcd_barrier_complete(bar, b.x, nloc, nx); b.st[0] = nloc; b.st[1] = nx; }
        const unsigned old = xb_add(&bar[XB_XSUB(b.x)], 1u);
        const unsigned gen = old / nloc;
        if (old + 1u == (gen + 1u) * nloc) {
            __builtin_amdgcn_fence(__ATOMIC_RELEASE, "agent");
            asm volatile("s_waitcnt vmcnt(0)" ::: "memory");
            const unsigned og = xb_add(&bar[XB_TOP], 1u);
            const unsigned tg = og / nx;
            if (og + 1u == (tg + 1u) * nx) xb_add(&bar[XB_TOPGEN], 1u);
            else XB_SPIN(xb_ld(&bar[XB_TOPGEN]) == tg, bar);
            __builtin_amdgcn_fence(__ATOMIC_ACQUIRE, "agent");
            xb_add(&bar[XB_XGEN(b.x)], 1u);
            asm volatile("s_waitcnt vmcnt(0)" ::: "memory");
        } else {
            XB_SPIN(xb_ld(&bar[XB_XGEN(b.x)]) == gen, bar);
            __builtin_amdgcn_fence(__ATOMIC_ACQUIRE, "agent");
            asm volatile("s_waitcnt vmcnt(0)" ::: "memory");
        }
    }
    __syncthreads();
}


constexpr int XB_LDS = pg8::STAGE_BYTES + pg8::PLAN_BYTES;
constexpr int MK_LDS = pg8::STAGE_BYTES + pg8::PLAN_BYTES + 64 + 2048;

struct MArgs {
    const float* x; const int* positions; const float* attn_norm_w; const float* w_in; const float* lq1; const float* lk1; const float* lq2; const float* lk2;
    const float* subln_w; const float* pool_w; const float* pool_scale; const float* w_out; const float* ffn_norm_w; const float* router_w; const float* router_b;
    const float* w_gu; const float* b_gu; const float* w_down; const float* b_down; const float* final_w; float* out; unsigned char* ws;
};

template <int MODE>
__device__ __forceinline__ void p0_transpose_item(const float* __restrict__ W, int N, bf16_t* __restrict__ WT, int ldk, LAS float* scr, int item, int lane, const float* __restrict__ kscale) {
    const int nblk = N / 32, kb = item / nblk, nb = item % nblk, k0 = 64 * kb, n0 = 32 * nb;
#pragma unroll 8
    for (int i = 0; i < 32; ++i) { const int kk = 2 * i + (lane >> 5); float v = W[(size_t)(k0 + kk) * N + n0 + (lane & 31)]; if (MODE != 0) v *= kscale[k0 + kk]; scr[kk * 33 + (lane & 31)] = v; }
    asm volatile("s_waitcnt lgkmcnt(0)" ::: "memory");
    const int c = lane & 7;
#pragma unroll
    for (int j = 0; j < 4; ++j) { const int nl = (lane >> 3) + 8 * j, n = n0 + nl; const LAS float* s = scr + (8 * c) * 33 + nl;
        int row = n;
        if (MODE == 1) { const int f = n & 1023, up = n >> 10; row = (f >> 7) * 256 + up * 128 + (f & 127); }
        u32x4 o; o.x = f2bf(s[0 * 33]) | (f2bf(s[1 * 33]) << 16); o.y = f2bf(s[2 * 33]) | (f2bf(s[3 * 33]) << 16); o.z = f2bf(s[4 * 33]) | (f2bf(s[5 * 33]) << 16); o.w = f2bf(s[6 * 33]) | (f2bf(s[7 * 33]) << 16);
        *(u32x4*)(WT + (size_t)row * ldk + k0 + 8 * c) = o; }
    asm volatile("s_waitcnt lgkmcnt(0)" ::: "memory");
}
template <int MODE>
__device__ __forceinline__ void p0_transpose_item_fp8(const float* __restrict__ W, int N, unsigned char* __restrict__ WT, int ldk, LAS float* scr, int item, int lane, const float* __restrict__ kscale, float sc) {
    const int nblk = N / 32, kb = item / nblk, nb = item % nblk, k0 = 64 * kb, n0 = 32 * nb;
#pragma unroll 8
    for (int i = 0; i < 32; ++i) { const int kk = 2 * i + (lane >> 5); float v = W[(size_t)(k0 + kk) * N + n0 + (lane & 31)] * sc; if (MODE == 1) v *= kscale[k0 + kk]; scr[kk * 33 + (lane & 31)] = v; }
    asm volatile("s_waitcnt lgkmcnt(0)" ::: "memory");
    const int c = lane & 3;
#pragma unroll
    for (int j = 0; j < 2; ++j) { const int nl = (lane >> 2) + 16 * j, n = n0 + nl; const LAS float* s = scr + (16 * c) * 33 + nl;
        int row = n;
        if (MODE == 1) { const int f = n & 1023, up = n >> 10; row = (f >> 7) * 256 + up * 128 + (f & 127); }
        u32x4 o;
#pragma unroll
        for (int q = 0; q < 4; ++q) o[q] = pk4_fp8(s[(4 * q) * 33], s[(4 * q + 1) * 33], s[(4 * q + 2) * 33], s[(4 * q + 3) * 33]);
        *(u32x4*)(WT + (size_t)row * ldk + k0 + 16 * c) = o; }
    asm volatile("s_waitcnt lgkmcnt(0)" ::: "memory");
}
__device__ __forceinline__ void xbf_row(const float* __restrict__ xrow, bf16_t* __restrict__ orow, float* __restrict__ rstd_out, int lane) {
    const f32x4* xr = (const f32x4*)xrow + lane;
    f32x4 v[4]; float s = 0.f;
#pragma unroll
    for (int j = 0; j < 4; ++j) { v[j] = xr[64 * j]; s += v[j].x * v[j].x + v[j].y * v[j].y + v[j].z * v[j].z + v[j].w * v[j].w; }
    unsigned long long* o8 = (unsigned long long*)orow + lane;
#pragma unroll
    for (int j = 0; j < 4; ++j) { const unsigned lo = f2bf(v[j].x) | (f2bf(v[j].y) << 16), hi = f2bf(v[j].z) | (f2bf(v[j].w) << 16); o8[64 * j] = (unsigned long long)lo | ((unsigned long long)hi << 32); }
    const float rstd = 1.0f / sqrtf(wave_sum(s) * (1.f / D) + EPS);
    if (lane == 0) *rstd_out = rstd;
}
__device__ __forceinline__ void rmsnorm_row_bf16(const float* __restrict__ xrow, const float* __restrict__ w, bf16_t* __restrict__ orow, int lane) {
    const f32x4* xr = (const f32x4*)xrow + lane;
    f32x4 v[4]; float s = 0.f;
#pragma unroll
    for (int j = 0; j < 4; ++j) { v[j] = xr[64 * j]; s += v[j].x * v[j].x + v[j].y * v[j].y + v[j].z * v[j].z + v[j].w * v[j].w; }
    const float rstd = 1.0f / sqrtf(wave_sum(s) * (1.f / D) + EPS);
    unsigned long long* o8 = (unsigned long long*)orow + lane;
#pragma unroll
    for (int j = 0; j < 4; ++j) { const f32x4 ww = ((const f32x4*)w)[64 * j + lane];
        const unsigned lo = f2bf(v[j].x * rstd * ww.x) | (f2bf(v[j].y * rstd * ww.y) << 16), hi = f2bf(v[j].z * rstd * ww.z) | (f2bf(v[j].w * rstd * ww.w) << 16);
        o8[64 * j] = (unsigned long long)lo | ((unsigned long long)hi << 32); }
}

__device__ __forceinline__ void final_row(float* __restrict__ out, const bf16_t* __restrict__ XB, const unsigned char* __restrict__ YP, const LAS int* tb, const int* slot, const float* __restrict__ lgate, const float* __restrict__ w, int t, int lane) {
    int rows[4]; float gk[4];
#pragma unroll
    for (int k = 0; k < 4; ++k) { const int sl = slot[t * 4 + k]; rows[k] = tb[sl >> 16] + (sl & 0xffff); gk[k] = lgate[(size_t)(sl >> 16) * TC + (sl & 0xffff)] * (1.0f / FP8_SY); }
    float v[16];
    { const u32x4 a0 = *(const u32x4*)(XB + (size_t)t * D + 16 * lane), a1 = *(const u32x4*)(XB + (size_t)t * D + 16 * lane + 8);
#pragma unroll
      for (int e = 0; e < 4; ++e) { v[2 * e] = __uint_as_float(a0[e] << 16); v[2 * e + 1] = __uint_as_float(a0[e] & 0xffff0000u); v[8 + 2 * e] = __uint_as_float(a1[e] << 16); v[8 + 2 * e + 1] = __uint_as_float(a1[e] & 0xffff0000u); } }
    float y[16];
#pragma unroll
    for (int e = 0; e < 16; ++e) y[e] = 0.f;
#pragma unroll
    for (int k = 0; k < 4; ++k) { const u32x4 q = *(const u32x4*)(YP + (size_t)rows[k] * D + 16 * lane);
#pragma unroll
        for (int e = 0; e < 4; ++e) { y[4 * e] += gk[k] * __builtin_amdgcn_cvt_f32_fp8(q[e], 0); y[4 * e + 1] += gk[k] * __builtin_amdgcn_cvt_f32_fp8(q[e], 1); y[4 * e + 2] += gk[k] * __builtin_amdgcn_cvt_f32_fp8(q[e], 2); y[4 * e + 3] += gk[k] * __builtin_amdgcn_cvt_f32_fp8(q[e], 3); } }
    float s = 0.f;
#pragma unroll
    for (int e = 0; e < 16; ++e) { v[e] += y[e]; s += v[e] * v[e]; }
    const float rstd = 1.0f / sqrtf(wave_sum(s) * (1.f / D) + EPS);
    float* op = out + (size_t)t * D + 16 * lane; const float* wp = w + 16 * lane;
#pragma unroll
    for (int e = 0; e < 4; ++e) { const f32x4 ww = *(const f32x4*)(wp + 4 * e); *(f32x4*)(op + 4 * e) = (f32x4){v[4 * e] * rstd * ww.x, v[4 * e + 1] * rstd * ww.y, v[4 * e + 2] * rstd * ww.z, v[4 * e + 3] * rstd * ww.w}; }
}

typedef const MArgs __attribute__((address_space(4)))* KArgP;
__device__ __forceinline__ KArgP kargs() { KArgP p = (KArgP)__builtin_amdgcn_kernarg_segment_ptr(); asm volatile("" : "+s"(p)); return p; }
#define WSP(T_, off) ((T_*)(ws + (off)))
__global__ __launch_bounds__(NTHREADS, 2) void mega_fwd(MArgs a_unused) {
    extern __shared__ __attribute__((aligned(16))) unsigned char lds_raw[];
    LAS unsigned char* lds = (LAS unsigned char*)lds_raw;
    const int G = gridDim.x, bid = blockIdx.x, gsz = G * NTHREADS, ngw = G * NWAVES;
    if (threadIdx.x < 16) ((LAS unsigned*)(lds + XB_LDS))[threadIdx.x] = 0u;
    __syncthreads();
    (void)xcd_barrier_post((unsigned*)(kargs()->ws + WS_BAR), (volatile LAS unsigned*)(lds + XB_LDS));
#define GRID_SYNC() do { XcdBarrier xb_; xb_.bar = (unsigned*)(kargs()->ws + WS_BAR); xb_.x = xb_xcc_id(); xb_.st = (volatile LAS unsigned*)(lds + XB_LDS); xcd_barrier(xb_); } while (0)
#define PHASE_IDX() const int tid = otid(), lane = tid & 63, wid = __builtin_amdgcn_readfirstlane(tid >> 6), gtid = bid * NTHREADS + tid, gw = bid * NWAVES + wid; (void)lane; (void)gtid; (void)gw

    {
        PHASE_IDX(); KArgP a = kargs(); unsigned char* ws = a->ws; int* cnt = WSP(int, WS_CTL); float* rope = WSP(float, WS_ROPE); bf16_t* Win_t = WSP(bf16_t, WS_WIN); bf16_t* Wo_t = WSP(bf16_t, WS_WO); bf16_t* Wd_t = WSP(bf16_t, WS_WD); bf16_t* Wgu_t = WSP(bf16_t, WS_WGU); bf16_t* XN = WSP(bf16_t, WS_XN);
        if (gtid < NCHUNK * 32) cnt[gtid] = 0;
        LAS float* scr = (LAS float*)(lds + wid * 8448);
        constexpr int I_IN = (D / 64) * (INW / 32), I_WO = (512 / 64) * (D / 32), I_GU = (D / 64) * (2048 / 32), I_DN = (FF / 64) * (D / 32);
        constexpr int NITEMS = I_IN + I_WO + NE * I_GU + NE * I_DN;
        for (int it = gw; it < NITEMS; it += ngw) {
            int r = it;
            if (r < I_IN) { p0_transpose_item<2>(a->w_in, INW, Win_t, D, scr, r, lane, a->attn_norm_w); continue; } r -= I_IN;
            if (r < I_WO) { p0_transpose_item<0>(a->w_out, D, Wo_t, D, scr, r, lane, nullptr); continue; } r -= I_WO;
            if (r < NE * I_GU) { const int e = r / I_GU; p0_transpose_item_fp8<1>(a->w_gu + (size_t)e * D * 2048, 2048, (unsigned char*)Wgu_t + (size_t)e * 2048 * D, D, scr, r % I_GU, lane, a->ffn_norm_w, FP8_SW); continue; } r -= NE * I_GU;
            { const int e = r / I_DN; p0_transpose_item_fp8<0>(a->w_down + (size_t)e * FF * D, D, (unsigned char*)Wd_t + (size_t)e * D * FF, FF, scr, r % I_DN, lane, nullptr, FP8_SW); }
        }
        for (int idx = gtid; idx < 512 * 1024; idx += gsz) {
            const int n = idx & 1023, gc = idx >> 10, g = gc >> 7; float acc = 0.f;
            for (int d = 0; d < 128; ++d) acc += a->pool_w[(size_t)gc * 128 + d] * a->pool_scale[g * 128 + d] * a->w_out[(size_t)(512 + g * 128 + d) * 1024 + n];
            Wo_t[(size_t)n * 1024 + 512 + gc] = (bf16_t)f2bf(acc);
        }
        for (int idx = gtid; idx < T * 8; idx += gsz) {
            const int t = idx >> 3, j = idx & 7;
            const double inv = exp(-(double)(2 * j) / 16.0 * log(500000.0)); const double ang = (double)a->positions[t] * inv;
            rope[(size_t)t * 16 + j] = (float)cos(ang); rope[(size_t)t * 16 + 8 + j] = (float)sin(ang);
        }
        for (int row = gw; row < T; row += ngw) xbf_row(a->x + (size_t)row * D, XN + (size_t)row * D, WSP(float, WS_RSTD) + row, lane);
    }
    GRID_SYNC();
    { PHASE_IDX(); KArgP a = kargs(); unsigned char* ws = a->ws; bf16_t* Win_t = WSP(bf16_t, WS_WIN); bf16_t* XN = WSP(bf16_t, WS_XN); bf16_t* PROJ = WSP(bf16_t, WS_PROJ); const float* rope = WSP(float, WS_ROPE);
      pg8::DensePlan S; S.init(T, INW, G, bid); pg8::EpiBf16 E{PROJ, INW, rope, 4, WSP(float, WS_RSTD)}; pg8::gemm_phase<2048, false>(lds, XN, Win_t, S, E); }
    GRID_SYNC();
    {
        PHASE_IDX(); KArgP a = kargs(); unsigned char* ws = a->ws; bf16_t* PROJ = WSP(bf16_t, WS_PROJ); bf16_t* CAT = WSP(bf16_t, WS_CAT);
        const float lam = expf(wave_sum(a->lq1[lane] * a->lk1[lane])) - expf(wave_sum(a->lq2[lane] * a->lk2[lane])) + 0.2f;
        dattn::phase((char*)lds_raw, PROJ, CAT, lam, a->subln_w, G, bid);
        for (int item = gtid; item < (T / 32) * 64; item += gsz) {
            const int chunk = item & 63, tb = item >> 6, c0 = chunk * 8, w = 2 << (c0 >> 7), t0 = tb * 32, s0 = t0 % SEQ;
            const bf16_t* up = PROJ + (size_t)t0 * INW + 1536 + c0; bf16_t* op = CAT + (size_t)t0 * D + 512 + c0;
            float sum[8];
#pragma unroll
            for (int e = 0; e < 8; ++e) sum[e] = 0.f;
            if (s0 > 0) for (int i = 1; i < w; ++i) { const u32x4 v = *(const u32x4*)(up - (size_t)i * INW);
#pragma unroll
                for (int e = 0; e < 4; ++e) { sum[2 * e] += __uint_as_float(v[e] << 16); sum[2 * e + 1] += __uint_as_float(v[e] & 0xffff0000u); } }
            for (int tb8 = 0; tb8 < 32; tb8 += 8) {
                u32x4 vin[8], vout[8];
#pragma unroll
                for (int i = 0; i < 8; ++i) vin[i] = *(const u32x4*)(up + (size_t)(tb8 + i) * INW);
#pragma unroll
                for (int i = 0; i < 8; ++i) { const int tt = tb8 + i; const bool has = s0 + tt + 1 >= w; vout[i] = *(const u32x4*)(up + (size_t)(has ? tt - w + 1 : tt) * INW); }
                asm volatile("" ::: "memory");
#pragma unroll
                for (int i = 0; i < 8; ++i) { const int tt = tb8 + i; float f[8];
#pragma unroll
                    for (int e = 0; e < 4; ++e) { f[2 * e] = __uint_as_float(vin[i][e] << 16); f[2 * e + 1] = __uint_as_float(vin[i][e] & 0xffff0000u); }
                    const int s = s0 + tt; const float rn = 1.0f / (float)((s + 1 < w) ? s + 1 : w);
                    u32x4 o;
#pragma unroll
                    for (int e = 0; e < 4; ++e) { sum[2 * e] += f[2 * e]; sum[2 * e + 1] += f[2 * e + 1]; o[e] = pg8::cvt_pk_bf16(sum[2 * e] * rn - f[2 * e], sum[2 * e + 1] * rn - f[2 * e + 1]); }
                    *(u32x4*)(op + (size_t)tt * D) = o;
                    const float hm = (s + 1 >= w) ? 1.f : 0.f;
#pragma unroll
                    for (int e = 0; e < 4; ++e) { sum[2 * e] -= hm * __uint_as_float(vout[i][e] << 16); sum[2 * e + 1] -= hm * __uint_as_float(vout[i][e] & 0xffff0000u); } }
            }
        }
    }
    GRID_SYNC();
    { PHASE_IDX(); KArgP a = kargs(); unsigned char* ws = a->ws; bf16_t* Wo_t = WSP(bf16_t, WS_WO); bf16_t* CAT = WSP(bf16_t, WS_CAT);
      pg8::DensePlan S; S.init(T, D, G, bid); pg8::EpiResBf16 E{WSP(bf16_t, WS_XB), WSP(bf16_t, WS_XN), D}; pg8::gemm_phase<2048, false>(lds, CAT, Wo_t, S, E); }
    GRID_SYNC();
    { PHASE_IDX(); KArgP a = kargs(); unsigned char* ws = a->ws;
      rtr::phase(lds, WSP(bf16_t, WS_XB), a->ffn_norm_w, a->router_w, a->router_b, WSP(int, WS_CTL), WSP(int, WS_LTOK), WSP(float, WS_LGATE), WSP(int, WS_SLOT), WSP(unsigned char, WS_XN), G, bid); }
    GRID_SYNC();
    for (int ch = 0; ch < NCHUNK; ++ch) {
        PHASE_IDX(); KArgP a = kargs(); unsigned char* ws = a->ws; int* cnt = WSP(int, WS_CTL); int* ltok = WSP(int, WS_LTOK); float* lgate = WSP(float, WS_LGATE); int* slot = WSP(int, WS_SLOT); bf16_t* Wd_t = WSP(bf16_t, WS_WD); bf16_t* Wgu_t = WSP(bf16_t, WS_WGU); bf16_t* XN = WSP(bf16_t, WS_XN); bf16_t* HM = WSP(bf16_t, WS_HM); bf16_t* YP = WSP(bf16_t, WS_YP); float* out = a->out;
        const int* cc = cnt + ch * 32; const int* lt = ltok + (size_t)ch * 32 * TC; const float* lg = lgate + (size_t)ch * 32 * TC;
        { pg8::MoePlan<true> S = pg8::moe_plan_setup<true>(lds + pg8::STAGE_BYTES, cc, lt, 8, G, bid); pg8::EpiGLU E{HM, a->b_gu, 8}; pg8::gemm_phase<1024, true>(lds, XN, Wgu_t, S, E); }
        GRID_SYNC();
        { pg8::MoePlan<false> S = pg8::moe_plan_setup<false>(lds + pg8::STAGE_BYTES, cc, lt, 4, G, bid); pg8::EpiDown E{YP, a->b_down, 4}; pg8::gemm_phase<1024, true>(lds, HM, Wd_t, S, E); }
        GRID_SYNC();
        { LAS int* tb = (LAS int*)(lds + pg8::STAGE_BYTES);
          if (tid < 64) { int v = (lane < 32) ? (__hip_atomic_load(cc + (lane & 31), __ATOMIC_RELAXED, __HIP_MEMORY_SCOPE_AGENT) + TM - 1) / TM : 0, incl = v;
#pragma unroll
              for (int o = 1; o < 32; o <<= 1) { const int up = __shfl_up(incl, o); if (lane >= o) incl += up; }
              if (lane < 32) tb[lane] = (incl - v) * TM; }
          __syncthreads();
          for (int t = ch * TC + gw; t < (ch + 1) * TC; t += ngw) final_row(out, WSP(bf16_t, WS_XB), (const unsigned char*)YP, tb, slot, lg, a->final_w, t, lane);
          __syncthreads(); }
    }
}

extern "C" void kernel_launch(void* const* d_in, const int* in_sizes, int n_in, void* d_out, int out_size, void* d_ws, size_t ws_size, hipStream_t stream) {
    if (n_in != 20 || in_sizes[0] != T * D || out_size != T * D || ws_size < WS_END) { fprintf(stderr, "kernel_launch: unexpected shapes / workspace (%d, %d, %d, %zu)\n", n_in, n_in > 0 ? in_sizes[0] : -1, out_size, ws_size); return; }
    static int grid_blocks = 0;
    if (!grid_blocks) {
        int dev = 0, cus = 0, per_cu = 0;
        (void)hipGetDevice(&dev); (void)hipDeviceGetAttribute(&cus, hipDeviceAttributeMultiprocessorCount, dev);
        (void)hipFuncSetAttribute((const void*)mega_fwd, hipFuncAttributeMaxDynamicSharedMemorySize, MK_LDS);
        (void)hipOccupancyMaxActiveBlocksPerMultiprocessor(&per_cu, (const void*)mega_fwd, NTHREADS, MK_LDS);
        if (per_cu < 1) { fprintf(stderr, "kernel_launch: occupancy query says %d blocks per CU\n", per_cu); per_cu = 1; }
        grid_blocks = cus * 1;
        if (grid_blocks % 8 != 0) grid_blocks -= grid_blocks % 8;
    }
    (void)hipMemsetAsync((char*)d_ws + WS_BAR, 0, XCD_BAR_WORDS * 4, stream);
    MArgs a{};
    a.x = (const float*)d_in[0]; a.positions = (const int*)d_in[1]; a.attn_norm_w = (const float*)d_in[2]; a.w_in = (const float*)d_in[3];
    a.lq1 = (const float*)d_in[4]; a.lk1 = (const float*)d_in[5]; a.lq2 = (const float*)d_in[6]; a.lk2 = (const float*)d_in[7];
    a.subln_w = (const float*)d_in[8]; a.pool_w = (const float*)d_in[9]; a.pool_scale = (const float*)d_in[10]; a.w_out = (const float*)d_in[11];
    a.ffn_norm_w = (const float*)d_in[12]; a.router_w = (const float*)d_in[13]; a.router_b = (const float*)d_in[14];
    a.w_gu = (const float*)d_in[15]; a.b_gu = (const float*)d_in[16]; a.w_down = (const float*)d_in[17]; a.b_down = (const float*)d_in[18]; a.final_w = (const float*)d_in[19];
    a.out = (float*)d_out; a.ws = (unsigned char*)d_ws;
    void* args[] = {&a};
    hipError_t e = hipLaunchCooperativeKernel((const void*)mega_fwd, dim3(grid_blocks), dim3(NTHREADS), args, MK_LDS, stream);
    if (e != hipSuccess) fprintf(stderr, "cooperative launch failed: %s (grid %d)\n", hipGetErrorString(e), grid_blocks);
}
```

```cpp
#include <hip/hip_runtime.h>
#include <cstdint>
#include <cstdio>

typedef unsigned short bf16_t;
typedef short bf16x8 __attribute__((ext_vector_type(8)));
typedef float f32x4 __attribute__((ext_vector_type(4)));
typedef unsigned u32x4 __attribute__((ext_vector_type(4)));

constexpr int T = 65536, D = 1024, SEQ = 2048, INW = 2048, NE = 32, FF = 1024, TOPK = 4;
constexpr int NCHUNK = 1, TC = T / NCHUNK;
constexpr int TM = 256;
constexpr int PC = TC * TOPK + NE * TM;
constexpr float EPS = 1e-5f;

constexpr size_t MiB = 1u << 20;
constexpr size_t WS_CTL = 0;
constexpr size_t WS_RSTD = 524288;
constexpr size_t WS_BAR = 65536;
constexpr size_t WS_LTOK = 1 * MiB;
constexpr size_t WS_LGATE = 9 * MiB;
constexpr size_t WS_SLOT = 17 * MiB;
constexpr size_t WS_ROPE = 18 * MiB;
constexpr size_t WS_WIN = 22 * MiB;
constexpr size_t WS_WO = 26 * MiB;
constexpr size_t WS_WD = 28 * MiB;
constexpr size_t WS_WGU = 92 * MiB;
constexpr size_t WS_XN = 220 * MiB;
constexpr size_t WS_PROJ = 348 * MiB;
constexpr size_t WS_CAT = 604 * MiB;
constexpr size_t WS_HM = 348 * MiB;
constexpr size_t WS_YP = 612 * MiB;
constexpr size_t WS_XB = 876 * MiB;
constexpr size_t WS_END = 1004 * MiB;
static_assert(WS_HM + (size_t)PC * 1024 <= WS_YP && WS_YP + (size_t)PC * 1024 <= WS_XB && WS_XB + (size_t)T * 1024 * 2 <= WS_END && WS_CAT + (size_t)T * 1024 * 2 <= WS_XB, "ws map");

__device__ __forceinline__ int otid() { int t = threadIdx.x; asm volatile("" : "+v"(t)); return t; }
__device__ __forceinline__ unsigned f2bf(float f) { unsigned u = __float_as_uint(f); return (u + 0x7fffu + ((u >> 16) & 1u)) >> 16; }
__device__ __forceinline__ unsigned pk4_fp8(float a, float b, float c, float d) {
    a = fminf(fmaxf(a, -448.f), 448.f); b = fminf(fmaxf(b, -448.f), 448.f); c = fminf(fmaxf(c, -448.f), 448.f); d = fminf(fmaxf(d, -448.f), 448.f);
    unsigned w = 0; w = __builtin_amdgcn_cvt_pk_fp8_f32(a, b, w, false); w = __builtin_amdgcn_cvt_pk_fp8_f32(c, d, w, true); return w; }
__device__ __forceinline__ unsigned pk4_fp8_nc(float a, float b, float c, float d) { unsigned w = 0; w = __builtin_amdgcn_cvt_pk_fp8_f32(a, b, w, false); w = __builtin_amdgcn_cvt_pk_fp8_f32(c, d, w, true); return w; }
constexpr float FP8_SX = 16.f, FP8_SW = 512.f, FP8_SH = 4.f, FP8_SY = 32.f;
__device__ __forceinline__ float bf2f(unsigned h) { return __uint_as_float(h << 16); }
__device__ __forceinline__ float wave_sum(float v) {
#pragma unroll
    for (int o = 1; o < 64; o <<= 1) v += __shfl_xor(v, o);
    return v;
}
__device__ __forceinline__ float wave_max(float v) {
#pragma unroll
    for (int o = 1; o < 64; o <<= 1) v = fmaxf(v, __shfl_xor(v, o));
    return v;
}

namespace pg8 {
#define PG8_LAS __attribute__((address_space(3)))
constexpr int BM = 256, BK = 64, HALF = 128, HTB = HALF * BK * 2  , STAGE_BYTES = 8 * HTB;
constexpr int MAXU = 36, PLAN_BYTES = MAXU * 32 + MAXU * 512, EPI_LDS = STAGE_BYTES + PLAN_BYTES + 64;
__host__ __device__ __forceinline__ int lds_byte(int r, int c) { return r * 128 + ((((c >> 3) ^ ((r >> 1) & 7))) << 4); }
__host__ __device__ __forceinline__ void stage_rc(int b, int& R, int& C) { R = b >> 7; C = ((((b >> 4) & 7) ^ ((R >> 1) & 7))) << 3; }
__host__ __device__ __forceinline__ int perm32(int rho) { const int n = rho >> 4, i = rho & 15; return 8 * (i >> 2) + 4 * n + (i & 3); }
__device__ __forceinline__ unsigned cvt_pk_bf16(float lo, float hi) { unsigned r; asm volatile("v_cvt_pk_bf16_f32 %0, %1, %2" : "=v"(r) : "v"(lo), "v"(hi)); return r; }

template <int IMM = 0>
__device__ __forceinline__ void glds16s(const void* sbase, unsigned voff, unsigned lds_dst) { unsigned keep;
    asm volatile("s_mov_b32 %0, m0\n\ts_mov_b32 m0, %3\n\ts_nop 0\n\tglobal_load_lds_dwordx4 %1, %2 offset:%4\n\ts_mov_b32 m0, %0" : "=&s"(keep) : "v"(voff), "s"(sbase), "s"(lds_dst), "i"(IMM) : "memory"); }
typedef int v4i_t __attribute__((ext_vector_type(4)));
typedef int v8i_t __attribute__((ext_vector_type(8)));
__device__ __forceinline__ v8i_t cat8(bf16x8 lo, bf16x8 hi) { return __builtin_shufflevector(__builtin_bit_cast(v4i_t, lo), __builtin_bit_cast(v4i_t, hi), 0, 1, 2, 3, 4, 5, 6, 7); }
__device__ __forceinline__ void mfma_fp8_inplace(f32x4& acc, v8i_t a, v8i_t b) {
    asm volatile("v_mfma_scale_f32_16x16x128_f8f6f4 %0, %1, %2, %0, %3, %3 op_sel_hi:[0,0,0]" : "+v"(acc) : "v"(a), "v"(b), "v"(0x7F7F7F7F)); }
struct Unit { int pm, pn, e, lt, ne; };

template <int ROWB, bool FP8, class Epi, class Plan>
__device__ __forceinline__ void gemm_phase(PG8_LAS unsigned char* lds, const bf16_t* gA_, const bf16_t* gBt_, const Plan& S, const Epi& E) {
    const int tid = otid(), wid = __builtin_amdgcn_readfirstlane(tid >> 6), lane = tid & 63, wr = wid >> 2, wc = wid & 3, fr = lane & 15, fq = lane >> 4;
    constexpr int nt = ROWB / 128;
    unsigned voffB[2];
#pragma unroll
    for (int i = 0; i < 2; ++i) { int R, C; stage_rc(tid * 16 + i * 8192, R, C); const int Rb = Epi::PERM ? ((R & ~31) + perm32(R & 31)) : R; voffB[i] = (unsigned)(Rb * ROWB + C * 2); }
    const size_t kstep = (size_t)(BK * 2);
    const size_t hstep = (size_t)HALF * ROWB;
    const size_t tstep = 2 * hstep;
    const unsigned ldsb_epi0 = (unsigned)__builtin_amdgcn_readfirstlane((unsigned)(__UINTPTR_TYPE__)lds + (unsigned)EPI_LDS);
    const unsigned ldsb = (unsigned)__builtin_amdgcn_readfirstlane((unsigned)(__UINTPTR_TYPE__)lds + (unsigned)wid * 1024u);
    const int aoff0 = lds_byte(wr * 64 + fr, fq * 8), aoff1 = lds_byte(wr * 64 + fr, 32 + fq * 8), boff0 = lds_byte(wc * 32 + fr, fq * 8), boff1 = lds_byte(wc * 32 + fr, 32 + fq * 8);
#define PG8_SA(b, h) (((b) * 2 + (h)) * HTB)
#define PG8_SB(b, h) ((4 + (b) * 2 + (h)) * HTB)
#define PG8_STAGE(bufoff, gbase, voff) do { _Pragma("unroll") for (int _i = 0; _i < 2; ++_i) glds16s<0>((gbase), (voff)[_i], ldsb + (unsigned)((bufoff) + _i * 8192)); } while (0)
#define PG8_STAGEK(bufoff, gbase, voff) do { _Pragma("unroll") for (int _i = 0; _i < 2; ++_i) glds16s<BK * 2>((gbase), (voff)[_i], ldsb + (unsigned)((bufoff) + _i * 8192)); } while (0)
#define PG8_LDA(dst, b, h) do { _Pragma("unroll") for (int m = 0; m < 4; ++m) { \
        if constexpr (FP8) dst##8[m] = cat8(*(const PG8_LAS bf16x8*)(lds + PG8_SA(b, h) + aoff0 + m * 2048), *(const PG8_LAS bf16x8*)(lds + PG8_SA(b, h) + aoff1 + m * 2048)); \
        else { dst[m][0] = *(const PG8_LAS bf16x8*)(lds + PG8_SA(b, h) + aoff0 + m * 2048); dst[m][1] = *(const PG8_LAS bf16x8*)(lds + PG8_SA(b, h) + aoff1 + m * 2048); } } } while (0)
#define PG8_LDB(dst, b, h) do { _Pragma("unroll") for (int n = 0; n < 2; ++n) { \
        if constexpr (FP8) dst##8[n] = cat8(*(const PG8_LAS bf16x8*)(lds + PG8_SB(b, h) + boff0 + n * 2048), *(const PG8_LAS bf16x8*)(lds + PG8_SB(b, h) + boff1 + n * 2048)); \
        else { dst[n][0] = *(const PG8_LAS bf16x8*)(lds + PG8_SB(b, h) + boff0 + n * 2048); dst[n][1] = *(const PG8_LAS bf16x8*)(lds + PG8_SB(b, h) + boff1 + n * 2048); } } } while (0)
#define PG8_MMA(ai, bj, At, Bt) do { __builtin_amdgcn_s_setprio(1); _Pragma("unroll") for (int m = 0; m < 4; ++m) _Pragma("unroll") for (int n = 0; n < 2; ++n) { \
        if constexpr (FP8) mfma_fp8_inplace(acc[ai][bj][m][n], Bt##8[n], At##8[m]); \
        else { _Pragma("unroll") for (int k = 0; k < 2; ++k) acc[ai][bj][m][n] = __builtin_amdgcn_mfma_f32_16x16x32_bf16(Bt[n][k], At[m][k], acc[ai][bj][m][n], 0, 0, 0); } } \
        __builtin_amdgcn_s_setprio(0); } while (0)
#define PG8_WAIT_V(n) asm volatile("s_waitcnt vmcnt(" #n ")" ::: "memory")
#define PG8_WAIT_L(n) asm volatile("s_waitcnt lgkmcnt(" #n ")" ::: "memory")
#define PG8_BAR __builtin_amdgcn_s_barrier()
#define PG8_SCHED __builtin_amdgcn_sched_barrier(0)
#define PG8_VOFF(dst, U, UI) do { const int _tv = otid(); _Pragma("unroll") for (int _i = 0; _i < 2; ++_i) { int _R, _C; stage_rc(_tv * 16 + _i * 8192, _R, _C); \
        _Pragma("unroll") for (int _h = 0; _h < 2; ++_h) dst[_h][_i] = S.rowA(U, UI, _h * HALF + _R) * (unsigned)ROWB + (unsigned)(_C * 2); } } while (0)
#define PG8_SP1A(A1) do { \
          \
        PG8_LDB(B0, 0, 0); PG8_LDB(B1, 0, 1); PG8_SCHED; PG8_LDA(At, 0, 0); PG8_STAGE(PG8_SA(1, 1), (A1), vc[1]); \
        PG8_WAIT_V(8); PG8_WAIT_L(0); PG8_BAR; PG8_MMA(0, 0, At, B0); PG8_MMA(0, 1, At, B1); PG8_BAR; PG8_SCHED; } while (0)
#define PG8_REST(A2, B2) do { \
          \
        PG8_LDA(At, 0, 1); PG8_STAGE(PG8_SB(0, 0), (B2), voffB); PG8_STAGE(PG8_SB(0, 1), (B2) + hstep, voffB); PG8_STAGE(PG8_SA(0, 0), (A2), vc[0]); \
        PG8_WAIT_V(8); PG8_WAIT_L(0); PG8_BAR; PG8_MMA(1, 0, At, B0); PG8_MMA(1, 1, At, B1); PG8_BAR; PG8_SCHED; \
          \
        PG8_LDB(B0, 1, 0); PG8_LDB(B1, 1, 1); PG8_SCHED; PG8_LDA(At, 1, 0); PG8_STAGE(PG8_SA(0, 1), (A2), vc[1]); \
        PG8_WAIT_V(8); PG8_WAIT_L(0); PG8_BAR; PG8_MMA(0, 0, At, B0); PG8_MMA(0, 1, At, B1); PG8_BAR; PG8_SCHED; \
          \
        PG8_LDA(At, 1, 1); PG8_STAGE(PG8_SB(1, 0), (B2) + kstep, voffB); PG8_STAGE(PG8_SB(1, 1), (B2) + kstep + hstep, voffB); PG8_STAGE(PG8_SA(1, 0), (A2) + kstep, vc[0]); \
        PG8_WAIT_V(8); PG8_WAIT_L(0); PG8_BAR; PG8_MMA(1, 0, At, B0); PG8_MMA(1, 1, At, B1); PG8_BAR; PG8_SCHED; } while (0)
    Unit cur, nxt; int ui = 0;
    if (!S.next(0, cur)) return;
    f32x4 acc[2][2][4][2];
#pragma unroll
    for (int a = 0; a < 2; ++a)
#pragma unroll
        for (int b = 0; b < 2; ++b)
#pragma unroll
            for (int m = 0; m < 4; ++m)
#pragma unroll
                for (int n = 0; n < 2; ++n) acc[a][b][m][n] = (f32x4){0.f, 0.f, 0.f, 0.f};
    bf16x8 At[4][2], B0[2][2], B1[2][2]; v8i_t At8[4], B08[2], B18[2];
    unsigned vc[2][2];
    PG8_VOFF(vc, cur, 0);
    if (wid == 0) E.prefetch(cur, ldsb_epi0, lane);
    const char* gA = (const char*)gA_; const char* cB = (const char*)gBt_ + (size_t)cur.pn * tstep;
    PG8_STAGE(PG8_SB(0, 0), cB, voffB); PG8_STAGE(PG8_SB(0, 1), cB + hstep, voffB); PG8_STAGE(PG8_SA(0, 0), gA, vc[0]); PG8_STAGE(PG8_SA(0, 1), gA, vc[1]);
    if (wr == 1) PG8_BAR;
    PG8_WAIT_V(2); PG8_BAR;
    PG8_STAGE(PG8_SB(1, 0), cB + kstep, voffB); PG8_STAGE(PG8_SA(1, 0), gA + kstep, vc[0]); PG8_STAGE(PG8_SB(1, 1), cB + hstep + kstep, voffB);
    PG8_WAIT_V(6); PG8_BAR;
    for (;;) {
        const bool has_next = S.next(ui + 1, nxt);
        const char* nB = has_next ? (const char*)gBt_ + (size_t)nxt.pn * tstep : cB;
#pragma clang loop unroll(disable)
        for (int t = 0; t < nt - 2; t += 2) { PG8_SP1A(gA + (size_t)(t + 1) * kstep); PG8_REST(gA + (size_t)(t + 2) * kstep, cB + (size_t)(t + 2) * kstep); }
        PG8_SP1A(gA + (size_t)(nt - 1) * kstep);
        if (has_next) PG8_VOFF(vc, nxt, ui + 1);
        PG8_REST(gA, nB);
        if constexpr (FP8) {
            asm volatile("s_nop 15\n\ts_nop 15" ::: "memory");
#pragma unroll
            for (int a = 0; a < 2; ++a)
#pragma unroll
                for (int b = 0; b < 2; ++b)
#pragma unroll
                    for (int m = 0; m < 4; ++m)
#pragma unroll
                        for (int n = 0; n < 2; ++n) asm volatile("" : "+v"(acc[a][b][m][n]));
        }
        if (wr == 0) PG8_BAR;
        E(acc, cur, lds + EPI_LDS + (ui & 1) * 1024);
        if (!has_next) break;
#pragma unroll
        for (int a = 0; a < 2; ++a)
#pragma unroll
            for (int b = 0; b < 2; ++b)
#pragma unroll
                for (int m = 0; m < 4; ++m)
#pragma unroll
                    for (int n = 0; n < 2; ++n) acc[a][b][m][n] = (f32x4){0.f, 0.f, 0.f, 0.f};
        cur = nxt; cB = nB; ++ui;
        if (wid == 0) E.prefetch(cur, ldsb_epi0 + (unsigned)((ui & 1) * 1024), lane);
        if (wr == 1) PG8_BAR;
    }
    PG8_WAIT_V(0);
    PG8_BAR;
#undef PG8_SA
#undef PG8_SB
#undef PG8_STAGE
#undef PG8_STAGEK
#undef PG8_LDA
#undef PG8_LDB
#undef PG8_MMA
#undef PG8_WAIT_V
#undef PG8_WAIT_L
#undef PG8_BAR
#undef PG8_SCHED
#undef PG8_VOFF
#undef PG8_SP1A
#undef PG8_REST
}

struct DensePlan {
    int nM, nN, nwg, G, c;
    __device__ void init(int M, int N, int G_, int c_) { nM = M / BM; nN = N / BM; nwg = nM * nN; G = G_; c = c_; }
    __device__ __forceinline__ bool next(int i, Unit& u) const {
        const long L = (long)i * G + c; if (L >= nwg) return false;
        int wgid = (int)L; { const int q = nwg / 8, r = nwg % 8, xcd = wgid % 8, off = wgid / 8; wgid = (xcd < r ? xcd * (q + 1) : r * (q + 1) + (xcd - r) * q) + off; }
        const int nig = 8 * nN, gid = wgid / nig, fm = gid * 8, gsz = (nM - fm) < 8 ? (nM - fm) : 8;
        u.pm = fm + ((wgid % nig) % gsz); u.pn = (wgid % nig) / gsz; u.e = 0; u.lt = 0; u.ne = 0; return true;
    }
    __device__ __forceinline__ unsigned rowA(const Unit& u, int, int r) const { return (unsigned)(u.pm * BM + r); }
};
template <bool GATHER>
struct MoePlan {
    const PG8_LAS int* desc; const PG8_LAS unsigned short* rowtab;
    __device__ __forceinline__ bool next(int i, Unit& u) const {
        if (i >= MAXU) return false;
        const PG8_LAS int* d = desc + i * 8;
        const int v = __builtin_amdgcn_readfirstlane(d[0]); u.pm = __builtin_amdgcn_readfirstlane(d[1]); u.pn = __builtin_amdgcn_readfirstlane(d[2]);
        u.e = __builtin_amdgcn_readfirstlane(d[3]); u.lt = __builtin_amdgcn_readfirstlane(d[4]); u.ne = __builtin_amdgcn_readfirstlane(d[5]); return v != 0;
    }
    __device__ __forceinline__ unsigned rowA(const Unit& u, int ui, int r) const { return GATHER ? (unsigned)rowtab[ui * 256 + r] : (unsigned)(u.pm * BM + r); }
};
template <bool GATHER>
__device__ __forceinline__ MoePlan<GATHER> moe_plan_setup(PG8_LAS unsigned char* tab, const int* cnt, const int* ltok, int NT, int G, int c) {
    PG8_LAS int* desc = (PG8_LAS int*)tab; PG8_LAS unsigned short* rowtab = (PG8_LAS unsigned short*)(tab + MAXU * 32);
    PG8_LAS int* cs = (PG8_LAS int*)rowtab;
    PG8_LAS int* bs = cs + 32;
    const int tid = otid(), xcd = c & 7, j = c >> 3;
    if (tid < 32) cs[tid] = __hip_atomic_load(cnt + tid, __ATOMIC_RELAXED, __HIP_MEMORY_SCOPE_AGENT);
    __syncthreads();
    if (tid < 64) { const int ln = tid & 63; int v = (ln < 32) ? (cs[ln & 31] + BM - 1) / BM : 0, incl = v;
#pragma unroll
        for (int o = 1; o < 32; o <<= 1) { const int up = __shfl_up(incl, o); if (ln >= o) incl += up; }
        if (ln < 32) bs[ln] = incl - v; if (ln == 31) bs[32] = incl; }
    __syncthreads();
    if (tid < MAXU) {
        const int q = tid * (G >> 3) + j, mt = (q / NT) * 8 + xcd, pnl = q % NT;
        int e = -1;
        for (int k = 0; k < 32; ++k) if (mt >= bs[k] && mt < bs[k + 1]) e = k;
        desc[tid * 8 + 0] = e >= 0 ? 1 : 0; desc[tid * 8 + 1] = mt; desc[tid * 8 + 2] = (e >= 0 ? e : 0) * NT + pnl; desc[tid * 8 + 3] = e;
        desc[tid * 8 + 4] = e >= 0 ? mt - bs[e] : 0; desc[tid * 8 + 5] = e >= 0 ? cs[e] : 0;
    }
    __syncthreads();
    if (GATHER && tid < 256) {
        for (int i = 0; i < MAXU; ++i) {
            const PG8_LAS int* d = desc + i * 8; const int valid = d[0], e = d[3], lt = d[4], ne = d[5];
            const int p = lt * BM + tid; rowtab[i * 256 + tid] = (unsigned short)((valid && p < ne) ? ltok[(size_t)e * TC + p] : 0);
        }
    }
    __syncthreads();
    MoePlan<GATHER> S; S.desc = desc; S.rowtab = rowtab; return S;
}

struct EpiBf16 {
    __device__ __forceinline__ void prefetch(const Unit& u, unsigned lds_dst, int lane) const { glds16s<0>(rstd + (size_t)u.pm * BM, (unsigned)(lane * 16), lds_dst); }
    static constexpr bool PERM = true;
    bf16_t* O; int ldc; const float* rope; int rope_tiles; const float* rstd;
    __device__ __forceinline__ void operator()(const f32x4 (&acc)[2][2][4][2], const Unit& u, const PG8_LAS unsigned char* el) const {
        const int tv_ = otid();
        const int wr = tv_ >> 8, wc = (tv_ >> 6) & 3, fr = tv_ & 15, fq = (tv_ >> 4) & 3;
        const int row0 = u.pm * BM + wr * 64 + fr, col0 = u.pn * BM + wc * 32 + 8 * fq;
        const bool rot = (u.pn < rope_tiles) && ((__builtin_amdgcn_readfirstlane(tv_ >> 6) & 1) == 0);
#pragma unroll
        for (int ai = 0; ai < 2; ++ai) {
            f32x4 rc[4][4];
            if (rot) {
#pragma unroll
                for (int m = 0; m < 4; ++m) { const float* rp = rope + (size_t)(row0 + ai * HALF + m * 16) * 16;
#pragma unroll
                    for (int q = 0; q < 4; ++q) rc[m][q] = *(const f32x4*)(rp + 4 * q); }
                asm volatile("" ::: "memory");
            }
#pragma unroll
            for (int m = 0; m < 4; ++m) { const int row = row0 + ai * HALF + m * 16; bf16_t* rowp = O + (size_t)row * ldc + col0;
                const float rsd = ((const PG8_LAS float*)el)[wr * 64 + fr + ai * HALF + m * 16];
                f32x4 cs0, cs1, sn0, sn1;
                if (rot) { cs0 = rc[m][0]; cs1 = rc[m][1]; sn0 = rc[m][2]; sn1 = rc[m][3];
                    if (fq == 0) { sn0 = -sn0; sn1 = -sn1; } }
#pragma unroll
                for (int bj = 0; bj < 2; ++bj) { f32x4 v0 = acc[ai][bj][m][0] * rsd, v1 = acc[ai][bj][m][1] * rsd;
                    if (rot) { f32x4 p0, p1;
#pragma unroll
                        for (int j = 0; j < 4; ++j) { p0[j] = __shfl_xor(v0[j], 16); p1[j] = __shfl_xor(v1[j], 16); }
                        if (fq < 2) { v0 = v0 * cs0 + p0 * sn0; v1 = v1 * cs1 + p1 * sn1; } }
                    u32x4 w; w.x = cvt_pk_bf16(v0[0], v0[1]); w.y = cvt_pk_bf16(v0[2], v0[3]); w.z = cvt_pk_bf16(v1[0], v1[1]); w.w = cvt_pk_bf16(v1[2], v1[3]);
                    *(u32x4*)(rowp + bj * HALF) = w; } }
        }
    }
};
struct EpiResBf16 {
    __device__ __forceinline__ void prefetch(const Unit&, unsigned, int) const {}
    static constexpr bool PERM = true;
    bf16_t* XB; const bf16_t* resid; int ldc;
    __device__ __forceinline__ void operator()(const f32x4 (&acc)[2][2][4][2], const Unit& u, const PG8_LAS unsigned char* el) const {
        const int tv_ = otid();
        const int wr = tv_ >> 8, wc = (tv_ >> 6) & 3, fr = tv_ & 15, fq = (tv_ >> 4) & 3;
        const int row0 = u.pm * BM + wr * 64 + fr, col0 = u.pn * BM + wc * 32 + 8 * fq;
        u32x4 xr[2][4][2];
#pragma unroll
        for (int ai = 0; ai < 2; ++ai)
#pragma unroll
            for (int m = 0; m < 4; ++m)
#pragma unroll
                for (int bj = 0; bj < 2; ++bj) xr[ai][m][bj] = *(const u32x4*)(resid + (size_t)(row0 + ai * HALF + m * 16) * ldc + col0 + bj * HALF);
        asm volatile("" ::: "memory");
#pragma unroll
        for (int ai = 0; ai < 2; ++ai)
#pragma unroll
            for (int m = 0; m < 4; ++m) { const size_t off = (size_t)(row0 + ai * HALF + m * 16) * ldc + col0;
#pragma unroll
                for (int bj = 0; bj < 2; ++bj) { const u32x4 x4 = xr[ai][m][bj];
                    const f32x4 v0 = (f32x4){__uint_as_float(x4.x << 16), __uint_as_float(x4.x & 0xffff0000u), __uint_as_float(x4.y << 16), __uint_as_float(x4.y & 0xffff0000u)} + acc[ai][bj][m][0],
                                v1 = (f32x4){__uint_as_float(x4.z << 16), __uint_as_float(x4.z & 0xffff0000u), __uint_as_float(x4.w << 16), __uint_as_float(x4.w & 0xffff0000u)} + acc[ai][bj][m][1];
                    u32x4 w; w.x = cvt_pk_bf16(v0[0], v0[1]); w.y = cvt_pk_bf16(v0[2], v0[3]); w.z = cvt_pk_bf16(v1[0], v1[1]); w.w = cvt_pk_bf16(v1[2], v1[3]);
                    *(u32x4*)(XB + off + bj * HALF) = w; } }
    }
};
struct EpiGLU {
    static constexpr bool PERM = true;
    bf16_t* HM; const float* b_gu; int NT;
    __device__ __forceinline__ void prefetch(const Unit& u, unsigned lds_dst, int lane) const {
        const int pnl = u.pn - u.e * NT; glds16s<0>(b_gu + (size_t)u.e * 2048 + pnl * HALF, (unsigned)((lane & 31) * 16 + (lane >> 5) * 4096), lds_dst); }
    __device__ __forceinline__ void operator()(const f32x4 (&acc)[2][2][4][2], const Unit& u, const PG8_LAS unsigned char* el) const {
        const int tv_ = otid();
        const int wr = tv_ >> 8, wc = (tv_ >> 6) & 3, fr = tv_ & 15, fq = (tv_ >> 4) & 3;
        const int pnl = u.pn - u.e * NT, f0 = pnl * HALF + wc * 32 + 8 * fq, row0 = u.pm * BM + wr * 64 + fr;
        const PG8_LAS float* bl = (const PG8_LAS float*)el + wc * 32 + 8 * fq;
        f32x4 bg4[2], bu1[2];
#pragma unroll
        for (int n = 0; n < 2; ++n) { bg4[n] = *(const PG8_LAS f32x4*)(bl + 4 * n) * FP8_SH; bu1[n] = *(const PG8_LAS f32x4*)(bl + 128 + 4 * n) + 1.0f; }
        constexpr float rs = 1.0f / (FP8_SX * FP8_SW), rs4 = rs * FP8_SH, ec = -1.702f * 1.4426950408889634f / FP8_SH;
#pragma unroll
        for (int ai = 0; ai < 2; ++ai)
#pragma unroll
            for (int m = 0; m < 4; ++m) { unsigned pk[2];
#pragma unroll
                for (int n = 0; n < 2; ++n) {
                    f32x4 g4 = acc[ai][0][m][n] * rs4 + bg4[n], u1 = acc[ai][1][m][n] * rs + bu1[n];
#pragma unroll
                    for (int j = 0; j < 4; ++j) { g4[j] = fminf(g4[j], 7.0f * FP8_SH); u1[j] = __builtin_amdgcn_fmed3f(u1[j], -6.0f, 8.0f); }
                    f32x4 ea = g4 * ec, den;
#pragma unroll
                    for (int j = 0; j < 4; ++j) den[j] = __builtin_amdgcn_exp2f(ea[j]);
                    den = den + 1.0f;
                    f32x4 h4 = u1 * g4;
#pragma unroll
                    for (int j = 0; j < 4; ++j) den[j] = __builtin_amdgcn_rcpf(den[j]);
                    h4 = h4 * den;
                    pk[n] = pk4_fp8_nc(h4[0], h4[1], h4[2], h4[3]); }
                *(unsigned long long*)((unsigned char*)HM + (size_t)(row0 + ai * HALF + m * 16) * FF + f0) = (unsigned long long)pk[0] | ((unsigned long long)pk[1] << 32); }
    }
};
struct EpiDown {
    static constexpr bool PERM = true;
    bf16_t* YP; const float* b_d; int NT;
    __device__ __forceinline__ void prefetch(const Unit& u, unsigned lds_dst, int lane) const {
        const int pnl = u.pn - u.e * NT; glds16s<0>(b_d + (size_t)u.e * 1024 + pnl * BM, (unsigned)(lane * 16), lds_dst); }
    __device__ __forceinline__ void operator()(const f32x4 (&acc)[2][2][4][2], const Unit& u, const PG8_LAS unsigned char* el) const {
        const int tv_ = otid();
        const int wr = tv_ >> 8, wc = (tv_ >> 6) & 3, fr = tv_ & 15, fq = (tv_ >> 4) & 3;
        const int pnl = u.pn - u.e * NT, col0 = pnl * BM + wc * 32 + 8 * fq, rl0 = wr * 64 + fr;
        const PG8_LAS float* bl = (const PG8_LAS float*)el + wc * 32 + 8 * fq;
        f32x4 bv[2][2];
#pragma unroll
        for (int bj = 0; bj < 2; ++bj)
#pragma unroll
            for (int n = 0; n < 2; ++n) bv[bj][n] = *(const PG8_LAS f32x4*)(bl + bj * HALF + 4 * n) * FP8_SY;
        constexpr float sa = FP8_SY / (FP8_SH * FP8_SW);
#pragma unroll
        for (int ai = 0; ai < 2; ++ai)
#pragma unroll
            for (int m = 0; m < 4; ++m) { const int rl = rl0 + ai * HALF + m * 16;
                unsigned char* rowp = (unsigned char*)YP + (size_t)(u.pm * BM + rl) * D + col0;
#pragma unroll
                for (int bj = 0; bj < 2; ++bj) { const f32x4 v0 = acc[ai][bj][m][0] * sa + bv[bj][0], v1 = acc[ai][bj][m][1] * sa + bv[bj][1];
                    *(unsigned long long*)(rowp + bj * HALF) = (unsigned long long)pk4_fp8(v0[0], v0[1], v0[2], v0[3]) | ((unsigned long long)pk4_fp8(v1[0], v1[1], v1[2], v1[3]) << 32); } }
    }
};
}


namespace dattn {
typedef float f32x16 __attribute__((ext_vector_type(16)));
typedef short s16x4 __attribute__((ext_vector_type(4)));
constexpr int NW = 8, QBLK = 32, KVBLK = 64, QB = NW * QBLK, DK = 64, DV = 128, RS = INW;
constexpr int SHM_V = KVBLK * DV * 2, SHM_K = KVBLK * DK * 2;
constexpr int NVB = 4;
constexpr int LDS_V = 0, LDS_K = NVB * SHM_V, LDS_WS = LDS_K + 2 * SHM_K, LDS_OST = LDS_WS + NW * 64 * 4, LDS_BYTES = LDS_OST + NW * 8192;
constexpr float SCALE = 0.125f, THR = 8.f;
#define KSWZ64(row, colB) ((row) * 128 + ((colB) ^ ((((row) >> 1) & 7) << 4)))
#define SBAR() __builtin_amdgcn_sched_barrier(0)
__device__ __forceinline__ int v_slot_key(int p) { const int kk = ((p >> 7) << 3) | ((p & 31) >> 2); return (kk & ~0xC) | ((kk & 4) << 1) | ((kk & 8) >> 1); }
__device__ __forceinline__ int v_slot_col(int p) { return ((p >> 5) & 3) * 32 + (p & 3) * 8; }
__device__ __forceinline__ int v_rd_base(int lane) { return ((lane & 3) << 3) | (((lane >> 2) & 3) << 6) | (((lane >> 4) & 1) << 5) | (((lane >> 5) & 1) << 8); }
constexpr int v_rd_off(int d0, int ks, int half) { return d0 * 512 + ks * 4096 + half * 2048; }
__device__ __forceinline__ int crow(int r, int hi) { return (r & 3) + 8 * (r >> 2) + 4 * hi; }
__device__ __forceinline__ unsigned cvtpk(float lo, float hi) { unsigned r; asm volatile("v_cvt_pk_bf16_f32 %0, %1, %2" : "=v"(r) : "v"(lo), "v"(hi)); return r; }
__device__ __forceinline__ bf16x8 load8(const bf16_t* p) { return *reinterpret_cast<const bf16x8*>(p); }
__device__ __forceinline__ void mask_tile(f32x16& p0, f32x16& p1, int dq) {
    const float NEG = -__builtin_inff();
#pragma unroll
    for (int r = 0; r < 16; ++r) { const int c = (r & 3) + 8 * (r >> 2); if (dq - c < 0) p0[r] = NEG; if (dq - c - 32 < 0) p1[r] = NEG; }
}
__device__ __forceinline__ void partialSM(f32x16& p0, f32x16& p1, float& m_reg, float& mn, float& alpha) {
    float pmax = p0[0];
#pragma unroll
    for (int r = 1; r < 16; ++r) pmax = fmaxf(pmax, p0[r]);
#pragma unroll
    for (int r = 0; r < 16; ++r) pmax = fmaxf(pmax, p1[r]);
    { auto rr = __builtin_amdgcn_permlane32_swap(__float_as_uint(pmax), __float_as_uint(pmax), false, false); pmax = fmaxf(__uint_as_float(rr[0]), __uint_as_float(rr[1])); }
    constexpr float C2 = 1.4426950408889634f * SCALE;
    if (__builtin_expect(__all((pmax - m_reg) * SCALE <= THR), 1)) { mn = m_reg; alpha = 1.f; }
    else { mn = fmaxf(m_reg, pmax); alpha = __builtin_amdgcn_exp2f((m_reg - mn) * C2); m_reg = mn; }
    const float mnL = -mn * C2;
#pragma unroll
    for (int r = 0; r < 16; ++r) p0[r] = fmaf(p0[r], C2, mnL);
#pragma unroll
    for (int r = 0; r < 16; ++r) p1[r] = fmaf(p1[r], C2, mnL);
#pragma unroll
    for (int r = 0; r < 16; ++r) p0[r] = __builtin_amdgcn_exp2f(p0[r]);
}
__device__ __forceinline__ void finishSM(f32x16& p0, f32x16& p1, float alpha, float& l_reg, bf16x8& pa0, bf16x8& pa1, bf16x8& pa2, bf16x8& pa3) {
#pragma unroll
    for (int r = 0; r < 16; ++r) p1[r] = __builtin_amdgcn_exp2f(p1[r]);
    float ps = 0;
#pragma unroll
    for (int r = 0; r < 16; ++r) ps += p0[r];
#pragma unroll
    for (int r = 0; r < 16; ++r) ps += p1[r];
    { auto rr = __builtin_amdgcn_permlane32_swap(__float_as_uint(ps), __float_as_uint(ps), false, false); ps = __uint_as_float(rr[0]) + __uint_as_float(rr[1]); }
    l_reg = l_reg * alpha + ps;
#define PK4(P, B_, OUT) do { unsigned a0 = cvtpk(P[B_+0], P[B_+1]), a1 = cvtpk(P[B_+2], P[B_+3]);                          \
        unsigned b0 = cvtpk(P[B_+4], P[B_+5]), b1 = cvtpk(P[B_+6], P[B_+7]);                                             \
        auto r0 = __builtin_amdgcn_permlane32_swap(a0, b0, false, false); auto r1 = __builtin_amdgcn_permlane32_swap(a1, b1, false, false); \
        u32x4 w = {r0[0], r1[0], r0[1], r1[1]}; OUT = *reinterpret_cast<bf16x8*>(&w); } while (0)
    PK4(p0, 0, pa0); PK4(p0, 8, pa1); PK4(p1, 0, pa2); PK4(p1, 8, pa3);
#undef PK4
}
template <int KB>
__device__ __forceinline__ void qkt(f32x16& p0, f32x16& p1, const char* K_lds, int r32, int hi, const bf16x8* qr) {
    p0 = f32x16{}; p1 = f32x16{};
#pragma unroll
    for (int d0 = 0; d0 < 4; ++d0) { const char* a = K_lds + KB * SHM_K + KSWZ64(r32, (d0 * 16 + hi * 8) * 2);
        bf16x8 b0 = *reinterpret_cast<const bf16x8*>(a);
        bf16x8 b1 = *reinterpret_cast<const bf16x8*>(a + 32 * 128);
        p0 = __builtin_amdgcn_mfma_f32_32x32x16_bf16(b0, qr[d0], p0, 0, 0, 0);
        p1 = __builtin_amdgcn_mfma_f32_32x32x16_bf16(b1, qr[d0], p1, 0, 0, 0); }
}
template <int VB>
__device__ __forceinline__ void pv_tile(f32x16* o, int vb0, bf16x8 pa0, bf16x8 pa1, bf16x8 pa2, bf16x8 pa3) {
#define TRRD(dst, off) asm volatile("ds_read_b64_tr_b16 %0, %1 offset:%2" : "=&v"(dst) : "v"(vb0), "i"(off) : "memory")
#define PV_RD(S, d0) do { constexpr int b_ = LDS_V + VB * SHM_V + v_rd_off(d0, 0, 0); \
        TRRD(S##l0, b_); TRRD(S##h0, b_ + 2048); TRRD(S##l1, b_ + 4096); TRRD(S##h1, b_ + 6144); TRRD(S##l2, b_ + 8192); TRRD(S##h2, b_ + 10240); TRRD(S##l3, b_ + 12288); TRRD(S##h3, b_ + 14336); } while (0)
#define PV_MM(S, d0) do { \
        o[d0] = __builtin_amdgcn_mfma_f32_32x32x16_bf16(pa0, (bf16x8){S##l0[0], S##l0[1], S##l0[2], S##l0[3], S##h0[0], S##h0[1], S##h0[2], S##h0[3]}, o[d0], 0, 0, 0);   \
        o[d0] = __builtin_amdgcn_mfma_f32_32x32x16_bf16(pa1, (bf16x8){S##l1[0], S##l1[1], S##l1[2], S##l1[3], S##h1[0], S##h1[1], S##h1[2], S##h1[3]}, o[d0], 0, 0, 0);   \
        o[d0] = __builtin_amdgcn_mfma_f32_32x32x16_bf16(pa2, (bf16x8){S##l2[0], S##l2[1], S##l2[2], S##l2[3], S##h2[0], S##h2[1], S##h2[2], S##h2[3]}, o[d0], 0, 0, 0);   \
        o[d0] = __builtin_amdgcn_mfma_f32_32x32x16_bf16(pa3, (bf16x8){S##l3[0], S##l3[1], S##l3[2], S##l3[3], S##h3[0], S##h3[1], S##h3[2], S##h3[3]}, o[d0], 0, 0, 0); } while (0)
#define LGK(n) do { asm volatile("s_waitcnt lgkmcnt(" #n ")" ::: "memory"); SBAR(); } while (0)
    s16x4 Al0, Al1, Al2, Al3, Ah0, Ah1, Ah2, Ah3, Bl0, Bl1, Bl2, Bl3, Bh0, Bh1, Bh2, Bh3;
    PV_RD(A, 0); PV_RD(B, 1); LGK(8); PV_MM(A, 0); SBAR();
    PV_RD(A, 2); LGK(8); PV_MM(B, 1); SBAR();
    PV_RD(B, 3); LGK(8); PV_MM(A, 2); SBAR();
    LGK(0); PV_MM(B, 3);
#undef PV_RD
#undef PV_MM
#undef LGK
#undef TRRD
}
struct BlockRef { const bf16_t* Q; const bf16_t* K; const bf16_t* V; bf16_t* OUT; int P0, c; };
struct Seam { bf16x8 qr[4]; };
#define DA_VMW() asm volatile("s_waitcnt vmcnt(0)" ::: "memory")
#define DA_KDMA(Kp, k0, bf) pg8::glds16s<0>((Kp) + (size_t)(k0) * RS, kvo, kdst + (unsigned)((bf) * SHM_K))
#define DA_VDMA(Vp, k0, bf) do { pg8::glds16s<0>((Vp) + (size_t)(k0) * RS, vvo0, vdst + (unsigned)((bf) * SHM_V)); pg8::glds16s<0>((Vp) + (size_t)(k0) * RS, vvo1, vdst + (unsigned)((bf) * SHM_V + 8192)); } while (0)
#define DA_ADDR() \
    const int kr = tid >> 3; \
    const unsigned kvo = (unsigned)(kr * RS + (((tid & 7) ^ ((kr >> 1) & 7)) * 8)) * 2u, kdst = (unsigned)__builtin_amdgcn_readfirstlane((unsigned)(uintptr_t)lds + LDS_K + wid * 1024); \
    const unsigned vvo0 = (unsigned)(v_slot_key(tid) * RS + v_slot_col(tid)) * 2u, vvo1 = (unsigned)(v_slot_key(tid + 512) * RS + v_slot_col(tid + 512)) * 2u, \
                   vdst = (unsigned)__builtin_amdgcn_readfirstlane((unsigned)(uintptr_t)lds + LDS_V + wid * 1024)
__device__ __forceinline__ void prime(const BlockRef& cur, char* lds, Seam& S) {
    const int tid = otid(), wid = __builtin_amdgcn_readfirstlane(tid >> 6), lane = tid & 63, r32 = lane & 31, hi = lane >> 5;
    DA_ADDR();
#pragma unroll
    for (int d0 = 0; d0 < 4; ++d0) S.qr[d0] = load8(cur.Q + (size_t)(wid * QBLK + r32) * RS + d0 * 16 + hi * 8);
    DA_KDMA(cur.K, 0, 0); DA_VDMA(cur.V, 0, 0); DA_VMW();
    __syncthreads();
}
__device__ __forceinline__ void block(const BlockRef& cur, const BlockRef& nxt, char* lds, Seam& S, float lam, const float* __restrict__ subln_w) {
    const int tid = otid(), wid = __builtin_amdgcn_readfirstlane(tid >> 6), lane = tid & 63, r32 = lane & 31, hi = lane >> 5;
    const int NT = (cur.P0 + QB) / KVBLK;
    const int qlo = cur.P0 + wid * QBLK, qm = qlo + r32 - 4 * hi;
    char* K_lds = lds + LDS_K;
    float* ws = (float*)(lds + LDS_WS) + wid * 64; float* li_l = ws; float* al_l = ws + 32;
    float m_reg = -1e30f, l_reg = 0; f32x16 o[4] = {};
    DA_ADDR();
    const int vb0 = (int)(uintptr_t)lds + v_rd_base(lane);
    const bf16_t* Kh = cur.K; const bf16_t* Vh = cur.V;
#define RESC(a) do { if (__any((a) < 1.f)) { if (hi == 0) al_l[r32] = (a); asm volatile("s_waitcnt lgkmcnt(0)" ::: "memory");              \
                     _Pragma("unroll") for (int d_ = 0; d_ < 4; ++d_) _Pragma("unroll") for (int r = 0; r < 16; ++r) o[d_][r] *= al_l[crow(r, hi)]; } } while (0)
#define KBASE(t) ((t) * KVBLK)
#define MASKT(P0_, P1_, t) do { const int kb_ = KBASE(t); if (kb_ + KVBLK - 1 > qlo) mask_tile(P0_, P1_, qm - kb_); } while (0)
    f32x16 pA0, pA1, pB0, pB1; float mnA, mnB, alA, alB; bf16x8 pa0, pa1, pa2, pa3;
    DA_KDMA(Kh, KBASE(1), 1); DA_VDMA(Vh, KBASE(1), 1);
    SBAR(); qkt<0>(pA0, pA1, K_lds, r32, hi, S.qr);
    MASKT(pA0, pA1, 0); partialSM(pA0, pA1, m_reg, mnA, alA);
    DA_VMW(); __syncthreads();
#define HALF_STEP(PX0, PX1, mnX, alX, PY0, PY1, alY, t, KB, VBP, KBN, VBN) do {                                               \
        SBAR(); qkt<KB>(PX0, PX1, K_lds, r32, hi, S.qr);                                                                      \
        finishSM(PY0, PY1, alY, l_reg, pa0, pa1, pa2, pa3); SBAR();                                                           \
        DA_KDMA(Kh, KBASE((t) + 1), KBN); DA_VDMA(Vh, KBASE((t) + 1), VBN); SBAR();                                          \
        pv_tile<VBP>(o, vb0, pa0, pa1, pa2, pa3); MASKT(PX0, PX1, (t)); partialSM(PX0, PX1, m_reg, mnX, alX);                  \
        RESC(alX); DA_VMW(); __syncthreads(); } while (0)
    HALF_STEP(pB0, pB1, mnB, alB, pA0, pA1, alA, 1, 1, 0, 0, 2);
    HALF_STEP(pA0, pA1, mnA, alA, pB0, pB1, alB, 2, 0, 1, 1, 3);
    for (int t = 3; t + 1 < NT; t += 4) {
        HALF_STEP(pB0, pB1, mnB, alB, pA0, pA1, alA, t, 1, 2, 0, 0);
        HALF_STEP(pA0, pA1, mnA, alA, pB0, pB1, alB, t + 1, 0, 3, 1, 1);
        HALF_STEP(pB0, pB1, mnB, alB, pA0, pA1, alA, t + 2, 1, 0, 0, 2);
        HALF_STEP(pA0, pA1, mnA, alA, pB0, pB1, alB, t + 3, 0, 1, 1, 3);
    }
    SBAR(); qkt<1>(pB0, pB1, K_lds, r32, hi, S.qr); SBAR();
    DA_KDMA(nxt.K, 0, 0); DA_VDMA(nxt.V, 0, 0); SBAR();
#pragma unroll
    for (int d0 = 0; d0 < 4; ++d0) S.qr[d0] = load8(nxt.Q + (size_t)(wid * QBLK + r32) * RS + d0 * 16 + hi * 8);
    SBAR();
    finishSM(pA0, pA1, alA, l_reg, pa0, pa1, pa2, pa3); SBAR();
    pv_tile<2>(o, vb0, pa0, pa1, pa2, pa3);
    MASKT(pB0, pB1, NT - 1); partialSM(pB0, pB1, m_reg, mnB, alB); RESC(alB);
    finishSM(pB0, pB1, alB, l_reg, pa0, pa1, pa2, pa3); SBAR(); pv_tile<3>(o, vb0, pa0, pa1, pa2, pa3);
    SBAR();
    if (hi == 0) li_l[r32] = l_reg;
    asm volatile("s_waitcnt lgkmcnt(0)" ::: "memory");
    float rli[16];
#pragma unroll
    for (int r = 0; r < 16; ++r) rli[r] = __builtin_amdgcn_rcpf(li_l[crow(r, hi)]);
    unsigned* ostw = (unsigned*)(lds + LDS_OST + wid * 8192);
    if (cur.c == 1) {
#pragma unroll
        for (int d0 = 0; d0 < 4; ++d0)
#pragma unroll
            for (int r = 0; r < 16; r += 2) ostw[(d0 * 8 + (r >> 1)) * 64 + lane] = cvtpk(o[d0][r] * rli[r], o[d0][r + 1] * rli[r + 1]);
    } else {
        float ss[16];
#pragma unroll
        for (int r = 0; r < 16; ++r) ss[r] = 0.f;
#pragma unroll
        for (int d0 = 0; d0 < 4; ++d0)
#pragma unroll
            for (int r = 0; r < 16; r += 2) { const unsigned u = ostw[(d0 * 8 + (r >> 1)) * 64 + lane];
                const float v0 = o[d0][r] * rli[r] - lam * __uint_as_float(u << 16), v1 = o[d0][r + 1] * rli[r + 1] - lam * __uint_as_float(u & 0xffff0000u);
                o[d0][r] = v0; o[d0][r + 1] = v1; ss[r] += v0 * v0; ss[r + 1] += v1 * v1; }
#pragma unroll
        for (int msk = 1; msk < 32; msk <<= 1)
#pragma unroll
            for (int r = 0; r < 16; ++r) ss[r] += __shfl_xor(ss[r], msk);
        float sw[4];
#pragma unroll
        for (int d0 = 0; d0 < 4; ++d0) sw[d0] = subln_w[d0 * 32 + r32] * 0.8f;
        asm volatile("s_waitcnt lgkmcnt(0)" ::: "memory");
        bf16_t* stg = (bf16_t*)ostw;
#pragma unroll
        for (int r = 0; r < 16; ++r) { const float rs = 1.0f / sqrtf(ss[r] * (1.f / 128.f) + EPS); const int orow = crow(r, hi);
#pragma unroll
            for (int d0 = 0; d0 < 4; ++d0) stg[orow * 128 + d0 * 32 + r32] = (bf16_t)f2bf(o[d0][r] * rs * sw[d0]); }
        asm volatile("s_waitcnt lgkmcnt(0)" ::: "memory");
        bf16_t* Ow = cur.OUT + (size_t)(wid * QBLK) * D;
#pragma unroll
        for (int i = 0; i < 8; ++i) { const int row = i * 4 + (lane >> 4), ch = lane & 15; const u32x4 v = *(const u32x4*)(stg + row * 128 + ch * 8); *(u32x4*)(Ow + (size_t)row * D + ch * 8) = v; }
    }
    DA_VMW();
    __syncthreads();
#undef RESC
#undef KBASE
#undef MASKT
#undef HALF_STEP
}
#undef DA_VMW
#undef DA_KDMA
#undef DA_VDMA
#undef DA_ADDR
__device__ __forceinline__ BlockRef ref_of(int L, int seq, const bf16_t* PROJ, bf16_t* CAT) {
    const int bh = L >> 2, y = L & 3, b = bh >> 2, h = bh & 3, qb = (seq < 2) ? y : 7 - y, c = (seq & 1) ? 0 : 1;
    BlockRef r; const size_t row0 = (size_t)b * SEQ;
    r.Q = PROJ + (row0 + (size_t)qb * QB) * RS + h * 128 + c * 64; r.K = PROJ + row0 * RS + 512 + h * 128 + c * 64; r.V = PROJ + row0 * RS + 1024 + h * 128;
    r.OUT = CAT + (row0 + (size_t)qb * QB) * D + h * 128; r.P0 = qb * QB; r.c = c; return r;
}
__device__ __forceinline__ void phase(char* lds, const bf16_t* PROJ, bf16_t* CAT, float lam, const float* subln_w, int G, int bid) {
    constexpr int TOTAL = (T / SEQ) * 4 * 4;
    const int v = (G % 8 == 0) ? (bid & 7) * (G >> 3) + (bid >> 3) : bid;
    int L = v; if (L >= TOTAL) return;
    int seq = 0; BlockRef cur = ref_of(L, 0, PROJ, CAT);
    Seam S; prime(cur, lds, S);
    for (;;) {
        int Ln = L, seqn = seq + 1; if (seqn == 4) { seqn = 0; Ln = L + G; }
        const bool last = Ln >= TOTAL;
        const BlockRef nxt = last ? cur : ref_of(Ln, seqn, PROJ, CAT);
        block(cur, nxt, lds, S, lam, subln_w);
        if (last) break;
        cur = nxt; L = Ln; seq = seqn;
    }
}
#undef KSWZ64
#undef SBAR
}


#define LAS __attribute__((address_space(3)))
constexpr int NWAVES = 8, NTHREADS = 512;
namespace rtr {
typedef float f32x2 __attribute__((ext_vector_type(2)));
constexpr int WPITCH = 2064;
constexpr int LDS_WHI = 0, LDS_WLO = 32 * WPITCH, LDS_LG = 64 * WPITCH, LDS_CNT = LDS_LG + 8 * 16 * 33 * 4, LDS_BYTES = LDS_CNT + 256;
static_assert(LDS_BYTES <= pg8::STAGE_BYTES + pg8::PLAN_BYTES, "router LDS overlaps the grid barrier's LDS words");
__device__ __forceinline__ void phase(LAS unsigned char* lds, const bf16_t* __restrict__ x1, const float* __restrict__ fw, const float* __restrict__ rw, const float* __restrict__ rb,
                                      int* cnt, int* ltok, float* lgate, int* slot, unsigned char* __restrict__ XQ, int G, int bid) {
    const int tid = otid(), lane = tid & 63, wid = __builtin_amdgcn_readfirstlane(tid >> 6), r = lane & 15, q = lane >> 4;
    LAS float* lg = (LAS float*)(lds + LDS_LG) + wid * (16 * 33); LAS int* lcount = (LAS int*)(lds + LDS_CNT); LAS int* lbase = lcount + 32;
    for (int idx = tid; idx < 1024 * 32; idx += NTHREADS) { const int k = idx >> 5, e = idx & 31; const float w = rw[idx] * fw[k];
        const unsigned hi = f2bf(w), lo = f2bf(w - __uint_as_float(hi << 16));
        *(LAS unsigned short*)(lds + LDS_WHI + e * WPITCH + 2 * k) = (unsigned short)hi; *(LAS unsigned short*)(lds + LDS_WLO + e * WPITCH + 2 * k) = (unsigned short)lo; }
    if (tid < 32) lcount[tid] = 0;
    __syncthreads();
    const float rb0 = rb[r], rb1 = rb[16 + r];
    const LAS unsigned char* whi = lds + LDS_WHI + r * WPITCH + 16 * q; const LAS unsigned char* wlo = lds + LDS_WLO + r * WPITCH + 16 * q;
    for (int tile = bid; tile < T / 128; tile += G) {
        const int t0 = tile * 128 + wid * 16, ch = (tile * 128) / TC;
        const bf16_t* xrow = x1 + (size_t)(t0 + r) * D + 8 * q;
        u32x4 xw[32];
#pragma unroll
        for (int j = 0; j < 32; ++j) xw[j] = *(const u32x4*)(xrow + 32 * j);
        f32x4 acc0 = {0.f, 0.f, 0.f, 0.f}, acc1 = {0.f, 0.f, 0.f, 0.f}; float ssq = 0.f;
#pragma unroll
        for (int j = 0; j < 32; ++j) {
            const bf16x8 av = *reinterpret_cast<const bf16x8*>(&xw[j]);
            const bf16x8 bh0 = *(const LAS bf16x8*)(whi + 64 * j), bh1 = *(const LAS bf16x8*)(whi + 16 * WPITCH + 64 * j), bl0 = *(const LAS bf16x8*)(wlo + 64 * j), bl1 = *(const LAS bf16x8*)(wlo + 16 * WPITCH + 64 * j);
            acc0 = __builtin_amdgcn_mfma_f32_16x16x32_bf16(av, bh0, acc0, 0, 0, 0); acc1 = __builtin_amdgcn_mfma_f32_16x16x32_bf16(av, bh1, acc1, 0, 0, 0);
            acc0 = __builtin_amdgcn_mfma_f32_16x16x32_bf16(av, bl0, acc0, 0, 0, 0); acc1 = __builtin_amdgcn_mfma_f32_16x16x32_bf16(av, bl1, acc1, 0, 0, 0);
#pragma unroll
            for (int i = 0; i < 4; ++i) { const float lo_ = __uint_as_float(xw[j][i] << 16), hi_ = __uint_as_float(xw[j][i] & 0xffff0000u); ssq += lo_ * lo_ + hi_ * hi_; }
            if ((j & 1) == 1) __builtin_amdgcn_sched_barrier(0);
        }
        ssq += __shfl_xor(ssq, 16); ssq += __shfl_xor(ssq, 32);
        const float rstd = 1.0f / sqrtf(ssq * (1.f / D) + EPS);
        { const float sx = rstd * FP8_SX;
#pragma unroll
          for (int j = 0; j < 32; ++j) { u32x4 xv = xw[j]; asm volatile("" : "+v"(xv));
              *(unsigned long long*)(XQ + (size_t)(t0 + r) * D + 32 * j + 8 * q) =
                  (unsigned long long)pk4_fp8(__uint_as_float(xv[0] << 16) * sx, __uint_as_float(xv[0] & 0xffff0000u) * sx, __uint_as_float(xv[1] << 16) * sx, __uint_as_float(xv[1] & 0xffff0000u) * sx)
                | ((unsigned long long)pk4_fp8(__uint_as_float(xv[2] << 16) * sx, __uint_as_float(xv[2] & 0xffff0000u) * sx, __uint_as_float(xv[3] << 16) * sx, __uint_as_float(xv[3] & 0xffff0000u) * sx) << 32); } }
        asm volatile("s_waitcnt lgkmcnt(0)" ::: "memory");
#pragma unroll
        for (int g4 = 0; g4 < 4; ++g4) { const float rs = __shfl(rstd, q * 4 + g4); lg[(q * 4 + g4) * 33 + r] = acc0[g4] * rs + rb0; lg[(q * 4 + g4) * 33 + 16 + r] = acc1[g4] * rs + rb1; }
        asm volatile("s_waitcnt lgkmcnt(0)" ::: "memory");
        int ti[4]; float gt[4]; int lpos[4];
        if (lane < 16) {
            float v[32];
#pragma unroll
            for (int e = 0; e < 32; ++e) v[e] = lg[lane * 33 + e];
            unsigned used = 0u; float tv[4];
#pragma unroll
            for (int k = 0; k < 4; ++k) { float best = -INFINITY; int bi = -1;
#pragma unroll
                for (int e = 0; e < 32; ++e) { const bool take = !((used >> e) & 1u) && (bi < 0 || v[e] > best); best = take ? v[e] : best; bi = take ? e : bi; }
                tv[k] = best; ti[k] = bi; used |= 1u << bi; }
            const float e1 = expf(tv[1] - tv[0]), e2 = expf(tv[2] - tv[0]), e3 = expf(tv[3] - tv[0]), inv = 1.f / (1.f + e1 + e2 + e3);
            gt[0] = inv; gt[1] = e1 * inv; gt[2] = e2 * inv; gt[3] = e3 * inv;
#pragma unroll
            for (int k = 0; k < 4; ++k) lpos[k] = __hip_atomic_fetch_add(lcount + ti[k], 1, __ATOMIC_RELAXED, __HIP_MEMORY_SCOPE_WORKGROUP);
        }
        __syncthreads();
        if (tid < 32) { const int c = lcount[tid]; lbase[tid] = c ? atomicAdd(&cnt[ch * 32 + tid], c) : 0; lcount[tid] = 0; }
        __syncthreads();
        if (lane < 16) { const int t = t0 + lane;
#pragma unroll
            for (int k = 0; k < 4; ++k) { const int pos = lbase[ti[k]] + lpos[k]; const size_t idx = ((size_t)ch * 32 + ti[k]) * TC + pos;
                ltok[idx] = t; lgate[idx] = gt[k]; slot[t * 4 + k] = (ti[k] << 16) | pos; } }
    }
    __syncthreads();
}
}

typedef unsigned gu32_t;
#define XB_TMO      128
#define XB_XCNT(j)  (256  + 64 * (j))
#define XB_XSUB(j)  (1280 + 64 * (j))
#define XB_XGEN(j)  (2304 + 64 * (j))
#define XB_TOP      3328
#define XB_TOPGEN   3392
#define XCD_BAR_WORDS 3456
#define XB_SPIN_CAP (1u << 18)

__device__ __forceinline__ unsigned xb_ld(unsigned* p)              { return __hip_atomic_load(p, __ATOMIC_RELAXED, __HIP_MEMORY_SCOPE_AGENT); }
__device__ __forceinline__ unsigned xb_add(unsigned* p, unsigned v) { return __hip_atomic_fetch_add(p, v, __ATOMIC_RELAXED, __HIP_MEMORY_SCOPE_AGENT); }
__device__ __forceinline__ unsigned xb_xcc_id() { return (unsigned)__builtin_amdgcn_s_getreg((3 << 11) | 20) & 0xFu; }
#define XB_SPIN(cond, bar) do { unsigned _sp = 0; while (cond) { __builtin_amdgcn_s_sleep(1); \
    if ((++_sp & 255u) == 0u) { if (xb_ld(&(bar)[XB_TMO])) break; if (_sp > XB_SPIN_CAP) { atomicAdd(&(bar)[XB_TMO], 1u); break; } } } } while (0)

struct XcdBarrier {
    unsigned* bar; unsigned x;
    volatile LAS unsigned* st;
};

__device__ __forceinline__ XcdBarrier xcd_barrier_post(unsigned* bar, volatile LAS unsigned* st) {
    XcdBarrier b; b.bar = bar; b.x = xb_xcc_id(); b.st = st;
    if (threadIdx.x == 0) (void)xb_add(&bar[XB_XCNT(b.x)], 1u);
    return b;
}
__device__ __forceinline__ void xcd_barrier_complete(unsigned* bar, unsigned x, unsigned& nloc, unsigned& nx) {
    const unsigned G = gridDim.x * gridDim.y * gridDim.z;
    unsigned sum, cnt, mine, sp = 0u;
    for (;;) {
        sum = 0u; cnt = 0u; mine = 0u;
#pragma unroll
        for (unsigned j = 0; j < 16; ++j) { const unsigned c = xb_ld(&bar[XB_XCNT(j)]); sum += c; cnt += (c > 0u) ? 1u : 0u; mine = (j == x) ? c : mine; }
        if (sum == G) break;
        __builtin_amdgcn_s_sleep(1);
        if ((++sp & 255u) == 0u) { if (xb_ld(&bar[XB_TMO])) break; if (sp > XB_SPIN_CAP) { atomicAdd(&bar[XB_TMO], 1u); break; } }
    }
    nloc = mine > 0u ? mine : 1u; nx = cnt > 0u ? cnt : 1u;
}

__device__ __forceinline__ void xcd_barrier(const XcdBarrier& b) {
    asm volatile("s_waitcnt vmcnt(0)" ::: "memory");
    __syncthreads();
    if (threadIdx.x == 0) {
        unsigned* bar = b.bar;
        __builtin_amdgcn_s_waitcnt(0);
        unsigned nloc = b.st[0], nx = b.st[1];
        if (nloc == 0u) { xcd_barrier_complete(bar, b.x, nloc, nx); b.st[0] = nloc; b.st[1] = nx; }
        const unsigned old = xb_add(&bar[XB_XSUB(b.x)], 1u);
        const unsigned gen = old / nloc;
        if (old + 1u == (gen + 1u) * nloc) {
            __builtin_amdgcn_fence(__ATOMIC_RELEASE, "agent");
            asm volatile("s_waitcnt vmcnt(0)" ::: "memory");
            const unsigned og = xb_add(&bar[XB_TOP], 1u);
            const unsigned tg = og / nx;
            if (og + 1u == (tg + 1u) * nx) xb_add(&bar[XB_TOPGEN], 1u);
            else XB_SPIN(xb_ld(&bar[XB_TOPGEN]) == tg, bar);
            __builtin_amdgcn_fence(__ATOMIC_ACQUIRE, "agent");
            xb_add(&bar[XB_XGEN(b.x)], 1u);
            asm volatile("s_waitcnt vmcnt(0)" ::: "memory");
        } else {
            XB_SPIN(xb_ld(&bar[XB_XGEN(b.x)]) == gen, bar);
            __builtin_amdgcn_fence(__ATOMIC_ACQUIRE, "agent");
            asm volatile("s_waitcnt vmcnt(0)" ::: "memory");
        }
    }
    __syncthreads();
}


constexpr int XB_LDS = pg8::STAGE_BYTES + pg8::PLAN_BYTES;
constexpr int MK_LDS = pg8::STAGE_BYTES + pg8::PLAN_BYTES + 64 + 2048;

struct MArgs {
    const float* x; const int* positions; const float* attn_norm_w; const float* w_in; const float* lq1; const float* lk1; const float* lq2; const float* lk2;
    const float* subln_w; const float* pool_w; const float* pool_scale; const float* w_out; const float* ffn_norm_w; const float* router_w; const float* router_b;
    const float* w_gu; const float* b_gu; const float* w_down; const float* b_down; const float* final_w; float* out; unsigned char* ws;
};

template <int MODE>
__device__ __forceinline__ void p0_transpose_item(const float* __restrict__ W, int N, bf16_t* __restrict__ WT, int ldk, LAS float* scr, int item, int lane, const float* __restrict__ kscale) {
    const int nblk = N / 32, kb = item / nblk, nb = item % nblk, k0 = 64 * kb, n0 = 32 * nb;
#pragma unroll 8
    for (int i = 0; i < 32; ++i) { const int kk = 2 * i + (lane >> 5); float v = W[(size_t)(k0 + kk) * N + n0 + (lane & 31)]; if (MODE != 0) v *= kscale[k0 + kk]; scr[kk * 33 + (lane & 31)] = v; }
    asm volatile("s_waitcnt lgkmcnt(0)" ::: "memory");
    const int c = lane & 7;
#pragma unroll
    for (int j = 0; j < 4; ++j) { const int nl = (lane >> 3) + 8 * j, n = n0 + nl; const LAS float* s = scr + (8 * c) * 33 + nl;
        int row = n;
        if (MODE == 1) { const int f = n & 1023, up = n >> 10; row = (f >> 7) * 256 + up * 128 + (f & 127); }
        u32x4 o; o.x = f2bf(s[0 * 33]) | (f2bf(s[1 * 33]) << 16); o.y = f2bf(s[2 * 33]) | (f2bf(s[3 * 33]) << 16); o.z = f2bf(s[4 * 33]) | (f2bf(s[5 * 33]) << 16); o.w = f2bf(s[6 * 33]) | (f2bf(s[7 * 33]) << 16);
        *(u32x4*)(WT + (size_t)row * ldk + k0 + 8 * c) = o; }
    asm volatile("s_waitcnt lgkmcnt(0)" ::: "memory");
}
template <int MODE>
__device__ __forceinline__ void p0_transpose_item_fp8(const float* __restrict__ W, int N, unsigned char* __restrict__ WT, int ldk, LAS float* scr, int item, int lane, const float* __restrict__ kscale, float sc) {
    const int nblk = N / 32, kb = item / nblk, nb = item % nblk, k0 = 64 * kb, n0 = 32 * nb;
#pragma unroll 8
    for (int i = 0; i < 32; ++i) { const int kk = 2 * i + (lane >> 5); float v = W[(size_t)(k0 + kk) * N + n0 + (lane & 31)] * sc; if (MODE == 1) v *= kscale[k0 + kk]; scr[kk * 33 + (lane & 31)] = v; }
    asm volatile("s_waitcnt lgkmcnt(0)" ::: "memory");
    const int c = lane & 3;
#pragma unroll
    for (int j = 0; j < 2; ++j) { const int nl = (lane >> 2) + 16 * j, n = n0 + nl; const LAS float* s = scr + (16 * c) * 33 + nl;
        int row = n;
        if (MODE == 1) { const int f = n & 1023, up = n >> 10; row = (f >> 7) * 256 + up * 128 + (f & 127); }
        u32x4 o;
#pragma unroll
        for (int q = 0; q < 4; ++q) o[q] = pk4_fp8(s[(4 * q) * 33], s[(4 * q + 1) * 33], s[(4 * q + 2) * 33], s[(4 * q + 3) * 33]);
        *(u32x4*)(WT + (size_t)row * ldk + k0 + 16 * c) = o; }
    asm volatile("s_waitcnt lgkmcnt(0)" ::: "memory");
}
__device__ __forceinline__ void xbf_row(const float* __restrict__ xrow, bf16_t* __restrict__ orow, float* __restrict__ rstd_out, int lane) {
    const f32x4* xr = (const f32x4*)xrow + lane;
    f32x4 v[4]; float s = 0.f;
#pragma unroll
    for (int j = 0; j < 4; ++j) { v[j] = xr[64 * j]; s += v[j].x * v[j].x + v[j].y * v[j].y + v[j].z * v[j].z + v[j].w * v[j].w; }
    unsigned long long* o8 = (unsigned long long*)orow + lane;
#pragma unroll
    for (int j = 0; j < 4; ++j) { const unsigned lo = f2bf(v[j].x) | (f2bf(v[j].y) << 16), hi = f2bf(v[j].z) | (f2bf(v[j].w) << 16); o8[64 * j] = (unsigned long long)lo | ((unsigned long long)hi << 32); }
    const float rstd = 1.0f / sqrtf(wave_sum(s) * (1.f / D) + EPS);
    if (lane == 0) *rstd_out = rstd;
}
__device__ __forceinline__ void rmsnorm_row_bf16(const float* __restrict__ xrow, const float* __restrict__ w, bf16_t* __restrict__ orow, int lane) {
    const f32x4* xr = (const f32x4*)xrow + lane;
    f32x4 v[4]; float s = 0.f;
#pragma unroll
    for (int j = 0; j < 4; ++j) { v[j] = xr[64 * j]; s += v[j].x * v[j].x + v[j].y * v[j].y + v[j].z * v[j].z + v[j].w * v[j].w; }
    const float rstd = 1.0f / sqrtf(wave_sum(s) * (1.f / D) + EPS);
    unsigned long long* o8 = (unsigned long long*)orow + lane;
#pragma unroll
    for (int j = 0; j < 4; ++j) { const f32x4 ww = ((const f32x4*)w)[64 * j + lane];
        const unsigned lo = f2bf(v[j].x * rstd * ww.x) | (f2bf(v[j].y * rstd * ww.y) << 16), hi = f2bf(v[j].z * rstd * ww.z) | (f2bf(v[j].w * rstd * ww.w) << 16);
        o8[64 * j] = (unsigned long long)lo | ((unsigned long long)hi << 32); }
}

__device__ __forceinline__ void final_row(float* __restrict__ out, const bf16_t* __restrict__ XB, const unsigned char* __restrict__ YP, const LAS int* tb, const int* slot, const float* __restrict__ lgate, const float* __restrict__ w, int t, int lane) {
    int rows[4]; float gk[4];
#pragma unroll
    for (int k = 0; k < 4; ++k) { const int sl = slot[t * 4 + k]; rows[k] = tb[sl >> 16] + (sl & 0xffff); gk[k] = lgate[(size_t)(sl >> 16) * TC + (sl & 0xffff)] * (1.0f / FP8_SY); }
    float v[16];
    { const u32x4 a0 = *(const u32x4*)(XB + (size_t)t * D + 16 * lane), a1 = *(const u32x4*)(XB + (size_t)t * D + 16 * lane + 8);
#pragma unroll
      for (int e = 0; e < 4; ++e) { v[2 * e] = __uint_as_float(a0[e] << 16); v[2 * e + 1] = __uint_as_float(a0[e] & 0xffff0000u); v[8 + 2 * e] = __uint_as_float(a1[e] << 16); v[8 + 2 * e + 1] = __uint_as_float(a1[e] & 0xffff0000u); } }
    float y[16];
#pragma unroll
    for (int e = 0; e < 16; ++e) y[e] = 0.f;
#pragma unroll
    for (int k = 0; k < 4; ++k) { const u32x4 q = *(const u32x4*)(YP + (size_t)rows[k] * D + 16 * lane);
#pragma unroll
        for (int e = 0; e < 4; ++e) { y[4 * e] += gk[k] * __builtin_amdgcn_cvt_f32_fp8(q[e], 0); y[4 * e + 1] += gk[k] * __builtin_amdgcn_cvt_f32_fp8(q[e], 1); y[4 * e + 2] += gk[k] * __builtin_amdgcn_cvt_f32_fp8(q[e], 2); y[4 * e + 3] += gk[k] * __builtin_amdgcn_cvt_f32_fp8(q[e], 3); } }
    float s = 0.f;
#pragma unroll
    for (int e = 0; e < 16; ++e) { v[e] += y[e]; s += v[e] * v[e]; }
    const float rstd = 1.0f / sqrtf(wave_sum(s) * (1.f / D) + EPS);
    float* op = out + (size_t)t * D + 16 * lane; const float* wp = w + 16 * lane;
#pragma unroll
    for (int e = 0; e < 4; ++e) { const f32x4 ww = *(const f32x4*)(wp + 4 * e); *(f32x4*)(op + 4 * e) = (f32x4){v[4 * e] * rstd * ww.x, v[4 * e + 1] * rstd * ww.y, v[4 * e + 2] * rstd * ww.z, v[4 * e + 3] * rstd * ww.w}; }
}

typedef const MArgs __attribute__((address_space(4)))* KArgP;
__device__ __forceinline__ KArgP kargs() { KArgP p = (KArgP)__builtin_amdgcn_kernarg_segment_ptr(); asm volatile("" : "+s"(p)); return p; }
#define WSP(T_, off) ((T_*)(ws + (off)))
__global__ __launch_bounds__(NTHREADS, 2) void mega_fwd(MArgs a_unused) {
    extern __shared__ __attribute__((aligned(16))) unsigned char lds_raw[];
    LAS unsigned char* lds = (LAS unsigned char*)lds_raw;
    const int G = gridDim.x, bid = blockIdx.x, gsz = G * NTHREADS, ngw = G * NWAVES;
    if (threadIdx.x < 16) ((LAS unsigned*)(lds + XB_LDS))[threadIdx.x] = 0u;
    __syncthreads();
    (void)xcd_barrier_post((unsigned*)(kargs()->ws + WS_BAR), (volatile LAS unsigned*)(lds + XB_LDS));
#define GRID_SYNC() do { XcdBarrier xb_; xb_.bar = (unsigned*)(kargs()->ws + WS_BAR); xb_.x = xb_xcc_id(); xb_.st = (volatile LAS unsigned*)(lds + XB_LDS); xcd_barrier(xb_); } while (0)
#define PHASE_IDX() const int tid = otid(), lane = tid & 63, wid = __builtin_amdgcn_readfirstlane(tid >> 6), gtid = bid * NTHREADS + tid, gw = bid * NWAVES + wid; (void)lane; (void)gtid; (void)gw

    {
        PHASE_IDX(); KArgP a = kargs(); unsigned char* ws = a->ws; int* cnt = WSP(int, WS_CTL); float* rope = WSP(float, WS_ROPE); bf16_t* Win_t = WSP(bf16_t, WS_WIN); bf16_t* Wo_t = WSP(bf16_t, WS_WO); bf16_t* Wd_t = WSP(bf16_t, WS_WD); bf16_t* Wgu_t = WSP(bf16_t, WS_WGU); bf16_t* XN = WSP(bf16_t, WS_XN);
        if (gtid < NCHUNK * 32) cnt[gtid] = 0;
        LAS float* scr = (LAS float*)(lds + wid * 8448);
        constexpr int I_IN = (D / 64) * (INW / 32), I_WO = (512 / 64) * (D / 32), I_GU = (D / 64) * (2048 / 32), I_DN = (FF / 64) * (D / 32);
        constexpr int NITEMS = I_IN + I_WO + NE * I_GU + NE * I_DN;
        for (int it = gw; it < NITEMS; it += ngw) {
            int r = it;
            if (r < I_IN) { p0_transpose_item<2>(a->w_in, INW, Win_t, D, scr, r, lane, a->attn_norm_w); continue; } r -= I_IN;
            if (r < I_WO) { p0_transpose_item<0>(a->w_out, D, Wo_t, D, scr, r, lane, nullptr); continue; } r -= I_WO;
            if (r < NE * I_GU) { const int e = r / I_GU; p0_transpose_item_fp8<1>(a->w_gu + (size_t)e * D * 2048, 2048, (unsigned char*)Wgu_t + (size_t)e * 2048 * D, D, scr, r % I_GU, lane, a->ffn_norm_w, FP8_SW); continue; } r -= NE * I_GU;
            { const int e = r / I_DN; p0_transpose_item_fp8<0>(a->w_down + (size_t)e * FF * D, D, (unsigned char*)Wd_t + (size_t)e * D * FF, FF, scr, r % I_DN, lane, nullptr, FP8_SW); }
        }
        for (int idx = gtid; idx < 512 * 1024; idx += gsz) {
            const int n = idx & 1023, gc = idx >> 10, g = gc >> 7; float acc = 0.f;
            for (int d = 0; d < 128; ++d) acc += a->pool_w[(size_t)gc * 128 + d] * a->pool_scale[g * 128 + d] * a->w_out[(size_t)(512 + g * 128 + d) * 1024 + n];
            Wo_t[(size_t)n * 1024 + 512 + gc] = (bf16_t)f2bf(acc);
        }
        for (int idx = gtid; idx < T * 8; idx += gsz) {
            const int t = idx >> 3, j = idx & 7;
            const double inv = exp(-(double)(2 * j) / 16.0 * log(500000.0)); const double ang = (double)a->positions[t] * inv;
            rope[(size_t)t * 16 + j] = (float)cos(ang); rope[(size_t)t * 16 + 8 + j] = (float)sin(ang);
        }
        for (int row = gw; row < T; row += ngw) xbf_row(a->x + (size_t)row * D, XN + (size_t)row * D, WSP(float, WS_RSTD) + row, lane);
    }
    GRID_SYNC();
    { PHASE_IDX(); KArgP a = kargs(); unsigned char* ws = a->ws; bf16_t* Win_t = WSP(bf16_t, WS_WIN); bf16_t* XN = WSP(bf16_t, WS_XN); bf16_t* PROJ = WSP(bf16_t, WS_PROJ); const float* rope = WSP(float, WS_ROPE);
      pg8::DensePlan S; S.init(T, INW, G, bid); pg8::EpiBf16 E{PROJ, INW, rope, 4, WSP(float, WS_RSTD)}; pg8::gemm_phase<2048, false>(lds, XN, Win_t, S, E); }
    GRID_SYNC();
    {
        PHASE_IDX(); KArgP a = kargs(); unsigned char* ws = a->ws; bf16_t* PROJ = WSP(bf16_t, WS_PROJ); bf16_t* CAT = WSP(bf16_t, WS_CAT);
        const float lam = expf(wave_sum(a->lq1[lane] * a->lk1[lane])) - expf(wave_sum(a->lq2[lane] * a->lk2[lane])) + 0.2f;
        dattn::phase((char*)lds_raw, PROJ, CAT, lam, a->subln_w, G, bid);
        for (int item = gtid; item < (T / 32) * 64; item += gsz) {
            const int chunk = item & 63, tb = item >> 6, c0 = chunk * 8, w = 2 << (c0 >> 7), t0 = tb * 32, s0 = t0 % SEQ;
            const bf16_t* up = PROJ + (size_t)t0 * INW + 1536 + c0; bf16_t* op = CAT + (size_t)t0 * D + 512 + c0;
            float sum[8];
#pragma unroll
            for (int e = 0; e < 8; ++e) sum[e] = 0.f;
            if (s0 > 0) for (int i = 1; i < w; ++i) { const u32x4 v = *(const u32x4*)(up - (size_t)i * INW);
#pragma unroll
                for (int e = 0; e < 4; ++e) { sum[2 * e] += __uint_as_float(v[e] << 16); sum[2 * e + 1] += __uint_as_float(v[e] & 0xffff0000u); } }
            for (int tb8 = 0; tb8 < 32; tb8 += 8) {
                u32x4 vin[8], vout[8];
#pragma unroll
                for (int i = 0; i < 8; ++i) vin[i] = *(const u32x4*)(up + (size_t)(tb8 + i) * INW);
#pragma unroll
                for (int i = 0; i < 8; ++i) { const int tt = tb8 + i; const bool has = s0 + tt + 1 >= w; vout[i] = *(const u32x4*)(up + (size_t)(has ? tt - w + 1 : tt) * INW); }
                asm volatile("" ::: "memory");
#pragma unroll
                for (int i = 0; i < 8; ++i) { const int tt = tb8 + i; float f[8];
#pragma unroll
                    for (int e = 0; e < 4; ++e) { f[2 * e] = __uint_as_float(vin[i][e] << 16); f[2 * e + 1] = __uint_as_float(vin[i][e] & 0xffff0000u); }
                    const int s = s0 + tt; const float rn = 1.0f / (float)((s + 1 < w) ? s + 1 : w);
                    u32x4 o;
#pragma unroll
                    for (int e = 0; e < 4; ++e) { sum[2 * e] += f[2 * e]; sum[2 * e + 1] += f[2 * e + 1]; o[e] = pg8::cvt_pk_bf16(sum[2 * e] * rn - f[2 * e], sum[2 * e + 1] * rn - f[2 * e + 1]); }
                    *(u32x4*)(op + (size_t)tt * D) = o;
                    const float hm = (s + 1 >= w) ? 1.f : 0.f;
#pragma unroll
                    for (int e = 0; e < 4; ++e) { sum[2 * e] -= hm * __uint_as_float(vout[i][e] << 16); sum[2 * e + 1] -= hm * __uint_as_float(vout[i][e] & 0xffff0000u); } }
            }
        }
    }
    GRID_SYNC();
    { PHASE_IDX(); KArgP a = kargs(); unsigned char* ws = a->ws; bf16_t* Wo_t = WSP(bf16_t, WS_WO); bf16_t* CAT = WSP(bf16_t, WS_CAT);
      pg8::DensePlan S; S.init(T, D, G, bid); pg8::EpiResBf16 E{WSP(bf16_t, WS_XB), WSP(bf16_t, WS_XN), D}; pg8::gemm_phase<2048, false>(lds, CAT, Wo_t, S, E); }
    GRID_SYNC();
    { PHASE_IDX(); KArgP a = kargs(); unsigned char* ws = a->ws;
      rtr::phase(lds, WSP(bf16_t, WS_XB), a->ffn_norm_w, a->router_w, a->router_b, WSP(int, WS_CTL), WSP(int, WS_LTOK), WSP(float, WS_LGATE), WSP(int, WS_SLOT), WSP(unsigned char, WS_XN), G, bid); }
    GRID_SYNC();
    for (int ch = 0; ch < NCHUNK; ++ch) {
        PHASE_IDX(); KArgP a = kargs(); unsigned char* ws = a->ws; int* cnt = WSP(int, WS_CTL); int* ltok = WSP(int, WS_LTOK); float* lgate = WSP(float, WS_LGATE); int* slot = WSP(int, WS_SLOT); bf16_t* Wd_t = WSP(bf16_t, WS_WD); bf16_t* Wgu_t = WSP(bf16_t, WS_WGU); bf16_t* XN = WSP(bf16_t, WS_XN); bf16_t* HM = WSP(bf16_t, WS_HM); bf16_t* YP = WSP(bf16_t, WS_YP); float* out = a->out;
        const int* cc = cnt + ch * 32; const int* lt = ltok + (size_t)ch * 32 * TC; const float* lg = lgate + (size_t)ch * 32 * TC;
        { pg8::MoePlan<true> S = pg8::moe_plan_setup<true>(lds + pg8::STAGE_BYTES, cc, lt, 8, G, bid); pg8::EpiGLU E{HM, a->b_gu, 8}; pg8::gemm_phase<1024, true>(lds, XN, Wgu_t, S, E); }
        GRID_SYNC();
        { pg8::MoePlan<false> S = pg8::moe_plan_setup<false>(lds + pg8::STAGE_BYTES, cc, lt, 4, G, bid); pg8::EpiDown E{YP, a->b_down, 4}; pg8::gemm_phase<1024, true>(lds, HM, Wd_t, S, E); }
        GRID_SYNC();
        { LAS int* tb = (LAS int*)(lds + pg8::STAGE_BYTES);
          if (tid < 64) { int v = (lane < 32) ? (__hip_atomic_load(cc + (lane & 31), __ATOMIC_RELAXED, __HIP_MEMORY_SCOPE_AGENT) + TM - 1) / TM : 0, incl = v;
#pragma unroll
              for (int o = 1; o < 32; o <<= 1) { const int up = __shfl_up(incl, o); if (lane >= o) incl += up; }
              if (lane < 32) tb[lane] = (incl - v) * TM; }
          __syncthreads();
          for (int t = ch * TC + gw; t < (ch + 1) * TC; t += ngw) final_row(out, WSP(bf16_t, WS_XB), (const unsigned char*)YP, tb, slot, lg, a->final_w, t, lane);
          __syncthreads(); }
    }
}

extern "C" void kernel_launch(void* const* d_in, const int* in_sizes, int n_in, void* d_out, int out_size, void* d_ws, size_t ws_size, hipStream_t stream) {
    if (n_in != 20 || in_sizes[0] != T * D || out_size != T * D || ws_size < WS_END) { fprintf(stderr, "kernel_launch: unexpected shapes / workspace (%d, %d, %d, %zu)\n", n_in, n_in > 0 ? in_sizes[0] : -1, out_size, ws_size); return; }
    static int grid_blocks = 0;
    if (!grid_blocks) {
        int dev = 0, cus = 0, per_cu = 0;
        (void)hipGetDevice(&dev); (void)hipDeviceGetAttribute(&cus, hipDeviceAttributeMultiprocessorCount, dev);
        (void)hipFuncSetAttribute((const void*)mega_fwd, hipFuncAttributeMaxDynamicSharedMemorySize, MK_LDS);
        (void)hipOccupancyMaxActiveBlocksPerMultiprocessor(&per_cu, (const void*)mega_fwd, NTHREADS, MK_LDS);
        if (per_cu < 1) { fprintf(stderr, "kernel_launch: occupancy query says %d blocks per CU\n", per_cu); per_cu = 1; }
        grid_blocks = cus * 1;
        if (grid_blocks % 8 != 0) grid_blocks -= grid_blocks % 8;
    }
    (void)hipMemsetAsync((char*)d_ws + WS_BAR, 0, XCD_BAR_WORDS * 4, stream);
    MArgs a{};
    a.x = (const float*)d_in[0]; a.positions = (const int*)d_in[1]; a.attn_norm_w = (const float*)d_in[2]; a.w_in = (const float*)d_in[3];
    a.lq1 = (const float*)d_in[4]; a.lk1 = (const float*)d_in[5]; a.lq2 = (const float*)d_in[6]; a.lk2 = (const float*)d_in[7];
    a.subln_w = (const float*)d_in[8]; a.pool_w = (const float*)d_in[9]; a.pool_scale = (const float*)d_in[10]; a.w_out = (const float*)d_in[11];
    a.ffn_norm_w = (const float*)d_in[12]; a.router_w = (const float*)d_in[13]; a.router_b = (const float*)d_in[14];
    a.w_gu = (const float*)d_in[15]; a.b_gu = (const float*)d_in[16]; a.w_down = (const float*)d_in[17]; a.b_down = (const float*)d_in[18]; a.final_w = (const float*)d_in[19];
    a.out = (float*)d_out; a.ws = (unsigned char*)d_ws;
    void* args[] = {&a};
    hipError_t e = hipLaunchCooperativeKernel((const void*)mega_fwd, dim3(grid_blocks), dim3(NTHREADS), args, MK_LDS, stream);
    if (e != hipSuccess) fprintf(stderr, "cooperative launch failed: %s (grid %d)\n", hipGetErrorString(e), grid_blocks);
}
```

```cpp
#include <hip/hip_runtime.h>
#include <cstdint>
#include <cstdio>

typedef unsigned short bf16_t;
typedef short bf16x8 __attribute__((ext_vector_type(8)));
typedef float f32x4 __attribute__((ext_vector_type(4)));
typedef unsigned u32x4 __attribute__((ext_vector_type(4)));

constexpr int T = 65536, D = 1024, SEQ = 2048, INW = 2048, NE = 32, FF = 1024, TOPK = 4;
constexpr int NCHUNK = 1, TC = T / NCHUNK;
constexpr int TM = 256;
constexpr int PC = TC * TOPK + NE * TM;
constexpr float EPS = 1e-5f;

constexpr size_t MiB = 1u << 20;
constexpr size_t WS_CTL = 0;
constexpr size_t WS_RSTD = 524288;
constexpr size_t WS_BAR = 65536;
constexpr size_t WS_LTOK = 1 * MiB;
constexpr size_t WS_LGATE = 9 * MiB;
constexpr size_t WS_SLOT = 17 * MiB;
constexpr size_t WS_ROPE = 18 * MiB;
constexpr size_t WS_WIN = 22 * MiB;
constexpr size_t WS_WO = 26 * MiB;
constexpr size_t WS_WD = 28 * MiB;
constexpr size_t WS_WGU = 92 * MiB;
constexpr size_t WS_XN = 220 * MiB;
constexpr size_t WS_PROJ = 348 * MiB;
constexpr size_t WS_CAT = 604 * MiB;
constexpr size_t WS_HM = 348 * MiB;
constexpr size_t WS_YP = 612 * MiB;
constexpr size_t WS_XB = 876 * MiB;
constexpr size_t WS_END = 1004 * MiB;
static_assert(WS_HM + (size_t)PC * 1024 <= WS_YP && WS_YP + (size_t)PC * 1024 <= WS_XB && WS_XB + (size_t)T * 1024 * 2 <= WS_END && WS_CAT + (size_t)T * 1024 * 2 <= WS_XB, "ws map");

__device__ __forceinline__ int otid() { int t = threadIdx.x; asm volatile("" : "+v"(t)); return t; }
__device__ __forceinline__ unsigned f2bf(float f) { unsigned u = __float_as_uint(f); return (u + 0x7fffu + ((u >> 16) & 1u)) >> 16; }
__device__ __forceinline__ unsigned pk4_fp8(float a, float b, float c, float d) {
    a = fminf(fmaxf(a, -448.f), 448.f); b = fminf(fmaxf(b, -448.f), 448.f); c = fminf(fmaxf(c, -448.f), 448.f); d = fminf(fmaxf(d, -448.f), 448.f);
    unsigned w = 0; w = __builtin_amdgcn_cvt_pk_fp8_f32(a, b, w, false); w = __builtin_amdgcn_cvt_pk_fp8_f32(c, d, w, true); return w; }
__device__ __forceinline__ unsigned pk4_fp8_nc(float a, float b, float c, float d) { unsigned w = 0; w = __builtin_amdgcn_cvt_pk_fp8_f32(a, b, w, false); w = __builtin_amdgcn_cvt_pk_fp8_f32(c, d, w, true); return w; }
constexpr float FP8_SX = 16.f, FP8_SW = 512.f, FP8_SH = 4.f, FP8_SY = 32.f;
__device__ __forceinline__ float bf2f(unsigned h) { return __uint_as_float(h << 16); }
__device__ __forceinline__ float wave_sum(float v) {
#pragma unroll
    for (int o = 1; o < 64; o <<= 1) v += __shfl_xor(v, o);
    return v;
}
__device__ __forceinline__ float wave_max(float v) {
#pragma unroll
    for (int o = 1; o < 64; o <<= 1) v = fmaxf(v, __shfl_xor(v, o));
    return v;
}

namespace pg8 {
#define PG8_LAS __attribute__((address_space(3)))
constexpr int BM = 256, BK = 64, HALF = 128, HTB = HALF * BK * 2  , STAGE_BYTES = 8 * HTB;
constexpr int MAXU = 36, PLAN_BYTES = MAXU * 32 + MAXU * 512, EPI_LDS = STAGE_BYTES + PLAN_BYTES + 64;
__host__ __device__ __forceinline__ int lds_byte(int r, int c) { return r * 128 + ((((c >> 3) ^ ((r >> 1) & 7))) << 4); }
__host__ __device__ __forceinline__ void stage_rc(int b, int& R, int& C) { R = b >> 7; C = ((((b >> 4) & 7) ^ ((R >> 1) & 7))) << 3; }
__host__ __device__ __forceinline__ int perm32(int rho) { const int n = rho >> 4, i = rho & 15; return 8 * (i >> 2) + 4 * n + (i & 3); }
__device__ __forceinline__ unsigned cvt_pk_bf16(float lo, float hi) { unsigned r; asm volatile("v_cvt_pk_bf16_f32 %0, %1, %2" : "=v"(r) : "v"(lo), "v"(hi)); return r; }

template <int IMM = 0>
__device__ __forceinline__ void glds16s(const void* sbase, unsigned voff, unsigned lds_dst) { unsigned keep;
    asm volatile("s_mov_b32 %0, m0\n\ts_mov_b32 m0, %3\n\ts_nop 0\n\tglobal_load_lds_dwordx4 %1, %2 offset:%4\n\ts_mov_b32 m0, %0" : "=&s"(keep) : "v"(voff), "s"(sbase), "s"(lds_dst), "i"(IMM) : "memory"); }
typedef int v4i_t __attribute__((ext_vector_type(4)));
typedef int v8i_t __attribute__((ext_vector_type(8)));
__device__ __forceinline__ v8i_t cat8(bf16x8 lo, bf16x8 hi) { return __builtin_shufflevector(__builtin_bit_cast(v4i_t, lo), __builtin_bit_cast(v4i_t, hi), 0, 1, 2, 3, 4, 5, 6, 7); }
__device__ __forceinline__ void mfma_fp8_inplace(f32x4& acc, v8i_t a, v8i_t b) {
    asm volatile("v_mfma_scale_f32_16x16x128_f8f6f4 %0, %1, %2, %0, %3, %3 op_sel_hi:[0,0,0]" : "+v"(acc) : "v"(a), "v"(b), "v"(0x7F7F7F7F)); }
struct Unit { int pm, pn, e, lt, ne; };

template <int ROWB, bool FP8, class Epi, class Plan>
__device__ __forceinline__ void gemm_phase(PG8_LAS unsigned char* lds, const bf16_t* gA_, const bf16_t* gBt_, const Plan& S, const Epi& E) {
    const int tid = otid(), wid = __builtin_amdgcn_readfirstlane(tid >> 6), lane = tid & 63, wr = wid >> 2, wc = wid & 3, fr = lane & 15, fq = lane >> 4;
    constexpr int nt = ROWB / 128;
    unsigned voffB[2];
#pragma unroll
    for (int i = 0; i < 2; ++i) { int R, C; stage_rc(tid * 16 + i * 8192, R, C); const int Rb = Epi::PERM ? ((R & ~31) + perm32(R & 31)) : R; voffB[i] = (unsigned)(Rb * ROWB + C * 2); }
    const size_t kstep = (size_t)(BK * 2);
    const size_t hstep = (size_t)HALF * ROWB;
    const size_t tstep = 2 * hstep;
    const unsigned ldsb_epi0 = (unsigned)__builtin_amdgcn_readfirstlane((unsigned)(__UINTPTR_TYPE__)lds + (unsigned)EPI_LDS);
    const unsigned ldsb = (unsigned)__builtin_amdgcn_readfirstlane((unsigned)(__UINTPTR_TYPE__)lds + (unsigned)wid * 1024u);
    const int aoff0 = lds_byte(wr * 64 + fr, fq * 8), aoff1 = lds_byte(wr * 64 + fr, 32 + fq * 8), boff0 = lds_byte(wc * 32 + fr, fq * 8), boff1 = lds_byte(wc * 32 + fr, 32 + fq * 8);
#define PG8_SA(b, h) (((b) * 2 + (h)) * HTB)
#define PG8_SB(b, h) ((4 + (b) * 2 + (h)) * HTB)
#define PG8_STAGE(bufoff, gbase, voff) do { _Pragma("unroll") for (int _i = 0; _i < 2; ++_i) glds16s<0>((gbase), (voff)[_i], ldsb + (unsigned)((bufoff) + _i * 8192)); } while (0)
#define PG8_STAGEK(bufoff, gbase, voff) do { _Pragma("unroll") for (int _i = 0; _i < 2; ++_i) glds16s<BK * 2>((gbase), (voff)[_i], ldsb + (unsigned)((bufoff) + _i * 8192)); } while (0)
#define PG8_LDA(dst, b, h) do { _Pragma("unroll") for (int m = 0; m < 4; ++m) { \
        if constexpr (FP8) dst##8[m] = cat8(*(const PG8_LAS bf16x8*)(lds + PG8_SA(b, h) + aoff0 + m * 2048), *(const PG8_LAS bf16x8*)(lds + PG8_SA(b, h) + aoff1 + m * 2048)); \
        else { dst[m][0] = *(const PG8_LAS bf16x8*)(lds + PG8_SA(b, h) + aoff0 + m * 2048); dst[m][1] = *(const PG8_LAS bf16x8*)(lds + PG8_SA(b, h) + aoff1 + m * 2048); } } } while (0)
#define PG8_LDB(dst, b, h) do { _Pragma("unroll") for (int n = 0; n < 2; ++n) { \
        if constexpr (FP8) dst##8[n] = cat8(*(const PG8_LAS bf16x8*)(lds + PG8_SB(b, h) + boff0 + n * 2048), *(const PG8_LAS bf16x8*)(lds + PG8_SB(b, h) + boff1 + n * 2048)); \
        else { dst[n][0] = *(const PG8_LAS bf16x8*)(lds + PG8_SB(b, h) + boff0 + n * 2048); dst[n][1] = *(const PG8_LAS bf16x8*)(lds + PG8_SB(b, h) + boff1 + n * 2048); } } } while (0)
#define PG8_MMA(ai, bj, At, Bt) do { __builtin_amdgcn_s_setprio(1); _Pragma("unroll") for (int m = 0; m < 4; ++m) _Pragma("unroll") for (int n = 0; n < 2; ++n) { \
        if constexpr (FP8) mfma_fp8_inplace(acc[ai][bj][m][n], Bt##8[n], At##8[m]); \
        else { _Pragma("unroll") for (int k = 0; k < 2; ++k) acc[ai][bj][m][n] = __builtin_amdgcn_mfma_f32_16x16x32_bf16(Bt[n][k], At[m][k], acc[ai][bj][m][n], 0, 0, 0); } } \
        __builtin_amdgcn_s_setprio(0); } while (0)
#define PG8_WAIT_V(n) asm volatile("s_waitcnt vmcnt(" #n ")" ::: "memory")
#define PG8_WAIT_L(n) asm volatile("s_waitcnt lgkmcnt(" #n ")" ::: "memory")
#define PG8_BAR __builtin_amdgcn_s_barrier()
#define PG8_SCHED __builtin_amdgcn_sched_barrier(0)
#define PG8_VOFF(dst, U, UI) do { const int _tv = otid(); _Pragma("unroll") for (int _i = 0; _i < 2; ++_i) { int _R, _C; stage_rc(_tv * 16 + _i * 8192, _R, _C); \
        _Pragma("unroll") for (int _h = 0; _h < 2; ++_h) dst[_h][_i] = S.rowA(U, UI, _h * HALF + _R) * (unsigned)ROWB + (unsigned)(_C * 2); } } while (0)
#define PG8_SP1A(A1) do { \
          \
        PG8_LDB(B0, 0, 0); PG8_LDB(B1, 0, 1); PG8_SCHED; PG8_LDA(At, 0, 0); PG8_STAGE(PG8_SA(1, 1), (A1), vc[1]); \
        PG8_WAIT_V(8); PG8_WAIT_L(0); PG8_BAR; PG8_MMA(0, 0, At, B0); PG8_MMA(0, 1, At, B1); PG8_BAR; PG8_SCHED; } while (0)
#define PG8_REST(A2, B2) do { \
          \
        PG8_LDA(At, 0, 1); PG8_STAGE(PG8_SB(0, 0), (B2), voffB); PG8_STAGE(PG8_SB(0, 1), (B2) + hstep, voffB); PG8_STAGE(PG8_SA(0, 0), (A2), vc[0]); \
        PG8_WAIT_V(8); PG8_WAIT_L(0); PG8_BAR; PG8_MMA(1, 0, At, B0); PG8_MMA(1, 1, At, B1); PG8_BAR; PG8_SCHED; \
          \
        PG8_LDB(B0, 1, 0); PG8_LDB(B1, 1, 1); PG8_SCHED; PG8_LDA(At, 1, 0); PG8_STAGE(PG8_SA(0, 1), (A2), vc[1]); \
        PG8_WAIT_V(8); PG8_WAIT_L(0); PG8_BAR; PG8_MMA(0, 0, At, B0); PG8_MMA(0, 1, At, B1); PG8_BAR; PG8_SCHED; \
          \
        PG8_LDA(At, 1, 1); PG8_STAGE(PG8_SB(1, 0), (B2) + kstep, voffB); PG8_STAGE(PG8_SB(1, 1), (B2) + kstep + hstep, voffB); PG8_STAGE(PG8_SA(1, 0), (A2) + kstep, vc[0]); \
        PG8_WAIT_V(8); PG8_WAIT_L(0); PG8_BAR; PG8_MMA(1, 0, At, B0); PG8_MMA(1, 1, At, B1); PG8_BAR; PG8_SCHED; } while (0)
    Unit cur, nxt; int ui = 0;
    if (!S.next(0, cur)) return;
    f32x4 acc[2][2][4][2];
#pragma unroll
    for (int a = 0; a < 2; ++a)
#pragma unroll
        for (int b = 0; b < 2; ++b)
#pragma unroll
            for (int m = 0; m < 4; ++m)
#pragma unroll
                for (int n = 0; n < 2; ++n) acc[a][b][m][n] = (f32x4){0.f, 0.f, 0.f, 0.f};
    bf16x8 At[4][2], B0[2][2], B1[2][2]; v8i_t At8[4], B08[2], B18[2];
    unsigned vc[2][2];
    PG8_VOFF(vc, cur, 0);
    if (wid == 0) E.prefetch(cur, ldsb_epi0, lane);
    const char* gA = (const char*)gA_; const char* cB = (const char*)gBt_ + (size_t)cur.pn * tstep;
    PG8_STAGE(PG8_SB(0, 0), cB, voffB); PG8_STAGE(PG8_SB(0, 1), cB + hstep, voffB); PG8_STAGE(PG8_SA(0, 0), gA, vc[0]); PG8_STAGE(PG8_SA(0, 1), gA, vc[1]);
    if (wr == 1) PG8_BAR;
    PG8_WAIT_V(2); PG8_BAR;
    PG8_STAGE(PG8_SB(1, 0), cB + kstep, voffB); PG8_STAGE(PG8_SA(1, 0), gA + kstep, vc[0]); PG8_STAGE(PG8_SB(1, 1), cB + hstep + kstep, voffB);
    PG8_WAIT_V(6); PG8_BAR;
    for (;;) {
        const bool has_next = S.next(ui + 1, nxt);
        const char* nB = has_next ? (const char*)gBt_ + (size_t)nxt.pn * tstep : cB;
#pragma clang loop unroll(disable)
        for (int t = 0; t < nt - 2; t += 2) { PG8_SP1A(gA + (size_t)(t + 1) * kstep); PG8_REST(gA + (size_t)(t + 2) * kstep, cB + (size_t)(t + 2) * kstep); }
        PG8_SP1A(gA + (size_t)(nt - 1) * kstep);
        if (has_next) PG8_VOFF(vc, nxt, ui + 1);
        PG8_REST(gA, nB);
        if constexpr (FP8) {
            asm volatile("s_nop 15\n\ts_nop 15" ::: "memory");
#pragma unroll
            for (int a = 0; a < 2; ++a)
#pragma unroll
                for (int b = 0; b < 2; ++b)
#pragma unroll
                    for (int m = 0; m < 4; ++m)
#pragma unroll
                        for (int n = 0; n < 2; ++n) asm volatile("" : "+v"(acc[a][b][m][n]));
        }
        if (wr == 0) PG8_BAR;
        E(acc, cur, lds + EPI_LDS + (ui & 1) * 1024);
        if (!has_next) break;
#pragma unroll
        for (int a = 0; a < 2; ++a)
#pragma unroll
            for (int b = 0; b < 2; ++b)
#pragma unroll
                for (int m = 0; m < 4; ++m)
#pragma unroll
                    for (int n = 0; n < 2; ++n) acc[a][b][m][n] = (f32x4){0.f, 0.f, 0.f, 0.f};
        cur = nxt; cB = nB; ++ui;
        if (wid == 0) E.prefetch(cur, ldsb_epi0 + (unsigned)((ui & 1) * 1024), lane);
        if (wr == 1) PG8_BAR;
    }
    PG8_WAIT_V(0);
    PG8_BAR;
#undef PG8_SA
#undef PG8_SB
#undef PG8_STAGE
#undef PG8_STAGEK
#undef PG8_LDA
#undef PG8_LDB
#undef PG8_MMA
#undef PG8_WAIT_V
#undef PG8_WAIT_L
#undef PG8_BAR
#undef PG8_SCHED
#undef PG8_VOFF
#undef PG8_SP1A
#undef PG8_REST
}

struct DensePlan {
    int nM, nN, nwg, G, c;
    __device__ void init(int M, int N, int G_, int c_) { nM = M / BM; nN = N / BM; nwg = nM * nN; G = G_; c = c_; }
    __device__ __forceinline__ bool next(int i, Unit& u) const {
        const long L = (long)i * G + c; if (L >= nwg) return false;
        int wgid = (int)L; { const int q = nwg / 8, r = nwg % 8, xcd = wgid % 8, off = wgid / 8; wgid = (xcd < r ? xcd * (q + 1) : r * (q + 1) + (xcd - r) * q) + off; }
        const int nig = 8 * nN, gid = wgid / nig, fm = gid * 8, gsz = (nM - fm) < 8 ? (nM - fm) : 8;
        u.pm = fm + ((wgid % nig) % gsz); u.pn = (wgid % nig) / gsz; u.e = 0; u.lt = 0; u.ne = 0; return true;
    }
    __device__ __forceinline__ unsigned rowA(const Unit& u, int, int r) const { return (unsigned)(u.pm * BM + r); }
};
template <bool GATHER>
struct MoePlan {
    const PG8_LAS int* desc; const PG8_LAS unsigned short* rowtab;
    __device__ __forceinline__ bool next(int i, Unit& u) const {
        if (i >= MAXU) return false;
        const PG8_LAS int* d = desc + i * 8;
        const int v = __builtin_amdgcn_readfirstlane(d[0]); u.pm = __builtin_amdgcn_readfirstlane(d[1]); u.pn = __builtin_amdgcn_readfirstlane(d[2]);
        u.e = __builtin_amdgcn_readfirstlane(d[3]); u.lt = __builtin_amdgcn_readfirstlane(d[4]); u.ne = __builtin_amdgcn_readfirstlane(d[5]); return v != 0;
    }
    __device__ __forceinline__ unsigned rowA(const Unit& u, int ui, int r) const { return GATHER ? (unsigned)rowtab[ui * 256 + r] : (unsigned)(u.pm * BM + r); }
};
template <bool GATHER>
__device__ __forceinline__ MoePlan<GATHER> moe_plan_setup(PG8_LAS unsigned char* tab, const int* cnt, const int* ltok, int NT, int G, int c) {
    PG8_LAS int* desc = (PG8_LAS int*)tab; PG8_LAS unsigned short* rowtab = (PG8_LAS unsigned short*)(tab + MAXU * 32);
    PG8_LAS int* cs = (PG8_LAS int*)rowtab;
    PG8_LAS int* bs = cs + 32;
    const int tid = otid(), xcd = c & 7, j = c >> 3;
    if (tid < 32) cs[tid] = __hip_atomic_load(cnt + tid, __ATOMIC_RELAXED, __HIP_MEMORY_SCOPE_AGENT);
    __syncthreads();
    if (tid < 64) { const int ln = tid & 63; int v = (ln < 32) ? (cs[ln & 31] + BM - 1) / BM : 0, incl = v;
#pragma unroll
        for (int o = 1; o < 32; o <<= 1) { const int up = __shfl_up(incl, o); if (ln >= o) incl += up; }
        if (ln < 32) bs[ln] = incl - v; if (ln == 31) bs[32] = incl; }
    __syncthreads();
    if (tid < MAXU) {
        const int q = tid * (G >> 3) + j, mt = (q / NT) * 8 + xcd, pnl = q % NT;
        int e = -1;
        for (int k = 0; k < 32; ++k) if (mt >= bs[k] && mt < bs[k + 1]) e = k;
        desc[tid * 8 + 0] = e >= 0 ? 1 : 0; desc[tid * 8 + 1] = mt; desc[tid * 8 + 2] = (e >= 0 ? e : 0) * NT + pnl; desc[tid * 8 + 3] = e;
        desc[tid * 8 + 4] = e >= 0 ? mt - bs[e] : 0; desc[tid * 8 + 5] = e >= 0 ? cs[e] : 0;
    }
    __syncthreads();
    if (GATHER && tid < 256) {
        for (int i = 0; i < MAXU; ++i) {
            const PG8_LAS int* d = desc + i * 8; const int valid = d[0], e = d[3], lt = d[4], ne = d[5];
            const int p = lt * BM + tid; rowtab[i * 256 + tid] = (unsigned short)((valid && p < ne) ? ltok[(size_t)e * TC + p] : 0);
        }
    }
    __syncthreads();
    MoePlan<GATHER> S; S.desc = desc; S.rowtab = rowtab; return S;
}

struct EpiBf16 {
    __device__ __forceinline__ void prefetch(const Unit& u, unsigned lds_dst, int lane) const { glds16s<0>(rstd + (size_t)u.pm * BM, (unsigned)(lane * 16), lds_dst); }
    static constexpr bool PERM = true;
    bf16_t* O; int ldc; const float* rope; int rope_tiles; const float* rstd;
    __device__ __forceinline__ void operator()(const f32x4 (&acc)[2][2][4][2], const Unit& u, const PG8_LAS unsigned char* el) const {
        const int tv_ = otid();
        const int wr = tv_ >> 8, wc = (tv_ >> 6) & 3, fr = tv_ & 15, fq = (tv_ >> 4) & 3;
        const int row0 = u.pm * BM + wr * 64 + fr, col0 = u.pn * BM + wc * 32 + 8 * fq;
        const bool rot = (u.pn < rope_tiles) && ((__builtin_amdgcn_readfirstlane(tv_ >> 6) & 1) == 0);
#pragma unroll
        for (int ai = 0; ai < 2; ++ai) {
            f32x4 rc[4][4];
            if (rot) {
#pragma unroll
                for (int m = 0; m < 4; ++m) { const float* rp = rope + (size_t)(row0 + ai * HALF + m * 16) * 16;
#pragma unroll
                    for (int q = 0; q < 4; ++q) rc[m][q] = *(const f32x4*)(rp + 4 * q); }
                asm volatile("" ::: "memory");
            }
#pragma unroll
            for (int m = 0; m < 4; ++m) { const int row = row0 + ai * HALF + m * 16; bf16_t* rowp = O + (size_t)row * ldc + col0;
                const float rsd = ((const PG8_LAS float*)el)[wr * 64 + fr + ai * HALF + m * 16];
                f32x4 cs0, cs1, sn0, sn1;
                if (rot) { cs0 = rc[m][0]; cs1 = rc[m][1]; sn0 = rc[m][2]; sn1 = rc[m][3];
                    if (fq == 0) { sn0 = -sn0; sn1 = -sn1; } }
#pragma unroll
                for (int bj = 0; bj < 2; ++bj) { f32x4 v0 = acc[ai][bj][m][0] * rsd, v1 = acc[ai][bj][m][1] * rsd;
                    if (rot) { f32x4 p0, p1;
#pragma unroll
                        for (int j = 0; j < 4; ++j) { p0[j] = __shfl_xor(v0[j], 16); p1[j] = __shfl_xor(v1[j], 16); }
                        if (fq < 2) { v0 = v0 * cs0 + p0 * sn0; v1 = v1 * cs1 + p1 * sn1; } }
                    u32x4 w; w.x = cvt_pk_bf16(v0[0], v0[1]); w.y = cvt_pk_bf16(v0[2], v0[3]); w.z = cvt_pk_bf16(v1[0], v1[1]); w.w = cvt_pk_bf16(v1[2], v1[3]);
                    *(u32x4*)(rowp + bj * HALF) = w; } }
        }
    }
};
struct EpiResBf16 {
    __device__ __forceinline__ void prefetch(const Unit&, unsigned, int) const {}
    static constexpr bool PERM = true;
    bf16_t* XB; const bf16_t* resid; int ldc;
    __device__ __forceinline__ void operator()(const f32x4 (&acc)[2][2][4][2], const Unit& u, const PG8_LAS unsigned char* el) const {
        const int tv_ = otid();
        const int wr = tv_ >> 8, wc = (tv_ >> 6) & 3, fr = tv_ & 15, fq = (tv_ >> 4) & 3;
        const int row0 = u.pm * BM + wr * 64 + fr, col0 = u.pn * BM + wc * 32 + 8 * fq;
        u32x4 xr[2][4][2];
#pragma unroll
        for (int ai = 0; ai < 2; ++ai)
#pragma unroll
            for (int m = 0; m < 4; ++m)
#pragma unroll
                for (int bj = 0; bj < 2; ++bj) xr[ai][m][bj] = *(const u32x4*)(resid + (size_t)(row0 + ai * HALF + m * 16) * ldc + col0 + bj * HALF);
        asm volatile("" ::: "memory");
#pragma unroll
        for (int ai = 0; ai < 2; ++ai)
#pragma unroll
            for (int m = 0; m < 4; ++m) { const size_t off = (size_t)(row0 + ai * HALF + m * 16) * ldc + col0;
#pragma unroll
                for (int bj = 0; bj < 2; ++bj) { const u32x4 x4 = xr[ai][m][bj];
                    const f32x4 v0 = (f32x4){__uint_as_float(x4.x << 16), __uint_as_float(x4.x & 0xffff0000u), __uint_as_float(x4.y << 16), __uint_as_float(x4.y & 0xffff0000u)} + acc[ai][bj][m][0],
                                v1 = (f32x4){__uint_as_float(x4.z << 16), __uint_as_float(x4.z & 0xffff0000u), __uint_as_float(x4.w << 16), __uint_as_float(x4.w & 0xffff0000u)} + acc[ai][bj][m][1];
                    u32x4 w; w.x = cvt_pk_bf16(v0[0], v0[1]); w.y = cvt_pk_bf16(v0[2], v0[3]); w.z = cvt_pk_bf16(v1[0], v1[1]); w.w = cvt_pk_bf16(v1[2], v1[3]);
                    *(u32x4*)(XB + off + bj * HALF) = w; } }
    }
};
struct EpiGLU {
    static constexpr bool PERM = true;
    bf16_t* HM; const float* b_gu; int NT;
    __device__ __forceinline__ void prefetch(const Unit& u, unsigned lds_dst, int lane) const {
        const int pnl = u.pn - u.e * NT; glds16s<0>(b_gu + (size_t)u.e * 2048 + pnl * HALF, (unsigned)((lane & 31) * 16 + (lane >> 5) * 4096), lds_dst); }
    __device__ __forceinline__ void operator()(const f32x4 (&acc)[2][2][4][2], const Unit& u, const PG8_LAS unsigned char* el) const {
        const int tv_ = otid();
        const int wr = tv_ >> 8, wc = (tv_ >> 6) & 3, fr = tv_ & 15, fq = (tv_ >> 4) & 3;
        const int pnl = u.pn - u.e * NT, f0 = pnl * HALF + wc * 32 + 8 * fq, row0 = u.pm * BM + wr * 64 + fr;
        const PG8_LAS float* bl = (const PG8_LAS float*)el + wc * 32 + 8 * fq;
        f32x4 bg4[2], bu1[2];
#pragma unroll
        for (int n = 0; n < 2; ++n) { bg4[n] = *(const PG8_LAS f32x4*)(bl + 4 * n) * FP8_SH; bu1[n] = *(const PG8_LAS f32x4*)(bl + 128 + 4 * n) + 1.0f; }
        constexpr float rs = 1.0f / (FP8_SX * FP8_SW), rs4 = rs * FP8_SH, ec = -1.702f * 1.4426950408889634f / FP8_SH;
#pragma unroll
        for (int ai = 0; ai < 2; ++ai)
#pragma unroll
            for (int m = 0; m < 4; ++m) { unsigned pk[2];
#pragma unroll
                for (int n = 0; n < 2; ++n) {
                    f32x4 g4 = acc[ai][0][m][n] * rs4 + bg4[n], u1 = acc[ai][1][m][n] * rs + bu1[n];
#pragma unroll
                    for (int j = 0; j < 4; ++j) { g4[j] = fminf(g4[j], 7.0f * FP8_SH); u1[j] = __builtin_amdgcn_fmed3f(u1[j], -6.0f, 8.0f); }
                    f32x4 ea = g4 * ec, den;
#pragma unroll
                    for (int j = 0; j < 4; ++j) den[j] = __builtin_amdgcn_exp2f(ea[j]);
                    den = den + 1.0f;
                    f32x4 h4 = u1 * g4;
#pragma unroll
                    for (int j = 0; j < 4; ++j) den[j] = __builtin_amdgcn_rcpf(den[j]);
                    h4 = h4 * den;
                    pk[n] = pk4_fp8_nc(h4[0], h4[1], h4[2], h4[3]); }
                *(unsigned long long*)((unsigned char*)HM + (size_t)(row0 + ai * HALF + m * 16) * FF + f0) = (unsigned long long)pk[0] | ((unsigned long long)pk[1] << 32); }
    }
};
struct EpiDown {
    static constexpr bool PERM = true;
    bf16_t* YP; const float* b_d; int NT;
    __device__ __forceinline__ void prefetch(const Unit& u, unsigned lds_dst, int lane) const {
        const int pnl = u.pn - u.e * NT; glds16s<0>(b_d + (size_t)u.e * 1024 + pnl * BM, (unsigned)(lane * 16), lds_dst); }
    __device__ __forceinline__ void operator()(const f32x4 (&acc)[2][2][4][2], const Unit& u, const PG8_LAS unsigned char* el) const {
        const int tv_ = otid();
        const int wr = tv_ >> 8, wc = (tv_ >> 6) & 3, fr = tv_ & 15, fq = (tv_ >> 4) & 3;
        const int pnl = u.pn - u.e * NT, col0 = pnl * BM + wc * 32 + 8 * fq, rl0 = wr * 64 + fr;
        const PG8_LAS float* bl = (const PG8_LAS float*)el + wc * 32 + 8 * fq;
        f32x4 bv[2][2];
#pragma unroll
        for (int bj = 0; bj < 2; ++bj)
#pragma unroll
            for (int n = 0; n < 2; ++n) bv[bj][n] = *(const PG8_LAS f32x4*)(bl + bj * HALF + 4 * n) * FP8_SY;
        constexpr float sa = FP8_SY / (FP8_SH * FP8_SW);
#pragma unroll
        for (int ai = 0; ai < 2; ++ai)
#pragma unroll
            for (int m = 0; m < 4; ++m) { const int rl = rl0 + ai * HALF + m * 16;
                unsigned char* rowp = (unsigned char*)YP + (size_t)(u.pm * BM + rl) * D + col0;
#pragma unroll
                for (int bj = 0; bj < 2; ++bj) { const f32x4 v0 = acc[ai][bj][m][0] * sa + bv[bj][0], v1 = acc[ai][bj][m][1] * sa + bv[bj][1];
                    *(unsigned long long*)(rowp + bj * HALF) = (unsigned long long)pk4_fp8(v0[0], v0[1], v0[2], v0[3]) | ((unsigned long long)pk4_fp8(v1[0], v1[1], v1[2], v1[3]) << 32); } }
    }
};
}


namespace dattn {
typedef float f32x16 __attribute__((ext_vector_type(16)));
typedef short s16x4 __attribute__((ext_vector_type(4)));
constexpr int NW = 8, QBLK = 32, KVBLK = 64, QB = NW * QBLK, DK = 64, DV = 128, RS = INW;
constexpr int SHM_V = KVBLK * DV * 2, SHM_K = KVBLK * DK * 2;
constexpr int NVB = 4;
constexpr int LDS_V = 0, LDS_K = NVB * SHM_V, LDS_WS = LDS_K + 2 * SHM_K, LDS_OST = LDS_WS + NW * 64 * 4, LDS_BYTES = LDS_OST + NW * 8192;
constexpr float SCALE = 0.125f, THR = 8.f;
#define KSWZ64(row, colB) ((row) * 128 + ((colB) ^ ((((row) >> 1) & 7) << 4)))
#define SBAR() __builtin_amdgcn_sched_barrier(0)
__device__ __forceinline__ int v_slot_key(int p) { const int kk = ((p >> 7) << 3) | ((p & 31) >> 2); return (kk & ~0xC) | ((kk & 4) << 1) | ((kk & 8) >> 1); }
__device__ __forceinline__ int v_slot_col(int p) { return ((p >> 5) & 3) * 32 + (p & 3) * 8; }
__device__ __forceinline__ int v_rd_base(int lane) { return ((lane & 3) << 3) | (((lane >> 2) & 3) << 6) | (((lane >> 4) & 1) << 5) | (((lane >> 5) & 1) << 8); }
constexpr int v_rd_off(int d0, int ks, int half) { return d0 * 512 + ks * 4096 + half * 2048; }
__device__ __forceinline__ int crow(int r, int hi) { return (r & 3) + 8 * (r >> 2) + 4 * hi; }
__device__ __forceinline__ unsigned cvtpk(float lo, float hi) { unsigned r; asm volatile("v_cvt_pk_bf16_f32 %0, %1, %2" : "=v"(r) : "v"(lo), "v"(hi)); return r; }
__device__ __forceinline__ bf16x8 load8(const bf16_t* p) { return *reinterpret_cast<const bf16x8*>(p); }
__device__ __forceinline__ void mask_tile(f32x16& p0, f32x16& p1, int dq) {
    const float NEG = -__builtin_inff();
#pragma unroll
    for (int r = 0; r < 16; ++r) { const int c = (r & 3) + 8 * (r >> 2); if (dq - c < 0) p0[r] = NEG; if (dq - c - 32 < 0) p1[r] = NEG; }
}
__device__ __forceinline__ void partialSM(f32x16& p0, f32x16& p1, float& m_reg, float& mn, float& alpha) {
    float pmax = p0[0];
#pragma unroll
    for (int r = 1; r < 16; ++r) pmax = fmaxf(pmax, p0[r]);
#pragma unroll
    for (int r = 0; r < 16; ++r) pmax = fmaxf(pmax, p1[r]);
    { auto rr = __builtin_amdgcn_permlane32_swap(__float_as_uint(pmax), __float_as_uint(pmax), false, false); pmax = fmaxf(__uint_as_float(rr[0]), __uint_as_float(rr[1])); }
    constexpr float C2 = 1.4426950408889634f * SCALE;
    if (__builtin_expect(__all((pmax - m_reg) * SCALE <= THR), 1)) { mn = m_reg; alpha = 1.f; }
    else { mn = fmaxf(m_reg, pmax); alpha = __builtin_amdgcn_exp2f((m_reg - mn) * C2); m_reg = mn; }
    const float mnL = -mn * C2;
#pragma unroll
    for (int r = 0; r < 16; ++r) p0[r] = fmaf(p0[r], C2, mnL);
#pragma unroll
    for (int r = 0; r < 16; ++r) p1[r] = fmaf(p1[r], C2, mnL);
#pragma unroll
    for (int r = 0; r < 16; ++r) p0[r] = __builtin_amdgcn_exp2f(p0[r]);
}
__device__ __forceinline__ void finishSM(f32x16& p0, f32x16& p1, float alpha, float& l_reg, bf16x8& pa0, bf16x8& pa1, bf16x8& pa2, bf16x8& pa3) {
#pragma unroll
    for (int r = 0; r < 16; ++r) p1[r] = __builtin_amdgcn_exp2f(p1[r]);
    float ps = 0;
#pragma unroll
    for (int r = 0; r < 16; ++r) ps += p0[r];
#pragma unroll
    for (int r = 0; r < 16; ++r) ps += p1[r];
    { auto rr = __builtin_amdgcn_permlane32_swap(__float_as_uint(ps), __float_as_uint(ps), false, false); ps = __uint_as_float(rr[0]) + __uint_as_float(rr[1]); }
    l_reg = l_reg * alpha + ps;
#define PK4(P, B_, OUT) do { unsigned a0 = cvtpk(P[B_+0], P[B_+1]), a1 = cvtpk(P[B_+2], P[B_+3]);                          \
        unsigned b0 = cvtpk(P[B_+4], P[B_+5]), b1 = cvtpk(P[B_+6], P[B_+7]);                                             \
        auto r0 = __builtin_amdgcn_permlane32_swap(a0, b0, false, false); auto r1 = __builtin_amdgcn_permlane32_swap(a1, b1, false, false); \
        u32x4 w = {r0[0], r1[0], r0[1], r1[1]}; OUT = *reinterpret_cast<bf16x8*>(&w); } while (0)
    PK4(p0, 0, pa0); PK4(p0, 8, pa1); PK4(p1, 0, pa2); PK4(p1, 8, pa3);
#undef PK4
}
template <int KB>
__device__ __forceinline__ void qkt(f32x16& p0, f32x16& p1, const char* K_lds, int r32, int hi, const bf16x8* qr) {
    p0 = f32x16{}; p1 = f32x16{};
#pragma unroll
    for (int d0 = 0; d0 < 4; ++d0) { const char* a = K_lds + KB * SHM_K + KSWZ64(r32, (d0 * 16 + hi * 8) * 2);
        bf16x8 b0 = *reinterpret_cast<const bf16x8*>(a);
        bf16x8 b1 = *reinterpret_cast<const bf16x8*>(a + 32 * 128);
        p0 = __builtin_amdgcn_mfma_f32_32x32x16_bf16(b0, qr[d0], p0, 0, 0, 0);
        p1 = __builtin_amdgcn_mfma_f32_32x32x16_bf16(b1, qr[d0], p1, 0, 0, 0); }
}
template <int VB>
__device__ __forceinline__ void pv_tile(f32x16* o, int vb0, bf16x8 pa0, bf16x8 pa1, bf16x8 pa2, bf16x8 pa3) {
#define TRRD(dst, off) asm volatile("ds_read_b64_tr_b16 %0, %1 offset:%2" : "=&v"(dst) : "v"(vb0), "i"(off) : "memory")
#define PV_RD(S, d0) do { constexpr int b_ = LDS_V + VB * SHM_V + v_rd_off(d0, 0, 0); \
        TRRD(S##l0, b_); TRRD(S##h0, b_ + 2048); TRRD(S##l1, b_ + 4096); TRRD(S##h1, b_ + 6144); TRRD(S##l2, b_ + 8192); TRRD(S##h2, b_ + 10240); TRRD(S##l3, b_ + 12288); TRRD(S##h3, b_ + 14336); } while (0)
#define PV_MM(S, d0) do { \
        o[d0] = __builtin_amdgcn_mfma_f32_32x32x16_bf16(pa0, (bf16x8){S##l0[0], S##l0[1], S##l0[2], S##l0[3], S##h0[0], S##h0[1], S##h0[2], S##h0[3]}, o[d0], 0, 0, 0);   \
        o[d0] = __builtin_amdgcn_mfma_f32_32x32x16_bf16(pa1, (bf16x8){S##l1[0], S##l1[1], S##l1[2], S##l1[3], S##h1[0], S##h1[1], S##h1[2], S##h1[3]}, o[d0], 0, 0, 0);   \
        o[d0] = __builtin_amdgcn_mfma_f32_32x32x16_bf16(pa2, (bf16x8){S##l2[0], S##l2[1], S##l2[2], S##l2[3], S##h2[0], S##h2[1], S##h2[2], S##h2[3]}, o[d0], 0, 0, 0);   \
        o[d0] = __builtin_amdgcn_mfma_f32_32x32x16_bf16(pa3, (bf16x8){S##l3[0], S##l3[1], S##l3[2], S##l3[3], S##h3[0], S##h3[1], S##h3[2], S##h3[3]}, o[d0], 0, 0, 0); } while (0)
#define LGK(n) do { asm volatile("s_waitcnt lgkmcnt(" #n ")" ::: "memory"); SBAR(); } while (0)
    s16x4 Al0, Al1, Al2, Al3, Ah0, Ah1, Ah2, Ah3, Bl0, Bl1, Bl2, Bl3, Bh0, Bh1, Bh2, Bh3;
    PV_RD(A, 0); PV_RD(B, 1); LGK(8); PV_MM(A, 0); SBAR();
    PV_RD(A, 2); LGK(8); PV_MM(B, 1); SBAR();
    PV_RD(B, 3); LGK(8); PV_MM(A, 2); SBAR();
    LGK(0); PV_MM(B, 3);
#undef PV_RD
#undef PV_MM
#undef LGK
#undef TRRD
}
struct BlockRef { const bf16_t* Q; const bf16_t* K; const bf16_t* V; bf16_t* OUT; int P0, c; };
struct Seam { bf16x8 qr[4]; };
#define DA_VMW() asm volatile("s_waitcnt vmcnt(0)" ::: "memory")
#define DA_KDMA(Kp, k0, bf) pg8::glds16s<0>((Kp) + (size_t)(k0) * RS, kvo, kdst + (unsigned)((bf) * SHM_K))
#define DA_VDMA(Vp, k0, bf) do { pg8::glds16s<0>((Vp) + (size_t)(k0) * RS, vvo0, vdst + (unsigned)((bf) * SHM_V)); pg8::glds16s<0>((Vp) + (size_t)(k0) * RS, vvo1, vdst + (unsigned)((bf) * SHM_V + 8192)); } while (0)
#define DA_ADDR() \
    const int kr = tid >> 3; \
    const unsigned kvo = (unsigned)(kr * RS + (((tid & 7) ^ ((kr >> 1) & 7)) * 8)) * 2u, kdst = (unsigned)__builtin_amdgcn_readfirstlane((unsigned)(uintptr_t)lds + LDS_K + wid * 1024); \
    const unsigned vvo0 = (unsigned)(v_slot_key(tid) * RS + v_slot_col(tid)) * 2u, vvo1 = (unsigned)(v_slot_key(tid + 512) * RS + v_slot_col(tid + 512)) * 2u, \
                   vdst = (unsigned)__builtin_amdgcn_readfirstlane((unsigned)(uintptr_t)lds + LDS_V + wid * 1024)
__device__ __forceinline__ void prime(const BlockRef& cur, char* lds, Seam& S) {
    const int tid = otid(), wid = __builtin_amdgcn_readfirstlane(tid >> 6), lane = tid & 63, r32 = lane & 31, hi = lane >> 5;
    DA_ADDR();
#pragma unroll
    for (int d0 = 0; d0 < 4; ++d0) S.qr[d0] = load8(cur.Q + (size_t)(wid * QBLK + r32) * RS + d0 * 16 + hi * 8);
    DA_KDMA(cur.K, 0, 0); DA_VDMA(cur.V, 0, 0); DA_VMW();
    __syncthreads();
}
__device__ __forceinline__ void block(const BlockRef& cur, const BlockRef& nxt, char* lds, Seam& S, float lam, const float* __restrict__ subln_w) {
    const int tid = otid(), wid = __builtin_amdgcn_readfirstlane(tid >> 6), lane = tid & 63, r32 = lane & 31, hi = lane >> 5;
    const int NT = (cur.P0 + QB) / KVBLK;
    const int qlo = cur.P0 + wid * QBLK, qm = qlo + r32 - 4 * hi;
    char* K_lds = lds + LDS_K;
    float* ws = (float*)(lds + LDS_WS) + wid * 64; float* li_l = ws; float* al_l = ws + 32;
    float m_reg = -1e30f, l_reg = 0; f32x16 o[4] = {};
    DA_ADDR();
    const int vb0 = (int)(uintptr_t)lds + v_rd_base(lane);
    const bf16_t* Kh = cur.K; const bf16_t* Vh = cur.V;
#define RESC(a) do { if (__any((a) < 1.f)) { if (hi == 0) al_l[r32] = (a); asm volatile("s_waitcnt lgkmcnt(0)" ::: "memory");              \
                     _Pragma("unroll") for (int d_ = 0; d_ < 4; ++d_) _Pragma("unroll") for (int r = 0; r < 16; ++r) o[d_][r] *= al_l[crow(r, hi)]; } } while (0)
#define KBASE(t) ((t) * KVBLK)
#define MASKT(P0_, P1_, t) do { const int kb_ = KBASE(t); if (kb_ + KVBLK - 1 > qlo) mask_tile(P0_, P1_, qm - kb_); } while (0)
    f32x16 pA0, pA1, pB0, pB1; float mnA, mnB, alA, alB; bf16x8 pa0, pa1, pa2, pa3;
    DA_KDMA(Kh, KBASE(1), 1); DA_VDMA(Vh, KBASE(1), 1);
    SBAR(); qkt<0>(pA0, pA1, K_lds, r32, hi, S.qr);
    MASKT(pA0, pA1, 0); partialSM(pA0, pA1, m_reg, mnA, alA);
    DA_VMW(); __syncthreads();
#define HALF_STEP(PX0, PX1, mnX, alX, PY0, PY1, alY, t, KB, VBP, KBN, VBN) do {                                               \
        SBAR(); DA_KDMA(Kh, KBASE((t) + 1), KBN); DA_VDMA(Vh, KBASE((t) + 1), VBN); SBAR();     \
        qkt<KB>(PX0, PX1, K_lds, r32, hi, S.qr);                                                                              \
        finishSM(PY0, PY1, alY, l_reg, pa0, pa1, pa2, pa3); SBAR();                                                           \
        pv_tile<VBP>(o, vb0, pa0, pa1, pa2, pa3); MASKT(PX0, PX1, (t)); partialSM(PX0, PX1, m_reg, mnX, alX);                  \
        RESC(alX); DA_VMW(); __syncthreads(); } while (0)
    HALF_STEP(pB0, pB1, mnB, alB, pA0, pA1, alA, 1, 1, 0, 0, 2);
    HALF_STEP(pA0, pA1, mnA, alA, pB0, pB1, alB, 2, 0, 1, 1, 3);
    for (int t = 3; t + 1 < NT; t += 4) {
        HALF_STEP(pB0, pB1, mnB, alB, pA0, pA1, alA, t, 1, 2, 0, 0);
        HALF_STEP(pA0, pA1, mnA, alA, pB0, pB1, alB, t + 1, 0, 3, 1, 1);
        HALF_STEP(pB0, pB1, mnB, alB, pA0, pA1, alA, t + 2, 1, 0, 0, 2);
        HALF_STEP(pA0, pA1, mnA, alA, pB0, pB1, alB, t + 3, 0, 1, 1, 3);
    }
    SBAR(); qkt<1>(pB0, pB1, K_lds, r32, hi, S.qr); SBAR();
    DA_KDMA(nxt.K, 0, 0); DA_VDMA(nxt.V, 0, 0); SBAR();
#pragma unroll
    for (int d0 = 0; d0 < 4; ++d0) S.qr[d0] = load8(nxt.Q + (size_t)(wid * QBLK + r32) * RS + d0 * 16 + hi * 8);
    SBAR();
    finishSM(pA0, pA1, alA, l_reg, pa0, pa1, pa2, pa3); SBAR();
    pv_tile<2>(o, vb0, pa0, pa1, pa2, pa3);
    MASKT(pB0, pB1, NT - 1); partialSM(pB0, pB1, m_reg, mnB, alB); RESC(alB);
    finishSM(pB0, pB1, alB, l_reg, pa0, pa1, pa2, pa3); SBAR(); pv_tile<3>(o, vb0, pa0, pa1, pa2, pa3);
    SBAR();
    if (hi == 0) li_l[r32] = l_reg;
    asm volatile("s_waitcnt lgkmcnt(0)" ::: "memory");
    float rli[16];
#pragma unroll
    for (int r = 0; r < 16; ++r) rli[r] = __builtin_amdgcn_rcpf(li_l[crow(r, hi)]);
    unsigned* ostw = (unsigned*)(lds + LDS_OST + wid * 8192);
    if (cur.c == 1) {
#pragma unroll
        for (int d0 = 0; d0 < 4; ++d0)
#pragma unroll
            for (int r = 0; r < 16; r += 2) ostw[(d0 * 8 + (r >> 1)) * 64 + lane] = cvtpk(o[d0][r] * rli[r], o[d0][r + 1] * rli[r + 1]);
    } else {
        float ss[16];
#pragma unroll
        for (int r = 0; r < 16; ++r) ss[r] = 0.f;
#pragma unroll
        for (int d0 = 0; d0 < 4; ++d0)
#pragma unroll
            for (int r = 0; r < 16; r += 2) { const unsigned u = ostw[(d0 * 8 + (r >> 1)) * 64 + lane];
                const float v0 = o[d0][r] * rli[r] - lam * __uint_as_float(u << 16), v1 = o[d0][r + 1] * rli[r + 1] - lam * __uint_as_float(u & 0xffff0000u);
                o[d0][r] = v0; o[d0][r + 1] = v1; ss[r] += v0 * v0; ss[r + 1] += v1 * v1; }
#pragma unroll
        for (int msk = 1; msk < 32; msk <<= 1)
#pragma unroll
            for (int r = 0; r < 16; ++r) ss[r] += __shfl_xor(ss[r], msk);
        float sw[4];
#pragma unroll
        for (int d0 = 0; d0 < 4; ++d0) sw[d0] = subln_w[d0 * 32 + r32] * 0.8f;
        asm volatile("s_waitcnt lgkmcnt(0)" ::: "memory");
        bf16_t* stg = (bf16_t*)ostw;
#pragma unroll
        for (int r = 0; r < 16; ++r) { const float rs = 1.0f / sqrtf(ss[r] * (1.f / 128.f) + EPS); const int orow = crow(r, hi);
#pragma unroll
            for (int d0 = 0; d0 < 4; ++d0) stg[orow * 128 + d0 * 32 + r32] = (bf16_t)f2bf(o[d0][r] * rs * sw[d0]); }
        asm volatile("s_waitcnt lgkmcnt(0)" ::: "memory");
        bf16_t* Ow = cur.OUT + (size_t)(wid * QBLK) * D;
#pragma unroll
        for (int i = 0; i < 8; ++i) { const int row = i * 4 + (lane >> 4), ch = lane & 15; const u32x4 v = *(const u32x4*)(stg + row * 128 + ch * 8); *(u32x4*)(Ow + (size_t)row * D + ch * 8) = v; }
    }
    DA_VMW();
    __syncthreads();
#undef RESC
#undef KBASE
#undef MASKT
#undef HALF_STEP
}
#undef DA_VMW
#undef DA_KDMA
#undef DA_VDMA
#undef DA_ADDR
__device__ __forceinline__ BlockRef ref_of(int L, int seq, const bf16_t* PROJ, bf16_t* CAT) {
    const int bh = L >> 2, y = L & 3, b = bh >> 2, h = bh & 3, qb = (seq < 2) ? y : 7 - y, c = (seq & 1) ? 0 : 1;
    BlockRef r; const size_t row0 = (size_t)b * SEQ;
    r.Q = PROJ + (row0 + (size_t)qb * QB) * RS + h * 128 + c * 64; r.K = PROJ + row0 * RS + 512 + h * 128 + c * 64; r.V = PROJ + row0 * RS + 1024 + h * 128;
    r.OUT = CAT + (row0 + (size_t)qb * QB) * D + h * 128; r.P0 = qb * QB; r.c = c; return r;
}
__device__ __forceinline__ void phase(char* lds, const bf16_t* PROJ, bf16_t* CAT, float lam, const float* subln_w, int G, int bid) {
    constexpr int TOTAL = (T / SEQ) * 4 * 4;
    const int v = (G % 8 == 0) ? (bid & 7) * (G >> 3) + (bid >> 3) : bid;
    int L = v; if (L >= TOTAL) return;
    int seq = 0; BlockRef cur = ref_of(L, 0, PROJ, CAT);
    Seam S; prime(cur, lds, S);
    for (;;) {
        int Ln = L, seqn = seq + 1; if (seqn == 4) { seqn = 0; Ln = L + G; }
        const bool last = Ln >= TOTAL;
        const BlockRef nxt = last ? cur : ref_of(Ln, seqn, PROJ, CAT);
        block(cur, nxt, lds, S, lam, subln_w);
        if (last) break;
        cur = nxt; L = Ln; seq = seqn;
    }
}
#undef KSWZ64
#undef SBAR
}


#define LAS __attribute__((address_space(3)))
constexpr int NWAVES = 8, NTHREADS = 512;
namespace rtr {
typedef float f32x2 __attribute__((ext_vector_type(2)));
constexpr int WPITCH = 2064;
constexpr int LDS_WHI = 0, LDS_WLO = 32 * WPITCH, LDS_LG = 64 * WPITCH, LDS_CNT = LDS_LG + 8 * 16 * 33 * 4, LDS_BYTES = LDS_CNT + 256;
static_assert(LDS_BYTES <= pg8::STAGE_BYTES + pg8::PLAN_BYTES, "router LDS overlaps the grid barrier's LDS words");
__device__ __forceinline__ void phase(LAS unsigned char* lds, const bf16_t* __restrict__ x1, const float* __restrict__ fw, const float* __restrict__ rw, const float* __restrict__ rb,
                                      int* cnt, int* ltok, float* lgate, int* slot, unsigned char* __restrict__ XQ, int G, int bid) {
    const int tid = otid(), lane = tid & 63, wid = __builtin_amdgcn_readfirstlane(tid >> 6), r = lane & 15, q = lane >> 4;
    LAS float* lg = (LAS float*)(lds + LDS_LG) + wid * (16 * 33); LAS int* lcount = (LAS int*)(lds + LDS_CNT); LAS int* lbase = lcount + 32;
    for (int idx = tid; idx < 1024 * 32; idx += NTHREADS) { const int k = idx >> 5, e = idx & 31; const float w = rw[idx] * fw[k];
        const unsigned hi = f2bf(w), lo = f2bf(w - __uint_as_float(hi << 16));
        *(LAS unsigned short*)(lds + LDS_WHI + e * WPITCH + 2 * k) = (unsigned short)hi; *(LAS unsigned short*)(lds + LDS_WLO + e * WPITCH + 2 * k) = (unsigned short)lo; }
    if (tid < 32) lcount[tid] = 0;
    __syncthreads();
    const float rb0 = rb[r], rb1 = rb[16 + r];
    const LAS unsigned char* whi = lds + LDS_WHI + r * WPITCH + 16 * q; const LAS unsigned char* wlo = lds + LDS_WLO + r * WPITCH + 16 * q;
    for (int tile = bid; tile < T / 128; tile += G) {
        const int t0 = tile * 128 + wid * 16, ch = (tile * 128) / TC;
        const bf16_t* xrow = x1 + (size_t)(t0 + r) * D + 8 * q;
        u32x4 xw[32];
#pragma unroll
        for (int j = 0; j < 32; ++j) xw[j] = *(const u32x4*)(xrow + 32 * j);
        f32x4 acc0 = {0.f, 0.f, 0.f, 0.f}, acc1 = {0.f, 0.f, 0.f, 0.f}; float ssq = 0.f;
#pragma unroll
        for (int j = 0; j < 32; ++j) {
            const bf16x8 av = *reinterpret_cast<const bf16x8*>(&xw[j]);
            const bf16x8 bh0 = *(const LAS bf16x8*)(whi + 64 * j), bh1 = *(const LAS bf16x8*)(whi + 16 * WPITCH + 64 * j), bl0 = *(const LAS bf16x8*)(wlo + 64 * j), bl1 = *(const LAS bf16x8*)(wlo + 16 * WPITCH + 64 * j);
            acc0 = __builtin_amdgcn_mfma_f32_16x16x32_bf16(av, bh0, acc0, 0, 0, 0); acc1 = __builtin_amdgcn_mfma_f32_16x16x32_bf16(av, bh1, acc1, 0, 0, 0);
            acc0 = __builtin_amdgcn_mfma_f32_16x16x32_bf16(av, bl0, acc0, 0, 0, 0); acc1 = __builtin_amdgcn_mfma_f32_16x16x32_bf16(av, bl1, acc1, 0, 0, 0);
#pragma unroll
            for (int i = 0; i < 4; ++i) { const float lo_ = __uint_as_float(xw[j][i] << 16), hi_ = __uint_as_float(xw[j][i] & 0xffff0000u); ssq += lo_ * lo_ + hi_ * hi_; }
            if ((j & 1) == 1) __builtin_amdgcn_sched_barrier(0);
        }
        ssq += __shfl_xor(ssq, 16); ssq += __shfl_xor(ssq, 32);
        const float rstd = 1.0f / sqrtf(ssq * (1.f / D) + EPS);
        { const float sx = rstd * FP8_SX;
#pragma unroll
          for (int j = 0; j < 32; ++j) { u32x4 xv = xw[j]; asm volatile("" : "+v"(xv));
              *(unsigned long long*)(XQ + (size_t)(t0 + r) * D + 32 * j + 8 * q) =
                  (unsigned long long)pk4_fp8(__uint_as_float(xv[0] << 16) * sx, __uint_as_float(xv[0] & 0xffff0000u) * sx, __uint_as_float(xv[1] << 16) * sx, __uint_as_float(xv[1] & 0xffff0000u) * sx)
                | ((unsigned long long)pk4_fp8(__uint_as_float(xv[2] << 16) * sx, __uint_as_float(xv[2] & 0xffff0000u) * sx, __uint_as_float(xv[3] << 16) * sx, __uint_as_float(xv[3] & 0xffff0000u) * sx) << 32); } }
        asm volatile("s_waitcnt lgkmcnt(0)" ::: "memory");
#pragma unroll
        for (int g4 = 0; g4 < 4; ++g4) { const float rs = __shfl(rstd, q * 4 + g4); lg[(q * 4 + g4) * 33 + r] = acc0[g4] * rs + rb0; lg[(q * 4 + g4) * 33 + 16 + r] = acc1[g4] * rs + rb1; }
        asm volatile("s_waitcnt lgkmcnt(0)" ::: "memory");
        int ti[4]; float gt[4]; int lpos[4];
        if (lane < 16) {
            float v[32];
#pragma unroll
            for (int e = 0; e < 32; ++e) v[e] = lg[lane * 33 + e];
            unsigned used = 0u; float tv[4];
#pragma unroll
            for (int k = 0; k < 4; ++k) { float best = -INFINITY; int bi = -1;
#pragma unroll
                for (int e = 0; e < 32; ++e) { const bool take = !((used >> e) & 1u) && (bi < 0 || v[e] > best); best = take ? v[e] : best; bi = take ? e : bi; }
                tv[k] = best; ti[k] = bi; used |= 1u << bi; }
            const float e1 = expf(tv[1] - tv[0]), e2 = expf(tv[2] - tv[0]), e3 = expf(tv[3] - tv[0]), inv = 1.f / (1.f + e1 + e2 + e3);
            gt[0] = inv; gt[1] = e1 * inv; gt[2] = e2 * inv; gt[3] = e3 * inv;
#pragma unroll
            for (int k = 0; k < 4; ++k) lpos[k] = __hip_atomic_fetch_add(lcount + ti[k], 1, __ATOMIC_RELAXED, __HIP_MEMORY_SCOPE_WORKGROUP);
        }
        __syncthreads();
        if (tid < 32) { const int c = lcount[tid]; lbase[tid] = c ? atomicAdd(&cnt[ch * 32 + tid], c) : 0; lcount[tid] = 0; }
        __syncthreads();
        if (lane < 16) { const int t = t0 + lane;
#pragma unroll
            for (int k = 0; k < 4; ++k) { const int pos = lbase[ti[k]] + lpos[k]; const size_t idx = ((size_t)ch * 32 + ti[k]) * TC + pos;
                ltok[idx] = t; lgate[idx] = gt[k]; slot[t * 4 + k] = (ti[k] << 16) | pos; } }
    }
    __syncthreads();
}
}

typedef unsigned gu32_t;
#define XB_TMO      128
#define XB_XCNT(j)  (256  + 64 * (j))
#define XB_XSUB(j)  (1280 + 64 * (j))
#define XB_XGEN(j)  (2304 + 64 * (j))
#define XB_TOP      3328
#define XB_TOPGEN   3392
#define XCD_BAR_WORDS 3456
#define XB_SPIN_CAP (1u << 18)

__device__ __forceinline__ unsigned xb_ld(unsigned* p)              { return __hip_atomic_load(p, __ATOMIC_RELAXED, __HIP_MEMORY_SCOPE_AGENT); }
__device__ __forceinline__ unsigned xb_add(unsigned* p, unsigned v) { return __hip_atomic_fetch_add(p, v, __ATOMIC_RELAXED, __HIP_MEMORY_SCOPE_AGENT); }
__device__ __forceinline__ unsigned xb_xcc_id() { return (unsigned)__builtin_amdgcn_s_getreg((3 << 11) | 20) & 0xFu; }
#define XB_SPIN(cond, bar) do { unsigned _sp = 0; while (cond) { __builtin_amdgcn_s_sleep(1); \
    if ((++_sp & 255u) == 0u) { if (xb_ld(&(bar)[XB_TMO])) break; if (_sp > XB_SPIN_CAP) { atomicAdd(&(bar)[XB_TMO], 1u); break; } } } } while (0)

struct XcdBarrier {
    unsigned* bar; unsigned x;
    volatile LAS unsigned* st;
};

__device__ __forceinline__ XcdBarrier xcd_barrier_post(unsigned* bar, volatile LAS unsigned* st) {
    XcdBarrier b; b.bar = bar; b.x = xb_xcc_id(); b.st = st;
    if (threadIdx.x == 0) (void)xb_add(&bar[XB_XCNT(b.x)], 1u);
    return b;
}
__device__ __forceinline__ void xcd_barrier_complete(unsigned* bar, unsigned x, unsigned& nloc, unsigned& nx) {
    const unsigned G = gridDim.x * gridDim.y * gridDim.z;
    unsigned sum, cnt, mine, sp = 0u;
    for (;;) {
        sum = 0u; cnt = 0u; mine = 0u;
#pragma unroll
        for (unsigned j = 0; j < 16; ++j) { const unsigned c = xb_ld(&bar[XB_XCNT(j)]); sum += c; cnt += (c > 0u) ? 1u : 0u; mine = (j == x) ? c : mine; }
        if (sum == G) break;
        __builtin_amdgcn_s_sleep(1);
        if ((++sp & 255u) == 0u) { if (xb_ld(&bar[XB_TMO])) break; if (sp > XB_SPIN_CAP) { atomicAdd(&bar[XB_TMO], 1u); break; } }
    }
    nloc = mine > 0u ? mine : 1u; nx = cnt > 0u ? cnt : 1u;
}

__device__ __forceinline__ void xcd_barrier(const XcdBarrier& b) {
    asm volatile("s_waitcnt vmcnt(0)" ::: "memory");
    __syncthreads();
    if (threadIdx.x == 0) {
        unsigned* bar = b.bar;
        __builtin_amdgcn_s_waitcnt(0);
        unsigned nloc = b.st[0], nx = b.st[1];
        if (nloc == 0u) { xcd_barrier_complete(bar, b.x, nloc, nx); b.st[0] = nloc; b.st[1] = nx; }
        const unsigned old = xb_add(&bar[XB_XSUB(b.x)], 1u);
        const unsigned gen = old / nloc;
        if (old + 1u == (gen + 1u) * nloc) {
            __builtin_amdgcn_fence(__ATOMIC_RELEASE, "agent");
            asm volatile("s_waitcnt vmcnt(0)" ::: "memory");
            const unsigned og = xb_add(&bar[XB_TOP], 1u);
            const unsigned tg = og / nx;
            if (og + 1u == (tg + 1u) * nx) xb_add(&bar[XB_TOPGEN], 1u);
            else XB_SPIN(xb_ld(&bar[XB_TOPGEN]) == tg, bar);
            __builtin_amdgcn_fence(__ATOMIC_ACQUIRE, "agent");
            xb_add(&bar[XB_XGEN(b.x)], 1u);
            asm volatile("s_waitcnt vmcnt(0)" ::: "memory");
        } else {
            XB_SPIN(xb_ld(&bar[XB_XGEN(b.x)]) == gen, bar);
            __builtin_amdgcn_fence(__ATOMIC_ACQUIRE, "agent");
            asm volatile("s_waitcnt vmcnt(0)" ::: "memory");
        }
    }
    __syncthreads();
}


constexpr int XB_LDS = pg8::STAGE_BYTES + pg8::PLAN_BYTES;
constexpr int MK_LDS = pg8::STAGE_BYTES + pg8::PLAN_BYTES + 64 + 2048;

struct MArgs {
    const float* x; const int* positions; const float* attn_norm_w; const float* w_in; const float* lq1; const float* lk1; const float* lq2; const float* lk2;
    const float* subln_w; const float* pool_w; const float* pool_scale; const float* w_out; const float* ffn_norm_w; const float* router_w; const float* router_b;
    const float* w_gu; const float* b_gu; const float* w_down; const float* b_down; const float* final_w; float* out; unsigned char* ws;
};

template <int MODE>
__device__ __forceinline__ void p0_transpose_item(const float* __restrict__ W, int N, bf16_t* __restrict__ WT, int ldk, LAS float* scr, int item, int lane, const float* __restrict__ kscale) {
    const int nblk = N / 32, kb = item / nblk, nb = item % nblk, k0 = 64 * kb, n0 = 32 * nb;
#pragma unroll 8
    for (int i = 0; i < 32; ++i) { const int kk = 2 * i + (lane >> 5); float v = W[(size_t)(k0 + kk) * N + n0 + (lane & 31)]; if (MODE != 0) v *= kscale[k0 + kk]; scr[kk * 33 + (lane & 31)] = v; }
    asm volatile("s_waitcnt lgkmcnt(0)" ::: "memory");
    const int c = lane & 7;
#pragma unroll
    for (int j = 0; j < 4; ++j) { const int nl = (lane >> 3) + 8 * j, n = n0 + nl; const LAS float* s = scr + (8 * c) * 33 + nl;
        int row = n;
        if (MODE == 1) { const int f = n & 1023, up = n >> 10; row = (f >> 7) * 256 + up * 128 + (f & 127); }
        u32x4 o; o.x = f2bf(s[0 * 33]) | (f2bf(s[1 * 33]) << 16); o.y = f2bf(s[2 * 33]) | (f2bf(s[3 * 33]) << 16); o.z = f2bf(s[4 * 33]) | (f2bf(s[5 * 33]) << 16); o.w = f2bf(s[6 * 33]) | (f2bf(s[7 * 33]) << 16);
        *(u32x4*)(WT + (size_t)row * ldk + k0 + 8 * c) = o; }
    asm volatile("s_waitcnt lgkmcnt(0)" ::: "memory");
}
template <int MODE>
__device__ __forceinline__ void p0_transpose_item_fp8(const float* __restrict__ W, int N, unsigned char* __restrict__ WT, int ldk, LAS float* scr, int item, int lane, const float* __restrict__ kscale, float sc) {
    const int nblk = N / 32, kb = item / nblk, nb = item % nblk, k0 = 64 * kb, n0 = 32 * nb;
#pragma unroll 8
    for (int i = 0; i < 32; ++i) { const int kk = 2 * i + (lane >> 5); float v = W[(size_t)(k0 + kk) * N + n0 + (lane & 31)] * sc; if (MODE == 1) v *= kscale[k0 + kk]; scr[kk * 33 + (lane & 31)] = v; }
    asm volatile("s_waitcnt lgkmcnt(0)" ::: "memory");
    const int c = lane & 3;
#pragma unroll
    for (int j = 0; j < 2; ++j) { const int nl = (lane >> 2) + 16 * j, n = n0 + nl; const LAS float* s = scr + (16 * c) * 33 + nl;
        int row = n;
        if (MODE == 1) { const int f = n & 1023, up = n >> 10; row = (f >> 7) * 256 + up * 128 + (f & 127); }
        u32x4 o;
#pragma unroll
        for (int q = 0; q < 4; ++q) o[q] = pk4_fp8(s[(4 * q) * 33], s[(4 * q + 1) * 33], s[(4 * q + 2) * 33], s[(4 * q + 3) * 33]);
        *(u32x4*)(WT + (size_t)row * ldk + k0 + 16 * c) = o; }
    asm volatile("s_waitcnt lgkmcnt(0)" ::: "memory");
}
__device__ __forceinline__ void xbf_row(const float* __restrict__ xrow, bf16_t* __restrict__ orow, float* __restrict__ rstd_out, int lane) {
    const f32x4* xr = (const f32x4*)xrow + lane;
    f32x4 v[4]; float s = 0.f;
#pragma unroll
    for (int j = 0; j < 4; ++j) { v[j] = xr[64 * j]; s += v[j].x * v[j].x + v[j].y * v[j].y + v[j].z * v[j].z + v[j].w * v[j].w; }
    unsigned long long* o8 = (unsigned long long*)orow + lane;
#pragma unroll
    for (int j = 0; j < 4; ++j) { const unsigned lo = f2bf(v[j].x) | (f2bf(v[j].y) << 16), hi = f2bf(v[j].z) | (f2bf(v[j].w) << 16); o8[64 * j] = (unsigned long long)lo | ((unsigned long long)hi << 32); }
    const float rstd = 1.0f / sqrtf(wave_sum(s) * (1.f / D) + EPS);
    if (lane == 0) *rstd_out = rstd;
}
__device__ __forceinline__ void rmsnorm_row_bf16(const float* __restrict__ xrow, const float* __restrict__ w, bf16_t* __restrict__ orow, int lane) {
    const f32x4* xr = (const f32x4*)xrow + lane;
    f32x4 v[4]; float s = 0.f;
#pragma unroll
    for (int j = 0; j < 4; ++j) { v[j] = xr[64 * j]; s += v[j].x * v[j].x + v[j].y * v[j].y + v[j].z * v[j].z + v[j].w * v[j].w; }
    const float rstd = 1.0f / sqrtf(wave_sum(s) * (1.f / D) + EPS);
    unsigned long long* o8 = (unsigned long long*)orow + lane;
#pragma unroll
    for (int j = 0; j < 4; ++j) { const f32x4 ww = ((const f32x4*)w)[64 * j + lane];
        const unsigned lo = f2bf(v[j].x * rstd * ww.x) | (f2bf(v[j].y * rstd * ww.y) << 16), hi = f2bf(v[j].z * rstd * ww.z) | (f2bf(v[j].w * rstd * ww.w) << 16);
        o8[64 * j] = (unsigned long long)lo | ((unsigned long long)hi << 32); }
}

__device__ __forceinline__ void final_row(float* __restrict__ out, const bf16_t* __restrict__ XB, const unsigned char* __restrict__ YP, const LAS int* tb, const int* slot, const float* __restrict__ lgate, const float* __restrict__ w, int t, int lane) {
    int rows[4]; float gk[4];
#pragma unroll
    for (int k = 0; k < 4; ++k) { const int sl = slot[t * 4 + k]; rows[k] = tb[sl >> 16] + (sl & 0xffff); gk[k] = lgate[(size_t)(sl >> 16) * TC + (sl & 0xffff)] * (1.0f / FP8_SY); }
    float v[16];
    { const u32x4 a0 = *(const u32x4*)(XB + (size_t)t * D + 16 * lane), a1 = *(const u32x4*)(XB + (size_t)t * D + 16 * lane + 8);
#pragma unroll
      for (int e = 0; e < 4; ++e) { v[2 * e] = __uint_as_float(a0[e] << 16); v[2 * e + 1] = __uint_as_float(a0[e] & 0xffff0000u); v[8 + 2 * e] = __uint_as_float(a1[e] << 16); v[8 + 2 * e + 1] = __uint_as_float(a1[e] & 0xffff0000u); } }
    float y[16];
#pragma unroll
    for (int e = 0; e < 16; ++e) y[e] = 0.f;
#pragma unroll
    for (int k = 0; k < 4; ++k) { const u32x4 q = *(const u32x4*)(YP + (size_t)rows[k] * D + 16 * lane);
#pragma unroll
        for (int e = 0; e < 4; ++e) { y[4 * e] += gk[k] * __builtin_amdgcn_cvt_f32_fp8(q[e], 0); y[4 * e + 1] += gk[k] * __builtin_amdgcn_cvt_f32_fp8(q[e], 1); y[4 * e + 2] += gk[k] * __builtin_amdgcn_cvt_f32_fp8(q[e], 2); y[4 * e + 3] += gk[k] * __builtin_amdgcn_cvt_f32_fp8(q[e], 3); } }
    float s = 0.f;
#pragma unroll
    for (int e = 0; e < 16; ++e) { v[e] += y[e]; s += v[e] * v[e]; }
    const float rstd = 1.0f / sqrtf(wave_sum(s) * (1.f / D) + EPS);
    float* op = out + (size_t)t * D + 16 * lane; const float* wp = w + 16 * lane;
#pragma unroll
    for (int e = 0; e < 4; ++e) { const f32x4 ww = *(const f32x4*)(wp + 4 * e); *(f32x4*)(op + 4 * e) = (f32x4){v[4 * e] * rstd * ww.x, v[4 * e + 1] * rstd * ww.y, v[4 * e + 2] * rstd * ww.z, v[4 * e + 3] * rstd * ww.w}; }
}

typedef const MArgs __attribute__((address_space(4)))* KArgP;
__device__ __forceinline__ KArgP kargs() { KArgP p = (KArgP)__builtin_amdgcn_kernarg_segment_ptr(); asm volatile("" : "+s"(p)); return p; }
#define WSP(T_, off) ((T_*)(ws + (off)))
__global__ __launch_bounds__(NTHREADS, 2) void mega_fwd(MArgs a_unused) {
    extern __shared__ __attribute__((aligned(16))) unsigned char lds_raw[];
    LAS unsigned char* lds = (LAS unsigned char*)lds_raw;
    const int G = gridDim.x, bid = blockIdx.x, gsz = G * NTHREADS, ngw = G * NWAVES;
    if (threadIdx.x < 16) ((LAS unsigned*)(lds + XB_LDS))[threadIdx.x] = 0u;
    __syncthreads();
    (void)xcd_barrier_post((unsigned*)(kargs()->ws + WS_BAR), (volatile LAS unsigned*)(lds + XB_LDS));
#define GRID_SYNC() do { XcdBarrier xb_; xb_.bar = (unsigned*)(kargs()->ws + WS_BAR); xb_.x = xb_xcc_id(); xb_.st = (volatile LAS unsigned*)(lds + XB_LDS); xcd_barrier(xb_); } while (0)
#define PHASE_IDX() const int tid = otid(), lane = tid & 63, wid = __builtin_amdgcn_readfirstlane(tid >> 6), gtid = bid * NTHREADS + tid, gw = bid * NWAVES + wid; (void)lane; (void)gtid; (void)gw

    {
        PHASE_IDX(); KArgP a = kargs(); unsigned char* ws = a->ws; int* cnt = WSP(int, WS_CTL); float* rope = WSP(float, WS_ROPE); bf16_t* Win_t = WSP(bf16_t, WS_WIN); bf16_t* Wo_t = WSP(bf16_t, WS_WO); bf16_t* Wd_t = WSP(bf16_t, WS_WD); bf16_t* Wgu_t = WSP(bf16_t, WS_WGU); bf16_t* XN = WSP(bf16_t, WS_XN);
        if (gtid < NCHUNK * 32) cnt[gtid] = 0;
        LAS float* scr = (LAS float*)(lds + wid * 8448);
        constexpr int I_IN = (D / 64) * (INW / 32), I_WO = (512 / 64) * (D / 32), I_GU = (D / 64) * (2048 / 32), I_DN = (FF / 64) * (D / 32);
        constexpr int NITEMS = I_IN + I_WO + NE * I_GU + NE * I_DN;
        for (int it = gw; it < NITEMS; it += ngw) {
            int r = it;
            if (r < I_IN) { p0_transpose_item<2>(a->w_in, INW, Win_t, D, scr, r, lane, a->attn_norm_w); continue; } r -= I_IN;
            if (r < I_WO) { p0_transpose_item<0>(a->w_out, D, Wo_t, D, scr, r, lane, nullptr); continue; } r -= I_WO;
            if (r < NE * I_GU) { const int e = r / I_GU; p0_transpose_item_fp8<1>(a->w_gu + (size_t)e * D * 2048, 2048, (unsigned char*)Wgu_t + (size_t)e * 2048 * D, D, scr, r % I_GU, lane, a->ffn_norm_w, FP8_SW); continue; } r -= NE * I_GU;
            { const int e = r / I_DN; p0_transpose_item_fp8<0>(a->w_down + (size_t)e * FF * D, D, (unsigned char*)Wd_t + (size_t)e * D * FF, FF, scr, r % I_DN, lane, nullptr, FP8_SW); }
        }
        for (int idx = gtid; idx < 512 * 1024; idx += gsz) {
            const int n = idx & 1023, gc = idx >> 10, g = gc >> 7; float acc = 0.f;
            for (int d = 0; d < 128; ++d) acc += a->pool_w[(size_t)gc * 128 + d] * a->pool_scale[g * 128 + d] * a->w_out[(size_t)(512 + g * 128 + d) * 1024 + n];
            Wo_t[(size_t)n * 1024 + 512 + gc] = (bf16_t)f2bf(acc);
        }
        for (int idx = gtid; idx < T * 8; idx += gsz) {
            const int t = idx >> 3, j = idx & 7;
            const double inv = exp(-(double)(2 * j) / 16.0 * log(500000.0)); const double ang = (double)a->positions[t] * inv;
            rope[(size_t)t * 16 + j] = (float)cos(ang); rope[(size_t)t * 16 + 8 + j] = (float)sin(ang);
        }
        for (int row = gw; row < T; row += ngw) xbf_row(a->x + (size_t)row * D, XN + (size_t)row * D, WSP(float, WS_RSTD) + row, lane);
    }
    GRID_SYNC();
    { PHASE_IDX(); KArgP a = kargs(); unsigned char* ws = a->ws; bf16_t* Win_t = WSP(bf16_t, WS_WIN); bf16_t* XN = WSP(bf16_t, WS_XN); bf16_t* PROJ = WSP(bf16_t, WS_PROJ); const float* rope = WSP(float, WS_ROPE);
      pg8::DensePlan S; S.init(T, INW, G, bid); pg8::EpiBf16 E{PROJ, INW, rope, 4, WSP(float, WS_RSTD)}; pg8::gemm_phase<2048, false>(lds, XN, Win_t, S, E); }
    GRID_SYNC();
    {
        PHASE_IDX(); KArgP a = kargs(); unsigned char* ws = a->ws; bf16_t* PROJ = WSP(bf16_t, WS_PROJ); bf16_t* CAT = WSP(bf16_t, WS_CAT);
        const float lam = expf(wave_sum(a->lq1[lane] * a->lk1[lane])) - expf(wave_sum(a->lq2[lane] * a->lk2[lane])) + 0.2f;
        dattn::phase((char*)lds_raw, PROJ, CAT, lam, a->subln_w, G, bid);
        for (int item = gtid; item < (T / 32) * 64; item += gsz) {
            const int chunk = item & 63, tb = item >> 6, c0 = chunk * 8, w = 2 << (c0 >> 7), t0 = tb * 32, s0 = t0 % SEQ;
            const bf16_t* up = PROJ + (size_t)t0 * INW + 1536 + c0; bf16_t* op = CAT + (size_t)t0 * D + 512 + c0;
            float sum[8];
#pragma unroll
            for (int e = 0; e < 8; ++e) sum[e] = 0.f;
            if (s0 > 0) for (int i = 1; i < w; ++i) { const u32x4 v = *(const u32x4*)(up - (size_t)i * INW);
#pragma unroll
                for (int e = 0; e < 4; ++e) { sum[2 * e] += __uint_as_float(v[e] << 16); sum[2 * e + 1] += __uint_as_float(v[e] & 0xffff0000u); } }
            for (int tb8 = 0; tb8 < 32; tb8 += 8) {
                u32x4 vin[8], vout[8];
#pragma unroll
                for (int i = 0; i < 8; ++i) vin[i] = *(const u32x4*)(up + (size_t)(tb8 + i) * INW);
#pragma unroll
                for (int i = 0; i < 8; ++i) { const int tt = tb8 + i; const bool has = s0 + tt + 1 >= w; vout[i] = *(const u32x4*)(up + (size_t)(has ? tt - w + 1 : tt) * INW); }
                asm volatile("" ::: "memory");
#pragma unroll
                for (int i = 0; i < 8; ++i) { const int tt = tb8 + i; float f[8];
#pragma unroll
                    for (int e = 0; e < 4; ++e) { f[2 * e] = __uint_as_float(vin[i][e] << 16); f[2 * e + 1] = __uint_as_float(vin[i][e] & 0xffff0000u); }
                    const int s = s0 + tt; const float rn = 1.0f / (float)((s + 1 < w) ? s + 1 : w);
                    u32x4 o;
#pragma unroll
                    for (int e = 0; e < 4; ++e) { sum[2 * e] += f[2 * e]; sum[2 * e + 1] += f[2 * e + 1]; o[e] = pg8::cvt_pk_bf16(sum[2 * e] * rn - f[2 * e], sum[2 * e + 1] * rn - f[2 * e + 1]); }
                    *(u32x4*)(op + (size_t)tt * D) = o;
                    const float hm = (s + 1 >= w) ? 1.f : 0.f;
#pragma unroll
                    for (int e = 0; e < 4; ++e) { sum[2 * e] -= hm * __uint_as_float(vout[i][e] << 16); sum[2 * e + 1] -= hm * __uint_as_float(vout[i][e] & 0xffff0000u); } }
            }
        }
    }
    GRID_SYNC();
    { PHASE_IDX(); KArgP a = kargs(); unsigned char* ws = a->ws; bf16_t* Wo_t = WSP(bf16_t, WS_WO); bf16_t* CAT = WSP(bf16_t, WS_CAT);
      pg8::DensePlan S; S.init(T, D, G, bid); pg8::EpiResBf16 E{WSP(bf16_t, WS_XB), WSP(bf16_t, WS_XN), D}; pg8::gemm_phase<2048, false>(lds, CAT, Wo_t, S, E); }
    GRID_SYNC();
    { PHASE_IDX(); KArgP a = kargs(); unsigned char* ws = a->ws;
      rtr::phase(lds, WSP(bf16_t, WS_XB), a->ffn_norm_w, a->router_w, a->router_b, WSP(int, WS_CTL), WSP(int, WS_LTOK), WSP(float, WS_LGATE), WSP(int, WS_SLOT), WSP(unsigned char, WS_XN), G, bid); }
    GRID_SYNC();
    for (int ch = 0; ch < NCHUNK; ++ch) {
        PHASE_IDX(); KArgP a = kargs(); unsigned char* ws = a->ws; int* cnt = WSP(int, WS_CTL); int* ltok = WSP(int, WS_LTOK); float* lgate = WSP(float, WS_LGATE); int* slot = WSP(int, WS_SLOT); bf16_t* Wd_t = WSP(bf16_t, WS_WD); bf16_t* Wgu_t = WSP(bf16_t, WS_WGU); bf16_t* XN = WSP(bf16_t, WS_XN); bf16_t* HM = WSP(bf16_t, WS_HM); bf16_t* YP = WSP(bf16_t, WS_YP); float* out = a->out;
        const int* cc = cnt + ch * 32; const int* lt = ltok + (size_t)ch * 32 * TC; const float* lg = lgate + (size_t)ch * 32 * TC;
        { pg8::MoePlan<true> S = pg8::moe_plan_setup<true>(lds + pg8::STAGE_BYTES, cc, lt, 8, G, bid); pg8::EpiGLU E{HM, a->b_gu, 8}; pg8::gemm_phase<1024, true>(lds, XN, Wgu_t, S, E); }
        GRID_SYNC();
        { pg8::MoePlan<false> S = pg8::moe_plan_setup<false>(lds + pg8::STAGE_BYTES, cc, lt, 4, G, bid); pg8::EpiDown E{YP, a->b_down, 4}; pg8::gemm_phase<1024, true>(lds, HM, Wd_t, S, E); }
        GRID_SYNC();
        { LAS int* tb = (LAS int*)(lds + pg8::STAGE_BYTES);
          if (tid < 64) { int v = (lane < 32) ? (__hip_atomic_load(cc + (lane & 31), __ATOMIC_RELAXED, __HIP_MEMORY_SCOPE_AGENT) + TM - 1) / TM : 0, incl = v;
#pragma unroll
              for (int o = 1; o < 32; o <<= 1) { const int up = __shfl_up(incl, o); if (lane >= o) incl += up; }
              if (lane < 32) tb[lane] = (incl - v) * TM; }
          __syncthreads();
          for (int t = ch * TC + gw; t < (ch + 1) * TC; t += ngw) final_row(out, WSP(bf16_t, WS_XB), (const unsigned char*)YP, tb, slot, lg, a->final_w, t, lane);
          __syncthreads(); }
    }
}

extern "C" void kernel_launch(void* const* d_in, const int* in_sizes, int n_in, void* d_out, int out_size, void* d_ws, size_t ws_size, hipStream_t stream) {
    if (n_in != 20 || in_sizes[0] != T * D || out_size != T * D || ws_size < WS_END) { fprintf(stderr, "kernel_launch: unexpected shapes / workspace (%d, %d, %d, %zu)\n", n_in, n_in > 0 ? in_sizes[0] : -1, out_size, ws_size); return; }
    static int grid_blocks = 0;
    if (!grid_blocks) {
        int dev = 0, cus = 0, per_cu = 0;
        (void)hipGetDevice(&dev); (void)hipDeviceGetAttribute(&cus, hipDeviceAttributeMultiprocessorCount, dev);
        (void)hipFuncSetAttribute((const void*)mega_fwd, hipFuncAttributeMaxDynamicSharedMemorySize, MK_LDS);
        (void)hipOccupancyMaxActiveBlocksPerMultiprocessor(&per_cu, (const void*)mega_fwd, NTHREADS, MK_LDS);
        if (per_cu < 1) { fprintf(stderr, "kernel_launch: occupancy query says %d blocks per CU\n", per_cu); per_cu = 1; }
        grid_blocks = cus * 1;
        if (grid_blocks % 8 != 0) grid_blocks -= grid_blocks % 8;
    }
    (void)hipMemsetAsync((char*)d_ws + WS_BAR, 0, XCD_BAR_WORDS * 4, stream);
    MArgs a{};
    a.x = (const float*)d_in[0]; a.positions = (const int*)d_in[1]; a.attn_norm_w = (const float*)d_in[2]; a.w_in = (const float*)d_in[3];
    a.lq1 = (const float*)d_in[4]; a.lk1 = (const float*)d_in[5]; a.lq2 = (const float*)d_in[6]; a.lk2 = (const float*)d_in[7];
    a.subln_w = (const float*)d_in[8]; a.pool_w = (const float*)d_in[9]; a.pool_scale = (const float*)d_in[10]; a.w_out = (const float*)d_in[11];
    a.ffn_norm_w = (const float*)d_in[12]; a.router_w = (const float*)d_in[13]; a.router_b = (const float*)d_in[14];
    a.w_gu = (const float*)d_in[15]; a.b_gu = (const float*)d_in[16]; a.w_down = (const float*)d_in[17]; a.b_down = (const float*)d_in[18]; a.final_w = (const float*)d_in[19];
    a.out = (float*)d_out; a.ws = (unsigned char*)d_ws;
    void* args[] = {&a};
    hipError_t e = hipLaunchCooperativeKernel((const void*)mega_fwd, dim3(grid_blocks), dim3(NTHREADS), args, MK_LDS, stream);
    if (e != hipSuccess) fprintf(stderr, "cooperative launch failed: %s (grid %d)\n", hipGetErrorString(e), grid_blocks);
}
```

```cpp
#include <hip/hip_runtime.h>
#include <cstdint>
#include <cstdio>

typedef unsigned short bf16_t;
typedef short bf16x8 __attribute__((ext_vector_type(8)));
typedef float f32x4 __attribute__((ext_vector_type(4)));
typedef unsigned u32x4 __attribute__((ext_vector_type(4)));

constexpr int T = 65536, D = 1024, SEQ = 2048, INW = 2048, NE = 32, FF = 1024, TOPK = 4;
constexpr int NCHUNK = 1, TC = T / NCHUNK;
constexpr int TM = 256;
constexpr int PC = TC * TOPK + NE * TM;
constexpr float EPS = 1e-5f;

constexpr size_t MiB = 1u << 20;
constexpr size_t WS_CTL = 0;
constexpr size_t WS_RSTD = 524288;
constexpr size_t WS_RTAB = 786432;
constexpr size_t WS_BAR = 65536;
constexpr size_t WS_LTOK = 1 * MiB;
constexpr size_t WS_LGATE = 9 * MiB;
constexpr size_t WS_SLOT = 17 * MiB;
constexpr size_t WS_ROPE = 18 * MiB;
constexpr size_t WS_WIN = 22 * MiB;
constexpr size_t WS_WO = 26 * MiB;
constexpr size_t WS_WD = 28 * MiB;
constexpr size_t WS_WGU = 92 * MiB;
constexpr size_t WS_XN = 220 * MiB;
constexpr size_t WS_PROJ = 348 * MiB;
constexpr size_t WS_CAT = 604 * MiB;
constexpr size_t WS_HM = 348 * MiB;
constexpr size_t WS_YP = 612 * MiB;
constexpr size_t WS_XB = 876 * MiB;
constexpr size_t WS_END = 1004 * MiB;
static_assert(WS_HM + (size_t)PC * 1024 <= WS_YP && WS_YP + (size_t)PC * 1024 <= WS_XB && WS_XB + (size_t)T * 1024 * 2 <= WS_END && WS_CAT + (size_t)T * 1024 * 2 <= WS_XB, "ws map");

__device__ __forceinline__ int otid() { int t = threadIdx.x; asm volatile("" : "+v"(t)); return t; }
__device__ __forceinline__ unsigned f2bf(float f) { unsigned u = __float_as_uint(f); return (u + 0x7fffu + ((u >> 16) & 1u)) >> 16; }
__device__ __forceinline__ unsigned pk4_fp8(float a, float b, float c, float d) {
    unsigned w = 0; w = __builtin_amdgcn_cvt_pk_fp8_f32(a, b, w, false); w = __builtin_amdgcn_cvt_pk_fp8_f32(c, d, w, true); return w; }
__device__ __forceinline__ unsigned pk4_fp8_nc(float a, float b, float c, float d) { unsigned w = 0; w = __builtin_amdgcn_cvt_pk_fp8_f32(a, b, w, false); w = __builtin_amdgcn_cvt_pk_fp8_f32(c, d, w, true); return w; }
constexpr float FP8_SX = 16.f, FP8_SW = 512.f, FP8_SH = 4.f, FP8_SY = 32.f;
__device__ __forceinline__ float bf2f(unsigned h) { return __uint_as_float(h << 16); }
__device__ __forceinline__ float wave_sum(float v) {
#pragma unroll
    for (int o = 1; o < 64; o <<= 1) v += __shfl_xor(v, o);
    return v;
}
__device__ __forceinline__ float wave_max(float v) {
#pragma unroll
    for (int o = 1; o < 64; o <<= 1) v = fmaxf(v, __shfl_xor(v, o));
    return v;
}

namespace pg8 {
#define PG8_LAS __attribute__((address_space(3)))
constexpr int BM = 256, BK = 64, HALF = 128, HTB = HALF * BK * 2  , STAGE_BYTES = 8 * HTB;
constexpr int MAXU = 36, PLAN_BYTES = MAXU * 32 + MAXU * 512, EPI_LDS = STAGE_BYTES + PLAN_BYTES + 64;
__host__ __device__ __forceinline__ int lds_byte(int r, int c) { return r * 128 + ((((c >> 3) ^ ((r >> 1) & 7))) << 4); }
__host__ __device__ __forceinline__ void stage_rc(int b, int& R, int& C) { R = b >> 7; C = ((((b >> 4) & 7) ^ ((R >> 1) & 7))) << 3; }
__host__ __device__ __forceinline__ int perm32(int rho) { const int n = rho >> 4, i = rho & 15; return 8 * (i >> 2) + 4 * n + (i & 3); }
__device__ __forceinline__ unsigned cvt_pk_bf16(float lo, float hi) { unsigned r; asm volatile("v_cvt_pk_bf16_f32 %0, %1, %2" : "=v"(r) : "v"(lo), "v"(hi)); return r; }

template <int IMM = 0>
__device__ __forceinline__ void glds16s(const void* sbase, unsigned voff, unsigned lds_dst) { unsigned keep;
    asm volatile("s_mov_b32 %0, m0\n\ts_mov_b32 m0, %3\n\ts_nop 0\n\tglobal_load_lds_dwordx4 %1, %2 offset:%4\n\ts_mov_b32 m0, %0" : "=&s"(keep) : "v"(voff), "s"(sbase), "s"(lds_dst), "i"(IMM) : "memory"); }
typedef int v4i_t __attribute__((ext_vector_type(4)));
typedef int v8i_t __attribute__((ext_vector_type(8)));
__device__ __forceinline__ v8i_t cat8(bf16x8 lo, bf16x8 hi) { return __builtin_shufflevector(__builtin_bit_cast(v4i_t, lo), __builtin_bit_cast(v4i_t, hi), 0, 1, 2, 3, 4, 5, 6, 7); }
__device__ __forceinline__ void mfma_fp8_inplace(f32x4& acc, v8i_t a, v8i_t b) {
    asm volatile("v_mfma_scale_f32_16x16x128_f8f6f4 %0, %1, %2, %0, %3, %3 op_sel_hi:[0,0,0]" : "+v"(acc) : "v"(a), "v"(b), "v"(0x7F7F7F7F)); }
struct Unit { int pm, pn, e, lt, ne; };

template <int ROWB, bool FP8, class Epi, class Plan>
__device__ __forceinline__ void gemm_phase(PG8_LAS unsigned char* lds, const bf16_t* gA_, const bf16_t* gBt_, const Plan& S, const Epi& E) {
    const int tid = otid(), wid = __builtin_amdgcn_readfirstlane(tid >> 6), lane = tid & 63, wr = wid >> 2, wc = wid & 3, fr = lane & 15, fq = lane >> 4;
    constexpr int nt = ROWB / 128;
    unsigned voffB[2];
#pragma unroll
    for (int i = 0; i < 2; ++i) { int R, C; stage_rc(tid * 16 + i * 8192, R, C); const int Rb = Epi::PERM ? ((R & ~31) + perm32(R & 31)) : R; voffB[i] = (unsigned)(Rb * ROWB + C * 2); }
    const size_t kstep = (size_t)(BK * 2);
    const size_t hstep = (size_t)HALF * ROWB;
    const size_t tstep = 2 * hstep;
    const unsigned ldsb_epi0 = (unsigned)__builtin_amdgcn_readfirstlane((unsigned)(__UINTPTR_TYPE__)lds + (unsigned)EPI_LDS);
    const unsigned ldsb = (unsigned)__builtin_amdgcn_readfirstlane((unsigned)(__UINTPTR_TYPE__)lds + (unsigned)wid * 1024u);
    const int aoff0 = lds_byte(wr * 64 + fr, fq * 8), aoff1 = lds_byte(wr * 64 + fr, 32 + fq * 8), boff0 = lds_byte(wc * 32 + fr, fq * 8), boff1 = lds_byte(wc * 32 + fr, 32 + fq * 8);
#define PG8_SA(b, h) (((b) * 2 + (h)) * HTB)
#define PG8_SB(b, h) ((4 + (b) * 2 + (h)) * HTB)
#define PG8_STAGE(bufoff, gbase, voff) do { _Pragma("unroll") for (int _i = 0; _i < 2; ++_i) glds16s<0>((gbase), (voff)[_i], ldsb + (unsigned)((bufoff) + _i * 8192)); } while (0)
#define PG8_STAGEK(bufoff, gbase, voff) do { _Pragma("unroll") for (int _i = 0; _i < 2; ++_i) glds16s<BK * 2>((gbase), (voff)[_i], ldsb + (unsigned)((bufoff) + _i * 8192)); } while (0)
#define PG8_LDA(dst, b, h) do { _Pragma("unroll") for (int m = 0; m < 4; ++m) { \
        if constexpr (FP8) dst##8[m] = cat8(*(const PG8_LAS bf16x8*)(lds + PG8_SA(b, h) + aoff0 + m * 2048), *(const PG8_LAS bf16x8*)(lds + PG8_SA(b, h) + aoff1 + m * 2048)); \
        else { dst[m][0] = *(const PG8_LAS bf16x8*)(lds + PG8_SA(b, h) + aoff0 + m * 2048); dst[m][1] = *(const PG8_LAS bf16x8*)(lds + PG8_SA(b, h) + aoff1 + m * 2048); } } } while (0)
#define PG8_LDB(dst, b, h) do { _Pragma("unroll") for (int n = 0; n < 2; ++n) { \
        if constexpr (FP8) dst##8[n] = cat8(*(const PG8_LAS bf16x8*)(lds + PG8_SB(b, h) + boff0 + n * 2048), *(const PG8_LAS bf16x8*)(lds + PG8_SB(b, h) + boff1 + n * 2048)); \
        else { dst[n][0] = *(const PG8_LAS bf16x8*)(lds + PG8_SB(b, h) + boff0 + n * 2048); dst[n][1] = *(const PG8_LAS bf16x8*)(lds + PG8_SB(b, h) + boff1 + n * 2048); } } } while (0)
#define PG8_MMA(ai, bj, At, Bt) do { __builtin_amdgcn_s_setprio(1); _Pragma("unroll") for (int m = 0; m < 4; ++m) _Pragma("unroll") for (int n = 0; n < 2; ++n) { \
        if constexpr (FP8) mfma_fp8_inplace(acc[ai][bj][m][n], Bt##8[n], At##8[m]); \
        else { _Pragma("unroll") for (int k = 0; k < 2; ++k) acc[ai][bj][m][n] = __builtin_amdgcn_mfma_f32_16x16x32_bf16(Bt[n][k], At[m][k], acc[ai][bj][m][n], 0, 0, 0); } } \
        __builtin_amdgcn_s_setprio(0); } while (0)
#define PG8_WAIT_V(n) asm volatile("s_waitcnt vmcnt(" #n ")" ::: "memory")
#define PG8_WAIT_L(n) asm volatile("s_waitcnt lgkmcnt(" #n ")" ::: "memory")
#define PG8_BAR __builtin_amdgcn_s_barrier()
#define PG8_SCHED __builtin_amdgcn_sched_barrier(0)
#define PG8_VOFF(dst, U, UI) do { const int _tv = otid(); _Pragma("unroll") for (int _i = 0; _i < 2; ++_i) { int _R, _C; stage_rc(_tv * 16 + _i * 8192, _R, _C); \
        _Pragma("unroll") for (int _h = 0; _h < 2; ++_h) dst[_h][_i] = S.rowA(U, UI, _h * HALF + _R) * (unsigned)ROWB + (unsigned)(_C * 2); } } while (0)
#define PG8_SP1A(A1) do { \
          \
        PG8_LDB(B0, 0, 0); PG8_LDB(B1, 0, 1); PG8_SCHED; PG8_LDA(At, 0, 0); PG8_STAGE(PG8_SA(1, 1), (A1), vc[1]); \
        PG8_WAIT_V(8); PG8_WAIT_L(0); PG8_BAR; PG8_MMA(0, 0, At, B0); PG8_MMA(0, 1, At, B1); PG8_BAR; PG8_SCHED; } while (0)
#define PG8_REST(A2, B2) do { \
          \
        PG8_LDA(At, 0, 1); PG8_STAGE(PG8_SB(0, 0), (B2), voffB); PG8_STAGE(PG8_SB(0, 1), (B2) + hstep, voffB); PG8_STAGE(PG8_SA(0, 0), (A2), vc[0]); \
        PG8_WAIT_V(8); PG8_WAIT_L(0); PG8_BAR; PG8_MMA(1, 0, At, B0); PG8_MMA(1, 1, At, B1); PG8_BAR; PG8_SCHED; \
          \
        PG8_LDB(B0, 1, 0); PG8_LDB(B1, 1, 1); PG8_SCHED; PG8_LDA(At, 1, 0); PG8_STAGE(PG8_SA(0, 1), (A2), vc[1]); \
        PG8_WAIT_V(8); PG8_WAIT_L(0); PG8_BAR; PG8_MMA(0, 0, At, B0); PG8_MMA(0, 1, At, B1); PG8_BAR; PG8_SCHED; \
          \
        PG8_LDA(At, 1, 1); PG8_STAGE(PG8_SB(1, 0), (B2) + kstep, voffB); PG8_STAGE(PG8_SB(1, 1), (B2) + kstep + hstep, voffB); PG8_STAGE(PG8_SA(1, 0), (A2) + kstep, vc[0]); \
        PG8_WAIT_V(8); PG8_WAIT_L(0); PG8_BAR; PG8_MMA(1, 0, At, B0); PG8_MMA(1, 1, At, B1); PG8_BAR; PG8_SCHED; } while (0)
    Unit cur, nxt; int ui = 0;
    if (!S.next(0, cur)) return;
    f32x4 acc[2][2][4][2];
#pragma unroll
    for (int a = 0; a < 2; ++a)
#pragma unroll
        for (int b = 0; b < 2; ++b)
#pragma unroll
            for (int m = 0; m < 4; ++m)
#pragma unroll
                for (int n = 0; n < 2; ++n) acc[a][b][m][n] = (f32x4){0.f, 0.f, 0.f, 0.f};
    bf16x8 At[4][2], B0[2][2], B1[2][2]; v8i_t At8[4], B08[2], B18[2];
    unsigned vc[2][2];
    PG8_VOFF(vc, cur, 0);
    if (wid == 0) E.prefetch(cur, ldsb_epi0, lane);
    const char* gA = (const char*)gA_; const char* cB = (const char*)gBt_ + (size_t)cur.pn * tstep;
    PG8_STAGE(PG8_SB(0, 0), cB, voffB); PG8_STAGE(PG8_SB(0, 1), cB + hstep, voffB); PG8_STAGE(PG8_SA(0, 0), gA, vc[0]); PG8_STAGE(PG8_SA(0, 1), gA, vc[1]);
    if (wr == 1) PG8_BAR;
    PG8_WAIT_V(2); PG8_BAR;
    PG8_STAGE(PG8_SB(1, 0), cB + kstep, voffB); PG8_STAGE(PG8_SA(1, 0), gA + kstep, vc[0]); PG8_STAGE(PG8_SB(1, 1), cB + hstep + kstep, voffB);
    PG8_WAIT_V(6); PG8_BAR;
    for (;;) {
        const bool has_next = S.next(ui + 1, nxt);
        const char* nB = has_next ? (const char*)gBt_ + (size_t)nxt.pn * tstep : cB;
#pragma clang loop unroll(disable)
        for (int t = 0; t < nt - 2; t += 2) { asm volatile(".p2align 3\n\ts_nop 0" ::: "memory"); PG8_SP1A(gA + (size_t)(t + 1) * kstep); PG8_REST(gA + (size_t)(t + 2) * kstep, cB + (size_t)(t + 2) * kstep); }
        PG8_SP1A(gA + (size_t)(nt - 1) * kstep);
        if (has_next) PG8_VOFF(vc, nxt, ui + 1);
        PG8_REST(gA, nB);
        if constexpr (FP8) {
            asm volatile("s_nop 15\n\ts_nop 15" ::: "memory");
#pragma unroll
            for (int a = 0; a < 2; ++a)
#pragma unroll
                for (int b = 0; b < 2; ++b)
#pragma unroll
                    for (int m = 0; m < 4; ++m)
#pragma unroll
                        for (int n = 0; n < 2; ++n) asm volatile("" : "+v"(acc[a][b][m][n]));
        }
        if (wr == 0) PG8_BAR;
        E(acc, cur, lds + EPI_LDS + (ui & 1) * 1024);
        if (!has_next) break;
#pragma unroll
        for (int a = 0; a < 2; ++a)
#pragma unroll
            for (int b = 0; b < 2; ++b)
#pragma unroll
                for (int m = 0; m < 4; ++m)
#pragma unroll
                    for (int n = 0; n < 2; ++n) acc[a][b][m][n] = (f32x4){0.f, 0.f, 0.f, 0.f};
        cur = nxt; cB = nB; ++ui;
        if (wid == 0) E.prefetch(cur, ldsb_epi0 + (unsigned)((ui & 1) * 1024), lane);
        if (wr == 1) PG8_BAR;
    }
    PG8_WAIT_V(0);
    PG8_BAR;
#undef PG8_SA
#undef PG8_SB
#undef PG8_STAGE
#undef PG8_STAGEK
#undef PG8_LDA
#undef PG8_LDB
#undef PG8_MMA
#undef PG8_WAIT_V
#undef PG8_WAIT_L
#undef PG8_BAR
#undef PG8_SCHED
#undef PG8_VOFF
#undef PG8_SP1A
#undef PG8_REST
}

struct DensePlan {
    int nM, nN, nwg, G, c;
    __device__ void init(int M, int N, int G_, int c_) { nM = M / BM; nN = N / BM; nwg = nM * nN; G = G_; c = c_; }
    __device__ __forceinline__ bool next(int i, Unit& u) const {
        const long L = (long)i * G + c; if (L >= nwg) return false;
        int wgid = (int)L; { const int q = nwg / 8, r = nwg % 8, xcd = wgid % 8, off = wgid / 8; wgid = (xcd < r ? xcd * (q + 1) : r * (q + 1) + (xcd - r) * q) + off; }
        const int nig = 8 * nN, gid = wgid / nig, fm = gid * 8, gsz = (nM - fm) < 8 ? (nM - fm) : 8;
        u.pm = fm + ((wgid % nig) % gsz); u.pn = (wgid % nig) / gsz; u.e = 0; u.lt = 0; u.ne = 0; return true;
    }
    __device__ __forceinline__ unsigned rowA(const Unit& u, int, int r) const { return (unsigned)(u.pm * BM + r); }
};
template <bool GATHER>
struct MoePlan {
    const PG8_LAS int* desc; const PG8_LAS unsigned short* rowtab;
    __device__ __forceinline__ bool next(int i, Unit& u) const {
        if (i >= MAXU) return false;
        const PG8_LAS int* d = desc + i * 8;
        const int v = __builtin_amdgcn_readfirstlane(d[0]); u.pm = __builtin_amdgcn_readfirstlane(d[1]); u.pn = __builtin_amdgcn_readfirstlane(d[2]);
        u.e = __builtin_amdgcn_readfirstlane(d[3]); u.lt = __builtin_amdgcn_readfirstlane(d[4]); u.ne = __builtin_amdgcn_readfirstlane(d[5]); return v != 0;
    }
    __device__ __forceinline__ unsigned rowA(const Unit& u, int ui, int r) const { return GATHER ? (unsigned)rowtab[ui * 256 + r] : (unsigned)(u.pm * BM + r); }
};
template <bool GATHER>
__device__ __forceinline__ MoePlan<GATHER> moe_plan_setup(PG8_LAS unsigned char* tab, const int* cnt, const int* ltok, int NT, int G, int c) {
    PG8_LAS int* desc = (PG8_LAS int*)tab; PG8_LAS unsigned short* rowtab = (PG8_LAS unsigned short*)(tab + MAXU * 32);
    PG8_LAS int* cs = (PG8_LAS int*)rowtab;
    PG8_LAS int* bs = cs + 32;
    const int tid = otid(), xcd = c & 7, j = c >> 3;
    if (tid < 32) cs[tid] = __hip_atomic_load(cnt + tid, __ATOMIC_RELAXED, __HIP_MEMORY_SCOPE_AGENT);
    __syncthreads();
    if (tid < 64) { const int ln = tid & 63; int v = (ln < 32) ? (cs[ln & 31] + BM - 1) / BM : 0, incl = v;
#pragma unroll
        for (int o = 1; o < 32; o <<= 1) { const int up = __shfl_up(incl, o); if (ln >= o) incl += up; }
        if (ln < 32) bs[ln] = incl - v; if (ln == 31) bs[32] = incl; }
    __syncthreads();
    if (tid < MAXU) {
        const int q = tid * (G >> 3) + j, mt = (q / NT) * 8 + xcd, pnl = q % NT;
        int e = -1;
        for (int k = 0; k < 32; ++k) if (mt >= bs[k] && mt < bs[k + 1]) e = k;
        desc[tid * 8 + 0] = e >= 0 ? 1 : 0; desc[tid * 8 + 1] = mt; desc[tid * 8 + 2] = (e >= 0 ? e : 0) * NT + pnl; desc[tid * 8 + 3] = e;
        desc[tid * 8 + 4] = e >= 0 ? mt - bs[e] : 0; desc[tid * 8 + 5] = e >= 0 ? cs[e] : 0;
    }
    __syncthreads();
    if (GATHER) {
        constexpr int PER = MAXU / 2; const int rw_ = tid & 255, ih = tid >> 8;
        int gi[PER], tk[PER];
#pragma unroll
        for (int k = 0; k < PER; ++k) { const PG8_LAS int* d = desc + (2 * k + ih) * 8; const int valid = d[0], e = d[3], lt = d[4], ne = d[5];
            const int p = lt * BM + rw_; gi[k] = (valid && p < ne) ? e * TC + p : -1; }
#pragma unroll
        for (int k = 0; k < PER; ++k) tk[k] = ltok[gi[k] < 0 ? 0 : gi[k]];
#pragma unroll
        for (int k = 0; k < PER; ++k) rowtab[(2 * k + ih) * 256 + rw_] = (unsigned short)(gi[k] < 0 ? 0 : tk[k]);
    }
    __syncthreads();
    MoePlan<GATHER> S; S.desc = desc; S.rowtab = rowtab; return S;
}

struct EpiBf16 {
    __device__ __forceinline__ void prefetch(const Unit& u, unsigned lds_dst, int lane) const { glds16s<0>(rstd + (size_t)u.pm * BM, (unsigned)(lane * 16), lds_dst); }
    static constexpr bool PERM = true;
    bf16_t* O; int ldc; const float* rope; int rope_tiles; const float* rstd;
    __device__ __forceinline__ void operator()(const f32x4 (&acc)[2][2][4][2], const Unit& u, const PG8_LAS unsigned char* el) const {
        const int tv_ = otid();
        const int wr = tv_ >> 8, wc = (tv_ >> 6) & 3, fr = tv_ & 15, fq = (tv_ >> 4) & 3;
        const int row0 = u.pm * BM + wr * 64 + fr, col0 = u.pn * BM + wc * 64 + 8 * fq;
        const bool rtile = u.pn < rope_tiles;
#pragma unroll
        for (int ai = 0; ai < 2; ++ai) {
            f32x4 rc[4][4];
            if (rtile) {
                if (fq < 2) {
#pragma unroll
                    for (int m = 0; m < 4; ++m) { const float* rp = rope + (size_t)(row0 + ai * HALF + m * 16) * 16;
#pragma unroll
                        for (int q = 0; q < 4; ++q) rc[m][q] = *(const f32x4*)(rp + 4 * q); }
                }
                asm volatile("" ::: "memory");
            }
#pragma unroll
            for (int m = 0; m < 4; ++m) { const int row = row0 + ai * HALF + m * 16; bf16_t* rowp = O + (size_t)row * ldc + col0;
                const float rsd = ((const PG8_LAS float*)el)[wr * 64 + fr + ai * HALF + m * 16];
                f32x4 a0 = acc[ai][0][m][0] * rsd, a1 = acc[ai][0][m][1] * rsd; const f32x4 b0 = acc[ai][1][m][0] * rsd, b1 = acc[ai][1][m][1] * rsd;
                if (rtile) { f32x4 p0, p1;
#pragma unroll
                    for (int j = 0; j < 4; ++j) { p0[j] = __shfl_xor(a0[j], 16); p1[j] = __shfl_xor(a1[j], 16); }
                    if (fq < 2) { f32x4 sn0 = rc[m][2], sn1 = rc[m][3]; if (fq == 0) { sn0 = -sn0; sn1 = -sn1; }
                        a0 = a0 * rc[m][0] + p0 * sn0; a1 = a1 * rc[m][1] + p1 * sn1; } }
                u32x4 w0, w1;
                w0.x = cvt_pk_bf16(a0[0], a0[1]); w0.y = cvt_pk_bf16(a0[2], a0[3]); w0.z = cvt_pk_bf16(a1[0], a1[1]); w0.w = cvt_pk_bf16(a1[2], a1[3]);
                w1.x = cvt_pk_bf16(b0[0], b0[1]); w1.y = cvt_pk_bf16(b0[2], b0[3]); w1.z = cvt_pk_bf16(b1[0], b1[1]); w1.w = cvt_pk_bf16(b1[2], b1[3]);
                *(u32x4*)rowp = w0; *(u32x4*)(rowp + 32) = w1; }
        }
    }
};
struct EpiResBf16 {
    __device__ __forceinline__ void prefetch(const Unit&, unsigned, int) const {}
    static constexpr bool PERM = true;
    bf16_t* XB; const bf16_t* resid; int ldc;
    __device__ __forceinline__ void operator()(const f32x4 (&acc)[2][2][4][2], const Unit& u, const PG8_LAS unsigned char* el) const {
        const int tv_ = otid();
        const int wr = tv_ >> 8, wc = (tv_ >> 6) & 3, fr = tv_ & 15, fq = (tv_ >> 4) & 3;
        const int row0 = u.pm * BM + wr * 64 + fr, col0 = u.pn * BM + wc * 64 + 8 * fq;
        u32x4 xr[2][4][2];
#pragma unroll
        for (int ai = 0; ai < 2; ++ai)
#pragma unroll
            for (int m = 0; m < 4; ++m)
#pragma unroll
                for (int bj = 0; bj < 2; ++bj) xr[ai][m][bj] = *(const u32x4*)(resid + (size_t)(row0 + ai * HALF + m * 16) * ldc + col0 + bj * 32);
        asm volatile("" ::: "memory");
#pragma unroll
        for (int ai = 0; ai < 2; ++ai)
#pragma unroll
            for (int m = 0; m < 4; ++m) { const size_t off = (size_t)(row0 + ai * HALF + m * 16) * ldc + col0;
#pragma unroll
                for (int bj = 0; bj < 2; ++bj) { const u32x4 x4 = xr[ai][m][bj];
                    const f32x4 v0 = (f32x4){__uint_as_float(x4.x << 16), __uint_as_float(x4.x & 0xffff0000u), __uint_as_float(x4.y << 16), __uint_as_float(x4.y & 0xffff0000u)} + acc[ai][bj][m][0],
                                v1 = (f32x4){__uint_as_float(x4.z << 16), __uint_as_float(x4.z & 0xffff0000u), __uint_as_float(x4.w << 16), __uint_as_float(x4.w & 0xffff0000u)} + acc[ai][bj][m][1];
                    u32x4 w; w.x = cvt_pk_bf16(v0[0], v0[1]); w.y = cvt_pk_bf16(v0[2], v0[3]); w.z = cvt_pk_bf16(v1[0], v1[1]); w.w = cvt_pk_bf16(v1[2], v1[3]);
                    *(u32x4*)(XB + off + bj * 32) = w; } }
    }
};
struct EpiGLU {
    static constexpr bool PERM = true;
    bf16_t* HM; const float* b_gu; int NT;
    __device__ __forceinline__ void prefetch(const Unit& u, unsigned lds_dst, int lane) const {
        const int pnl = u.pn - u.e * NT; glds16s<0>(b_gu + (size_t)u.e * 2048 + pnl * HALF, (unsigned)((lane & 31) * 16 + (lane >> 5) * 4096), lds_dst); }
    __device__ __forceinline__ void operator()(const f32x4 (&acc)[2][2][4][2], const Unit& u, const PG8_LAS unsigned char* el) const {
        const int tv_ = otid();
        const int wr = tv_ >> 8, wc = (tv_ >> 6) & 3, fr = tv_ & 15, fq = (tv_ >> 4) & 3;
        const int pnl = u.pn - u.e * NT, f0 = pnl * HALF + wc * 32 + 8 * fq, row0 = u.pm * BM + wr * 64 + fr;
        const PG8_LAS float* bl = (const PG8_LAS float*)el + wc * 32 + 8 * fq;
        f32x4 bg4[2], bu1[2];
#pragma unroll
        for (int n = 0; n < 2; ++n) { bg4[n] = *(const PG8_LAS f32x4*)(bl + 4 * n) * FP8_SH; bu1[n] = *(const PG8_LAS f32x4*)(bl + 128 + 4 * n) + 1.0f; }
        constexpr float rs = 1.0f / (FP8_SX * FP8_SW), rs4 = rs * FP8_SH, ec = -1.702f * 1.4426950408889634f / FP8_SH;
#pragma unroll
        for (int ai = 0; ai < 2; ++ai) { unsigned pkm[4][2];
#pragma unroll
            for (int m = 0; m < 4; ++m) { unsigned* pk = pkm[m];
#pragma unroll
                for (int n = 0; n < 2; ++n) {
                    f32x4 g4 = acc[ai][0][m][n] * rs4 + bg4[n], u1 = acc[ai][1][m][n] * rs + bu1[n];
#pragma unroll
                    for (int j = 0; j < 4; ++j) { g4[j] = fminf(g4[j], 7.0f * FP8_SH); u1[j] = __builtin_amdgcn_fmed3f(u1[j], -6.0f, 8.0f); }
                    f32x4 ea = g4 * ec, den;
#pragma unroll
                    for (int j = 0; j < 4; ++j) den[j] = __builtin_amdgcn_exp2f(ea[j]);
                    den = den + 1.0f;
                    f32x4 h4 = u1 * g4;
#pragma unroll
                    for (int j = 0; j < 4; ++j) den[j] = __builtin_amdgcn_rcpf(den[j]);
                    h4 = h4 * den;
                    pk[n] = pk4_fp8_nc(h4[0], h4[1], h4[2], h4[3]); }
            }
#pragma unroll
            for (int mp = 0; mp < 4; mp += 2) {
                const auto r0 = __builtin_amdgcn_permlane16_swap(pkm[mp][0], pkm[mp + 1][0], false, false), r1 = __builtin_amdgcn_permlane16_swap(pkm[mp][1], pkm[mp + 1][1], false, false);
                const u32x4 w = {r0[0], r1[0], r0[1], r1[1]};
                *(u32x4*)((unsigned char*)HM + (size_t)(row0 + ai * HALF + (mp + (fq & 1)) * 16) * FF + pnl * HALF + wc * 32 + 16 * (fq >> 1)) = w; }
        }
    }
};
struct EpiDown {
    static constexpr bool PERM = true;
    bf16_t* YP; const float* b_d; int NT;
    __device__ __forceinline__ void prefetch(const Unit& u, unsigned lds_dst, int lane) const {
        const int pnl = u.pn - u.e * NT; glds16s<0>(b_d + (size_t)u.e * 1024 + pnl * BM, (unsigned)(lane * 16), lds_dst); }
    __device__ __forceinline__ void operator()(const f32x4 (&acc)[2][2][4][2], const Unit& u, const PG8_LAS unsigned char* el) const {
        const int tv_ = otid();
        const int wr = tv_ >> 8, wc = (tv_ >> 6) & 3, fr = tv_ & 15, fq = (tv_ >> 4) & 3;
        const int pnl = u.pn - u.e * NT, col0 = pnl * BM + wc * 64 + 16 * fq, rl0 = wr * 64 + fr;
        const PG8_LAS float* bl = (const PG8_LAS float*)el + wc * 64 + 16 * fq;
        f32x4 bv[2][2];
#pragma unroll
        for (int bj = 0; bj < 2; ++bj)
#pragma unroll
            for (int n = 0; n < 2; ++n) bv[bj][n] = *(const PG8_LAS f32x4*)(bl + bj * 8 + 4 * n) * FP8_SY;
        constexpr float sa = FP8_SY / (FP8_SH * FP8_SW);
#pragma unroll
        for (int ai = 0; ai < 2; ++ai)
#pragma unroll
            for (int m = 0; m < 4; ++m) { const int rl = rl0 + ai * HALF + m * 16;
                unsigned char* rowp = (unsigned char*)YP + (size_t)(u.pm * BM + rl) * D + col0;
                u32x4 w;
#pragma unroll
                for (int bj = 0; bj < 2; ++bj) { const f32x4 v0 = acc[ai][bj][m][0] * sa + bv[bj][0], v1 = acc[ai][bj][m][1] * sa + bv[bj][1];
                    w[2 * bj] = pk4_fp8(v0[0], v0[1], v0[2], v0[3]); w[2 * bj + 1] = pk4_fp8(v1[0], v1[1], v1[2], v1[3]); }
                *(u32x4*)rowp = w; }
    }
};
}


namespace dattn {
typedef float f32x16 __attribute__((ext_vector_type(16)));
typedef short s16x4 __attribute__((ext_vector_type(4)));
constexpr int NW = 8, QBLK = 32, KVBLK = 64, QB = NW * QBLK, DK = 64, DV = 128, RS = INW;
constexpr int SHM_V = KVBLK * DV * 2, SHM_K = KVBLK * DK * 2;
constexpr int NVB = 4;
constexpr int LDS_V = 0, LDS_K = NVB * SHM_V, LDS_WS = LDS_K + 2 * SHM_K, LDS_OST = LDS_WS + NW * 64 * 4, LDS_BYTES = LDS_OST + NW * 8192;
constexpr float SCALE = 0.125f, THR = 8.f;
#define KSWZ64(row, colB) ((row) * 128 + ((colB) ^ ((((row) >> 1) & 7) << 4)))
#define SBAR() __builtin_amdgcn_sched_barrier(0)
__device__ __forceinline__ int v_slot_key(int p) { const int kk = ((p >> 7) << 3) | ((p & 31) >> 2); return (kk & ~0xC) | ((kk & 4) << 1) | ((kk & 8) >> 1); }
__device__ __forceinline__ int v_slot_col(int p) { return ((p >> 5) & 3) * 32 + (p & 3) * 8; }
__device__ __forceinline__ int v_rd_base(int lane) { return ((lane & 3) << 3) | (((lane >> 2) & 3) << 6) | (((lane >> 4) & 1) << 5) | (((lane >> 5) & 1) << 8); }
constexpr int v_rd_off(int d0, int ks, int half) { return d0 * 512 + ks * 4096 + half * 2048; }
__device__ __forceinline__ int crow(int r, int hi) { return (r & 3) + 8 * (r >> 2) + 4 * hi; }
__device__ __forceinline__ unsigned cvtpk(float lo, float hi) { unsigned r; asm volatile("v_cvt_pk_bf16_f32 %0, %1, %2" : "=v"(r) : "v"(lo), "v"(hi)); return r; }
__device__ __forceinline__ bf16x8 load8(const bf16_t* p) { return *reinterpret_cast<const bf16x8*>(p); }
__device__ __forceinline__ void mask_tile(f32x16& p0, f32x16& p1, int dq) {
    const float NEG = -__builtin_inff();
#pragma unroll
    for (int r = 0; r < 16; ++r) { const int c = (r & 3) + 8 * (r >> 2); if (dq - c < 0) p0[r] = NEG; if (dq - c - 32 < 0) p1[r] = NEG; }
}
__device__ __forceinline__ void partialSM(f32x16& p0, f32x16& p1, float& m_reg, float& mn, float& alpha) {
    float pmax = p0[0];
#pragma unroll
    for (int r = 1; r < 16; ++r) pmax = fmaxf(pmax, p0[r]);
#pragma unroll
    for (int r = 0; r < 16; ++r) pmax = fmaxf(pmax, p1[r]);
    { auto rr = __builtin_amdgcn_permlane32_swap(__float_as_uint(pmax), __float_as_uint(pmax), false, false); pmax = fmaxf(__uint_as_float(rr[0]), __uint_as_float(rr[1])); }
    constexpr float C2 = 1.4426950408889634f * SCALE;
    if (__builtin_expect(__all((pmax - m_reg) * SCALE <= THR), 1)) { mn = m_reg; alpha = 1.f; }
    else { mn = fmaxf(m_reg, pmax); alpha = __builtin_amdgcn_exp2f((m_reg - mn) * C2); m_reg = mn; }
    const float mnL = -mn * C2;
    p0 = p0 * C2 + mnL; p1 = p1 * C2 + mnL;
#pragma unroll
    for (int r = 0; r < 16; ++r) p0[r] = __builtin_amdgcn_exp2f(p0[r]);
}
__device__ __forceinline__ void finishSM(f32x16& p0, f32x16& p1, float alpha, float& l_reg, bf16x8& pa0, bf16x8& pa1, bf16x8& pa2, bf16x8& pa3) {
#pragma unroll
    for (int r = 0; r < 16; ++r) p1[r] = __builtin_amdgcn_exp2f(p1[r]);
    float ps;
    { typedef float f32x8_ __attribute__((ext_vector_type(8))); typedef float f32x2_ __attribute__((ext_vector_type(2)));
      const f32x16 s16 = p0 + p1; const f32x8_ s8 = s16.lo + s16.hi; const f32x4 s4 = s8.lo + s8.hi; const f32x2_ s2 = s4.lo + s4.hi; ps = s2.x + s2.y; }
    { auto rr = __builtin_amdgcn_permlane32_swap(__float_as_uint(ps), __float_as_uint(ps), false, false); ps = __uint_as_float(rr[0]) + __uint_as_float(rr[1]); }
    l_reg = l_reg * alpha + ps;
#define PK4(P, B_, OUT) do { unsigned a0 = cvtpk(P[B_+0], P[B_+1]), a1 = cvtpk(P[B_+2], P[B_+3]);                          \
        unsigned b0 = cvtpk(P[B_+4], P[B_+5]), b1 = cvtpk(P[B_+6], P[B_+7]);                                             \
        auto r0 = __builtin_amdgcn_permlane32_swap(a0, b0, false, false); auto r1 = __builtin_amdgcn_permlane32_swap(a1, b1, false, false); \
        u32x4 w = {r0[0], r1[0], r0[1], r1[1]}; OUT = *reinterpret_cast<bf16x8*>(&w); } while (0)
    PK4(p0, 0, pa0); PK4(p0, 8, pa1); PK4(p1, 0, pa2); PK4(p1, 8, pa3);
#undef PK4
}
template <int KB>
__device__ __forceinline__ void qkt(f32x16& p0, f32x16& p1, const char* K_lds, int r32, int hi, const bf16x8* qr) {
    p0 = f32x16{}; p1 = f32x16{};
#pragma unroll
    for (int d0 = 0; d0 < 4; ++d0) { const char* a = K_lds + KB * SHM_K + KSWZ64(r32, (d0 * 16 + hi * 8) * 2);
        bf16x8 b0 = *reinterpret_cast<const bf16x8*>(a);
        bf16x8 b1 = *reinterpret_cast<const bf16x8*>(a + 32 * 128);
        p0 = __builtin_amdgcn_mfma_f32_32x32x16_bf16(b0, qr[d0], p0, 0, 0, 0);
        p1 = __builtin_amdgcn_mfma_f32_32x32x16_bf16(b1, qr[d0], p1, 0, 0, 0); }
}
template <int VB>
__device__ __forceinline__ void pv_tile(f32x16* o, int vb0, bf16x8 pa0, bf16x8 pa1, bf16x8 pa2, bf16x8 pa3) {
#define TRRD(dst, off) asm volatile("ds_read_b64_tr_b16 %0, %1 offset:%2" : "=&v"(dst) : "v"(vb0), "i"(off) : "memory")
#define PV_RD(S, d0) do { constexpr int b_ = LDS_V + VB * SHM_V + v_rd_off(d0, 0, 0); \
        TRRD(S##l0, b_); TRRD(S##h0, b_ + 2048); TRRD(S##l1, b_ + 4096); TRRD(S##h1, b_ + 6144); TRRD(S##l2, b_ + 8192); TRRD(S##h2, b_ + 10240); TRRD(S##l3, b_ + 12288); TRRD(S##h3, b_ + 14336); } while (0)
#define PV_MM(S, d0) do { \
        o[d0] = __builtin_amdgcn_mfma_f32_32x32x16_bf16(pa0, (bf16x8){S##l0[0], S##l0[1], S##l0[2], S##l0[3], S##h0[0], S##h0[1], S##h0[2], S##h0[3]}, o[d0], 0, 0, 0);   \
        o[d0] = __builtin_amdgcn_mfma_f32_32x32x16_bf16(pa1, (bf16x8){S##l1[0], S##l1[1], S##l1[2], S##l1[3], S##h1[0], S##h1[1], S##h1[2], S##h1[3]}, o[d0], 0, 0, 0);   \
        o[d0] = __builtin_amdgcn_mfma_f32_32x32x16_bf16(pa2, (bf16x8){S##l2[0], S##l2[1], S##l2[2], S##l2[3], S##h2[0], S##h2[1], S##h2[2], S##h2[3]}, o[d0], 0, 0, 0);   \
        o[d0] = __builtin_amdgcn_mfma_f32_32x32x16_bf16(pa3, (bf16x8){S##l3[0], S##l3[1], S##l3[2], S##l3[3], S##h3[0], S##h3[1], S##h3[2], S##h3[3]}, o[d0], 0, 0, 0); } while (0)
#define LGK(n) do { asm volatile("s_waitcnt lgkmcnt(" #n ")" ::: "memory"); SBAR(); } while (0)
    s16x4 Al0, Al1, Al2, Al3, Ah0, Ah1, Ah2, Ah3, Bl0, Bl1, Bl2, Bl3, Bh0, Bh1, Bh2, Bh3;
    PV_RD(A, 0); PV_RD(B, 1); LGK(8); PV_MM(A, 0); SBAR();
    PV_RD(A, 2); LGK(8); PV_MM(B, 1); SBAR();
    PV_RD(B, 3); LGK(8); PV_MM(A, 2); SBAR();
    LGK(0); PV_MM(B, 3);
#undef PV_RD
#undef PV_MM
#undef LGK
#undef TRRD
}
struct BlockRef { const bf16_t* Q; const bf16_t* K; const bf16_t* V; bf16_t* OUT; int P0, c; };
struct Seam { bf16x8 qr[4]; };
#define DA_VMW() asm volatile("s_waitcnt vmcnt(0)" ::: "memory")
#define DA_KDMA(Kp, k0, bf) pg8::glds16s<0>((Kp) + (size_t)(k0) * RS, kvo, kdst + (unsigned)((bf) * SHM_K))
#define DA_VDMA(Vp, k0, bf) do { pg8::glds16s<0>((Vp) + (size_t)(k0) * RS, vvo0, vdst + (unsigned)((bf) * SHM_V)); pg8::glds16s<0>((Vp) + (size_t)(k0) * RS, vvo1, vdst + (unsigned)((bf) * SHM_V + 8192)); } while (0)
#define DA_ADDR() \
    const int kr = tid >> 3; \
    const unsigned kvo = (unsigned)(kr * RS + (((tid & 7) ^ ((kr >> 1) & 7)) * 8)) * 2u, kdst = (unsigned)__builtin_amdgcn_readfirstlane((unsigned)(uintptr_t)lds + LDS_K + wid * 1024); \
    const unsigned vvo0 = (unsigned)(v_slot_key(tid) * RS + v_slot_col(tid)) * 2u, vvo1 = (unsigned)(v_slot_key(tid + 512) * RS + v_slot_col(tid + 512)) * 2u, \
                   vdst = (unsigned)__builtin_amdgcn_readfirstlane((unsigned)(uintptr_t)lds + LDS_V + wid * 1024)
__device__ __forceinline__ void prime(const BlockRef& cur, char* lds, Seam& S) {
    const int tid = otid(), wid = __builtin_amdgcn_readfirstlane(tid >> 6), lane = tid & 63, r32 = lane & 31, hi = lane >> 5;
    DA_ADDR();
#pragma unroll
    for (int d0 = 0; d0 < 4; ++d0) S.qr[d0] = load8(cur.Q + (size_t)(wid * QBLK + r32) * RS + d0 * 16 + hi * 8);
    DA_KDMA(cur.K, 0, 0); DA_VDMA(cur.V, 0, 0); DA_VMW();
    __syncthreads();
}
__device__ __forceinline__ void block(const BlockRef& cur, const BlockRef& nxt, char* lds, Seam& S, float lam, const float* __restrict__ subln_w) {
    const int tid = otid(), wid = __builtin_amdgcn_readfirstlane(tid >> 6), lane = tid & 63, r32 = lane & 31, hi = lane >> 5;
    const int NT = (cur.P0 + QB) / KVBLK;
    const int qlo = cur.P0 + wid * QBLK, qm = qlo + r32 - 4 * hi;
    char* K_lds = lds + LDS_K;
    float* ws = (float*)(lds + LDS_WS) + wid * 64; float* li_l = ws; float* al_l = ws + 32;
    float m_reg = -1e30f, l_reg = 0; f32x16 o[4] = {};
    DA_ADDR();
    const int vb0 = (int)(uintptr_t)lds + v_rd_base(lane);
    const bf16_t* Kh = cur.K; const bf16_t* Vh = cur.V;
#define RESC(a) do { if (__any((a) < 1.f)) { if (hi == 0) al_l[r32] = (a); asm volatile("s_waitcnt lgkmcnt(0)" ::: "memory");              \
                     _Pragma("unroll") for (int d_ = 0; d_ < 4; ++d_) _Pragma("unroll") for (int r = 0; r < 16; ++r) o[d_][r] *= al_l[crow(r, hi)]; } } while (0)
#define KBASE(t) ((t) * KVBLK)
#define MASKT(P0_, P1_, t) do { const int kb_ = KBASE(t); if (kb_ + KVBLK - 1 > qlo) mask_tile(P0_, P1_, qm - kb_); } while (0)
    f32x16 pA0, pA1, pB0, pB1; float mnA, mnB, alA, alB; bf16x8 pa0, pa1, pa2, pa3;
    DA_KDMA(Kh, KBASE(1), 1); DA_VDMA(Vh, KBASE(1), 1);
    SBAR(); qkt<0>(pA0, pA1, K_lds, r32, hi, S.qr);
    MASKT(pA0, pA1, 0); partialSM(pA0, pA1, m_reg, mnA, alA);
    DA_VMW(); __syncthreads();
#define HALF_STEP(PX0, PX1, mnX, alX, PY0, PY1, alY, t, KB, VBP, KBN, VBN) do {                                               \
        SBAR(); DA_KDMA(Kh, KBASE((t) + 1), KBN); DA_VDMA(Vh, KBASE((t) + 1), VBN); SBAR();     \
        qkt<KB>(PX0, PX1, K_lds, r32, hi, S.qr);                                                                              \
        finishSM(PY0, PY1, alY, l_reg, pa0, pa1, pa2, pa3); SBAR();                                                           \
        pv_tile<VBP>(o, vb0, pa0, pa1, pa2, pa3); MASKT(PX0, PX1, (t)); partialSM(PX0, PX1, m_reg, mnX, alX);                  \
        RESC(alX); DA_VMW(); __syncthreads(); } while (0)
    HALF_STEP(pB0, pB1, mnB, alB, pA0, pA1, alA, 1, 1, 0, 0, 2);
    HALF_STEP(pA0, pA1, mnA, alA, pB0, pB1, alB, 2, 0, 1, 1, 3);
    for (int t = 3; t + 1 < NT; t += 4) {
        asm volatile(".p2align 3\n\ts_nop 0" ::: "memory");
        HALF_STEP(pB0, pB1, mnB, alB, pA0, pA1, alA, t, 1, 2, 0, 0);
        HALF_STEP(pA0, pA1, mnA, alA, pB0, pB1, alB, t + 1, 0, 3, 1, 1);
        HALF_STEP(pB0, pB1, mnB, alB, pA0, pA1, alA, t + 2, 1, 0, 0, 2);
        HALF_STEP(pA0, pA1, mnA, alA, pB0, pB1, alB, t + 3, 0, 1, 1, 3);
    }
    SBAR(); qkt<1>(pB0, pB1, K_lds, r32, hi, S.qr); SBAR();
    DA_KDMA(nxt.K, 0, 0); DA_VDMA(nxt.V, 0, 0); SBAR();
#pragma unroll
    for (int d0 = 0; d0 < 4; ++d0) S.qr[d0] = load8(nxt.Q + (size_t)(wid * QBLK + r32) * RS + d0 * 16 + hi * 8);
    SBAR();
    finishSM(pA0, pA1, alA, l_reg, pa0, pa1, pa2, pa3); SBAR();
    pv_tile<2>(o, vb0, pa0, pa1, pa2, pa3);
    MASKT(pB0, pB1, NT - 1); partialSM(pB0, pB1, m_reg, mnB, alB); RESC(alB);
    finishSM(pB0, pB1, alB, l_reg, pa0, pa1, pa2, pa3); SBAR(); pv_tile<3>(o, vb0, pa0, pa1, pa2, pa3);
    SBAR();
    if (hi == 0) li_l[r32] = l_reg;
    asm volatile("s_waitcnt lgkmcnt(0)" ::: "memory");
    float rli[16];
#pragma unroll
    for (int r = 0; r < 16; ++r) rli[r] = __builtin_amdgcn_rcpf(li_l[crow(r, hi)]);
    unsigned* ostw = (unsigned*)(lds + LDS_OST + wid * 8192);
    if (cur.c == 1) {
#pragma unroll
        for (int d0 = 0; d0 < 4; ++d0)
#pragma unroll
            for (int r = 0; r < 16; r += 2) ostw[(d0 * 8 + (r >> 1)) * 64 + lane] = cvtpk(o[d0][r] * rli[r], o[d0][r + 1] * rli[r + 1]);
    } else {
        float ss[16];
#pragma unroll
        for (int r = 0; r < 16; ++r) ss[r] = 0.f;
#pragma unroll
        for (int d0 = 0; d0 < 4; ++d0)
#pragma unroll
            for (int r = 0; r < 16; r += 2) { const unsigned u = ostw[(d0 * 8 + (r >> 1)) * 64 + lane];
                const float v0 = o[d0][r] * rli[r] - lam * __uint_as_float(u << 16), v1 = o[d0][r + 1] * rli[r + 1] - lam * __uint_as_float(u & 0xffff0000u);
                o[d0][r] = v0; o[d0][r + 1] = v1; ss[r] += v0 * v0; ss[r + 1] += v1 * v1; }
#pragma unroll
        for (int msk = 1; msk < 32; msk <<= 1)
#pragma unroll
            for (int r = 0; r < 16; ++r) ss[r] += __shfl_xor(ss[r], msk);
        float sw[4];
#pragma unroll
        for (int d0 = 0; d0 < 4; ++d0) sw[d0] = subln_w[d0 * 32 + r32] * 0.8f;
        asm volatile("s_waitcnt lgkmcnt(0)" ::: "memory");
        bf16_t* stg = (bf16_t*)ostw;
#pragma unroll
        for (int r = 0; r < 16; ++r) { const float rs = 1.0f / sqrtf(ss[r] * (1.f / 128.f) + EPS); const int orow = crow(r, hi);
#pragma unroll
            for (int d0 = 0; d0 < 4; ++d0) stg[orow * 128 + d0 * 32 + r32] = (bf16_t)f2bf(o[d0][r] * rs * sw[d0]); }
        asm volatile("s_waitcnt lgkmcnt(0)" ::: "memory");
        bf16_t* Ow = cur.OUT + (size_t)(wid * QBLK) * D;
#pragma unroll
        for (int i = 0; i < 8; ++i) { const int row = i * 4 + (lane >> 4), ch = lane & 15; const u32x4 v = *(const u32x4*)(stg + row * 128 + ch * 8); *(u32x4*)(Ow + (size_t)row * D + ch * 8) = v; }
    }
    DA_VMW();
    __syncthreads();
#undef RESC
#undef KBASE
#undef MASKT
#undef HALF_STEP
}
#undef DA_VMW
#undef DA_KDMA
#undef DA_VDMA
#undef DA_ADDR
__device__ __forceinline__ BlockRef ref_of(int L, int seq, const bf16_t* PROJ, bf16_t* CAT) {
    const int bh = L >> 2, y = L & 3, b = bh >> 2, h = bh & 3, qb = (seq < 2) ? y : 7 - y, c = (seq & 1) ? 0 : 1;
    BlockRef r; const size_t row0 = (size_t)b * SEQ;
    r.Q = PROJ + (row0 + (size_t)qb * QB) * RS + h * 128 + c * 64; r.K = PROJ + row0 * RS + 512 + h * 128 + c * 64; r.V = PROJ + row0 * RS + 1024 + h * 128;
    r.OUT = CAT + (row0 + (size_t)qb * QB) * D + h * 128; r.P0 = qb * QB; r.c = c; return r;
}
__device__ __forceinline__ void phase(char* lds, const bf16_t* PROJ, bf16_t* CAT, float lam, const float* subln_w, int G, int bid) {
    constexpr int TOTAL = (T / SEQ) * 4 * 4;
    const int v = (G % 8 == 0) ? (bid & 7) * (G >> 3) + (bid >> 3) : bid;
    int L = v; if (L >= TOTAL) return;
    int seq = 0; BlockRef cur = ref_of(L, 0, PROJ, CAT);
    Seam S; prime(cur, lds, S);
    for (;;) {
        int Ln = L, seqn = seq + 1; if (seqn == 4) { seqn = 0; Ln = L + G; }
        const bool last = Ln >= TOTAL;
        const BlockRef nxt = last ? cur : ref_of(Ln, seqn, PROJ, CAT);
        block(cur, nxt, lds, S, lam, subln_w);
        if (last) break;
        cur = nxt; L = Ln; seq = seqn;
    }
}
#undef KSWZ64
#undef SBAR
}


#define LAS __attribute__((address_space(3)))
constexpr int NWAVES = 8, NTHREADS = 512;
namespace rtr {
typedef float f32x2 __attribute__((ext_vector_type(2)));
constexpr int WPITCH = 2064;
constexpr int LDS_WHI = 0, LDS_WLO = 32 * WPITCH, LDS_LG = 64 * WPITCH, LDS_CNT = LDS_LG + 8 * 16 * 33 * 4, LDS_BYTES = LDS_CNT + 256;
static_assert(LDS_BYTES <= pg8::STAGE_BYTES + pg8::PLAN_BYTES, "router LDS overlaps the grid barrier's LDS words");
__device__ __forceinline__ void build_tables(unsigned char* tab, const float* __restrict__ fw, const float* __restrict__ rw, int gtid, int gsz) {
    for (int idx = gtid; idx < 1024 * 32; idx += gsz) { const int k = idx >> 5, e = idx & 31; const float w = rw[idx] * fw[k];
        const unsigned hi = f2bf(w), lo = f2bf(w - __uint_as_float(hi << 16));
        *(unsigned short*)(tab + LDS_WHI + e * WPITCH + 2 * k) = (unsigned short)hi; *(unsigned short*)(tab + LDS_WLO + e * WPITCH + 2 * k) = (unsigned short)lo; }
}
__device__ __forceinline__ void phase(LAS unsigned char* lds, const bf16_t* __restrict__ x1, const unsigned char* rtab, const float* __restrict__ rb,
                                      int* cnt, int* ltok, float* lgate, int* slot, unsigned char* __restrict__ XQ, int G, int bid) {
    const int tid = otid(), lane = tid & 63, wid = __builtin_amdgcn_readfirstlane(tid >> 6), r = lane & 15, q = lane >> 4;
    LAS float* lg = (LAS float*)(lds + LDS_LG) + wid * (16 * 33); LAS int* lcount = (LAS int*)(lds + LDS_CNT); LAS int* lbase = lcount + 32;
    { const unsigned ldsb = (unsigned)__builtin_amdgcn_readfirstlane((unsigned)(__UINTPTR_TYPE__)lds);
      for (int p = wid; p < (64 * WPITCH) / 1024; p += NWAVES) pg8::glds16s<0>(rtab + (size_t)p * 1024, (unsigned)(lane * 16), ldsb + (unsigned)(p * 1024));
      asm volatile("s_waitcnt vmcnt(0)" ::: "memory"); }
    if (tid < 32) lcount[tid] = 0;
    __syncthreads();
    const float rb0 = rb[r], rb1 = rb[16 + r];
    const LAS unsigned char* whi = lds + LDS_WHI + r * WPITCH + 16 * q; const LAS unsigned char* wlo = lds + LDS_WLO + r * WPITCH + 16 * q;
    for (int tile = bid; tile < T / 256; tile += G) {
        const int ch = (tile * 256) / TC;
        int ti[2][4]; float gt[2][4]; int lpos[2][4];
#pragma unroll
        for (int h = 0; h < 2; ++h) {
            const int t0 = tile * 256 + wid * 32 + h * 16;
            const bf16_t* xrow = x1 + (size_t)(t0 + r) * D + 8 * q;
            u32x4 xw[32];
#pragma unroll
            for (int j = 0; j < 32; ++j) xw[j] = *(const u32x4*)(xrow + 32 * j);
            f32x4 acc0 = {0.f, 0.f, 0.f, 0.f}, acc1 = {0.f, 0.f, 0.f, 0.f}; float ssq = 0.f;
#pragma unroll
            for (int j = 0; j < 32; ++j) {
                const bf16x8 av = *reinterpret_cast<const bf16x8*>(&xw[j]);
                const bf16x8 bh0 = *(const LAS bf16x8*)(whi + 64 * j), bh1 = *(const LAS bf16x8*)(whi + 16 * WPITCH + 64 * j), bl0 = *(const LAS bf16x8*)(wlo + 64 * j), bl1 = *(const LAS bf16x8*)(wlo + 16 * WPITCH + 64 * j);
                acc0 = __builtin_amdgcn_mfma_f32_16x16x32_bf16(av, bh0, acc0, 0, 0, 0); acc1 = __builtin_amdgcn_mfma_f32_16x16x32_bf16(av, bh1, acc1, 0, 0, 0);
                acc0 = __builtin_amdgcn_mfma_f32_16x16x32_bf16(av, bl0, acc0, 0, 0, 0); acc1 = __builtin_amdgcn_mfma_f32_16x16x32_bf16(av, bl1, acc1, 0, 0, 0);
#pragma unroll
                for (int i = 0; i < 4; ++i) { const float lo_ = __uint_as_float(xw[j][i] << 16), hi_ = __uint_as_float(xw[j][i] & 0xffff0000u); ssq += lo_ * lo_ + hi_ * hi_; }
                if ((j & 1) == 1) __builtin_amdgcn_sched_barrier(0);
            }
            ssq += __shfl_xor(ssq, 16); ssq += __shfl_xor(ssq, 32);
            const float rstd = 1.0f / sqrtf(ssq * (1.f / D) + EPS);
            { const float sx = rstd * FP8_SX;
#pragma unroll
              for (int j = 0; j < 32; ++j) { u32x4 xv = xw[j]; asm volatile("" : "+v"(xv));
                  *(unsigned long long*)(XQ + (size_t)(t0 + r) * D + 32 * j + 8 * q) =
                      (unsigned long long)pk4_fp8(__uint_as_float(xv[0] << 16) * sx, __uint_as_float(xv[0] & 0xffff0000u) * sx, __uint_as_float(xv[1] << 16) * sx, __uint_as_float(xv[1] & 0xffff0000u) * sx)
                    | ((unsigned long long)pk4_fp8(__uint_as_float(xv[2] << 16) * sx, __uint_as_float(xv[2] & 0xffff0000u) * sx, __uint_as_float(xv[3] << 16) * sx, __uint_as_float(xv[3] & 0xffff0000u) * sx) << 32); } }
            asm volatile("s_waitcnt lgkmcnt(0)" ::: "memory");
#pragma unroll
            for (int g4 = 0; g4 < 4; ++g4) { const float rs = __shfl(rstd, q * 4 + g4); lg[(q * 4 + g4) * 33 + r] = acc0[g4] * rs + rb0; lg[(q * 4 + g4) * 33 + 16 + r] = acc1[g4] * rs + rb1; }
            asm volatile("s_waitcnt lgkmcnt(0)" ::: "memory");
            if (lane < 16) {
                float v[32];
#pragma unroll
                for (int e = 0; e < 32; ++e) v[e] = lg[lane * 33 + e];
                unsigned used = 0u; float tv[4];
#pragma unroll
                for (int k = 0; k < 4; ++k) { float best = -INFINITY; int bi = -1;
#pragma unroll
                    for (int e = 0; e < 32; ++e) { const bool take = !((used >> e) & 1u) && (bi < 0 || v[e] > best); best = take ? v[e] : best; bi = take ? e : bi; }
                    tv[k] = best; ti[h][k] = bi; used |= 1u << bi; }
                const float e1 = expf(tv[1] - tv[0]), e2 = expf(tv[2] - tv[0]), e3 = expf(tv[3] - tv[0]), inv = 1.f / (1.f + e1 + e2 + e3);
                gt[h][0] = inv; gt[h][1] = e1 * inv; gt[h][2] = e2 * inv; gt[h][3] = e3 * inv;
#pragma unroll
                for (int k = 0; k < 4; ++k) lpos[h][k] = __hip_atomic_fetch_add(lcount + ti[h][k], 1, __ATOMIC_RELAXED, __HIP_MEMORY_SCOPE_WORKGROUP);
            }
            asm volatile("s_waitcnt lgkmcnt(0)" ::: "memory"); __builtin_amdgcn_sched_barrier(0);
        }
        __syncthreads();
        if (tid < 32) { const int c = lcount[tid]; lbase[tid] = c ? atomicAdd(&cnt[ch * 32 + tid], c) : 0; lcount[tid] = 0; }
        __syncthreads();
        if (lane < 16) {
#pragma unroll
            for (int h = 0; h < 2; ++h) { const int t = tile * 256 + wid * 32 + h * 16 + lane;
#pragma unroll
                for (int k = 0; k < 4; ++k) { const int pos = lbase[ti[h][k]] + lpos[h][k]; const size_t idx = ((size_t)ch * 32 + ti[h][k]) * TC + pos;
                    ltok[idx] = t; lgate[idx] = gt[h][k]; slot[t * 4 + k] = (ti[h][k] << 16) | pos; } } }
        __syncthreads();
    }
    __syncthreads();
}
}

typedef unsigned gu32_t;
#define XB_TMO      128
#define XB_XCNT(j)  (256  + 64 * (j))
#define XB_XSUB(j)  (1280 + 64 * (j))
#define XB_XGEN(j)  (2304 + 64 * (j))
#define XB_TOP      3328
#define XB_TOPGEN   3392
#define XCD_BAR_WORDS 3456
#define XB_SPIN_CAP (1u << 18)

__device__ __forceinline__ unsigned xb_ld(unsigned* p)              { return __hip_atomic_load(p, __ATOMIC_RELAXED, __HIP_MEMORY_SCOPE_AGENT); }
__device__ __forceinline__ unsigned xb_add(unsigned* p, unsigned v) { return __hip_atomic_fetch_add(p, v, __ATOMIC_RELAXED, __HIP_MEMORY_SCOPE_AGENT); }
__device__ __forceinline__ unsigned xb_xcc_id() { return (unsigned)__builtin_amdgcn_s_getreg((3 << 11) | 20) & 0xFu; }
#define XB_SPIN(cond, bar) do { unsigned _sp = 0; while (cond) { __builtin_amdgcn_s_sleep(1); \
    if ((++_sp & 255u) == 0u) { if (xb_ld(&(bar)[XB_TMO])) break; if (_sp > XB_SPIN_CAP) { atomicAdd(&(bar)[XB_TMO], 1u); break; } } } } while (0)

struct XcdBarrier {
    unsigned* bar; unsigned x;
    volatile LAS unsigned* st;
};

__device__ __forceinline__ XcdBarrier xcd_barrier_post(unsigned* bar, volatile LAS unsigned* st) {
    XcdBarrier b; b.bar = bar; b.x = xb_xcc_id(); b.st = st;
    if (threadIdx.x == 0) (void)xb_add(&bar[XB_XCNT(b.x)], 1u);
    return b;
}
__device__ __forceinline__ void xcd_barrier_complete(unsigned* bar, unsigned x, unsigned& nloc, unsigned& nx) {
    const unsigned G = gridDim.x * gridDim.y * gridDim.z;
    unsigned sum, cnt, mine, sp = 0u;
    for (;;) {
        sum = 0u; cnt = 0u; mine = 0u;
#pragma unroll
        for (unsigned j = 0; j < 16; ++j) { const unsigned c = xb_ld(&bar[XB_XCNT(j)]); sum += c; cnt += (c > 0u) ? 1u : 0u; mine = (j == x) ? c : mine; }
        if (sum == G) break;
        __builtin_amdgcn_s_sleep(1);
        if ((++sp & 255u) == 0u) { if (xb_ld(&bar[XB_TMO])) break; if (sp > XB_SPIN_CAP) { atomicAdd(&bar[XB_TMO], 1u); break; } }
    }
    nloc = mine > 0u ? mine : 1u; nx = cnt > 0u ? cnt : 1u;
}

__device__ __forceinline__ void xcd_barrier(const XcdBarrier& b) {
    asm volatile("s_waitcnt vmcnt(0)" ::: "memory");
    __syncthreads();
    if (threadIdx.x == 0) {
        unsigned* bar = b.bar;
        __builtin_amdgcn_s_waitcnt(0);
        unsigned nloc = b.st[0], nx = b.st[1];
        if (nloc == 0u) { xcd_barrier_complete(bar, b.x, nloc, nx); b.st[0] = nloc; b.st[1] = nx; }
        const unsigned old = xb_add(&bar[XB_XSUB(b.x)], 1u);
        const unsigned gen = old / nloc;
        if (old + 1u == (gen + 1u) * nloc) {
            __builtin_amdgcn_fence(__ATOMIC_RELEASE, "agent");
            asm volatile("s_waitcnt vmcnt(0)" ::: "memory");
            const unsigned og = xb_add(&bar[XB_TOP], 1u);
            const unsigned tg = og / nx;
            if (og + 1u == (tg + 1u) * nx) xb_add(&bar[XB_TOPGEN], 1u);
            else XB_SPIN(xb_ld(&bar[XB_TOPGEN]) == tg, bar);
            __builtin_amdgcn_fence(__ATOMIC_ACQUIRE, "agent");
            asm volatile("s_waitcnt vmcnt(0)" ::: "memory");
        } else {
            XB_SPIN(xb_ld(&bar[XB_TOPGEN]) == gen, bar);
            __builtin_amdgcn_fence(__ATOMIC_ACQUIRE, "agent");
            asm volatile("s_waitcnt vmcnt(0)" ::: "memory");
        }
    }
    __syncthreads();
}


constexpr int XB_LDS = pg8::STAGE_BYTES + pg8::PLAN_BYTES;
constexpr int MK_LDS = pg8::STAGE_BYTES + pg8::PLAN_BYTES + 64 + 2048;

struct MArgs {
    const float* x; const int* positions; const float* attn_norm_w; const float* w_in; const float* lq1; const float* lk1; const float* lq2; const float* lk2;
    const float* subln_w; const float* pool_w; const float* pool_scale; const float* w_out; const float* ffn_norm_w; const float* router_w; const float* router_b;
    const float* w_gu; const float* b_gu; const float* w_down; const float* b_down; const float* final_w; float* out; unsigned char* ws;
};

__device__ __forceinline__ int rho256(int c) { return (((c >> 5) & 1) << 7) | ((c >> 6) << 5) | (c & 31); }
template <int MODE>
__device__ __forceinline__ void p0_transpose_item(const float* __restrict__ W, int N, bf16_t* __restrict__ WT, int ldk, LAS float* scr, int item, int lane, const float* __restrict__ kscale) {
    const int nblk = N / 32, kb = item / nblk, nb = item % nblk, k0 = 64 * kb, n0 = 32 * nb;
#pragma unroll 8
    for (int i = 0; i < 32; ++i) { const int kk = 2 * i + (lane >> 5); float v = W[(size_t)(k0 + kk) * N + n0 + (lane & 31)]; if (MODE == 1 || MODE == 2) v *= kscale[k0 + kk]; scr[kk * 33 + (lane & 31)] = v; }
    asm volatile("s_waitcnt lgkmcnt(0)" ::: "memory");
    const int c = lane & 7;
#pragma unroll
    for (int j = 0; j < 4; ++j) { const int nl = (lane >> 3) + 8 * j, n = n0 + nl; const LAS float* s = scr + (8 * c) * 33 + nl;
        int row = n;
        if (MODE == 1) { const int f = n & 1023, up = n >> 10; row = (f >> 7) * 256 + up * 128 + (f & 127); }
        if (MODE >= 2) row = (n & ~255) | rho256(n & 255);
        u32x4 o; o.x = f2bf(s[0 * 33]) | (f2bf(s[1 * 33]) << 16); o.y = f2bf(s[2 * 33]) | (f2bf(s[3 * 33]) << 16); o.z = f2bf(s[4 * 33]) | (f2bf(s[5 * 33]) << 16); o.w = f2bf(s[6 * 33]) | (f2bf(s[7 * 33]) << 16);
        *(u32x4*)(WT + (size_t)row * ldk + k0 + 8 * c) = o; }
    asm volatile("s_waitcnt lgkmcnt(0)" ::: "memory");
}
template <int MODE>
__device__ __forceinline__ void p0_transpose_item_fp8(const float* __restrict__ W, int N, unsigned char* __restrict__ WT, int ldk, LAS float* scr, int item, int lane, const float* __restrict__ kscale, float sc) {
    const int nblk = N / 32, kb = item / nblk, nb = item % nblk, k0 = 64 * kb, n0 = 32 * nb;
#pragma unroll 8
    for (int i = 0; i < 32; ++i) { const int kk = 2 * i + (lane >> 5); float v = W[(size_t)(k0 + kk) * N + n0 + (lane & 31)] * sc; if (MODE == 1) v *= kscale[k0 + kk]; scr[kk * 33 + (lane & 31)] = v; }
    asm volatile("s_waitcnt lgkmcnt(0)" ::: "memory");
    const int c = lane & 3;
#pragma unroll
    for (int j = 0; j < 2; ++j) { const int nl = (lane >> 2) + 16 * j, n = n0 + nl; const LAS float* s = scr + (16 * c) * 33 + nl;
        int row = n;
        if (MODE == 1) { const int f = n & 1023, up = n >> 10; row = (f >> 7) * 256 + up * 128 + (f & 127); }
        if (MODE == 2) { const int c = n & 255; row = (n & ~255) | (((c >> 3) & 1) << 7) | ((c >> 6) << 5) | (((c >> 4) & 3) << 3) | (c & 7); }
        u32x4 o;
#pragma unroll
        for (int q = 0; q < 4; ++q) o[q] = pk4_fp8(s[(4 * q) * 33], s[(4 * q + 1) * 33], s[(4 * q + 2) * 33], s[(4 * q + 3) * 33]);
        *(u32x4*)(WT + (size_t)row * ldk + k0 + 16 * c) = o; }
    asm volatile("s_waitcnt lgkmcnt(0)" ::: "memory");
}
__device__ __forceinline__ void xbf_row(const float* __restrict__ xrow, bf16_t* __restrict__ orow, float* __restrict__ rstd_out, int lane) {
    const f32x4* xr = (const f32x4*)xrow + lane;
    f32x4 v[4]; float s = 0.f;
#pragma unroll
    for (int j = 0; j < 4; ++j) { v[j] = xr[64 * j]; s += v[j].x * v[j].x + v[j].y * v[j].y + v[j].z * v[j].z + v[j].w * v[j].w; }
    unsigned long long* o8 = (unsigned long long*)orow + lane;
#pragma unroll
    for (int j = 0; j < 4; ++j) { const unsigned lo = f2bf(v[j].x) | (f2bf(v[j].y) << 16), hi = f2bf(v[j].z) | (f2bf(v[j].w) << 16); o8[64 * j] = (unsigned long long)lo | ((unsigned long long)hi << 32); }
    const float rstd = 1.0f / sqrtf(wave_sum(s) * (1.f / D) + EPS);
    if (lane == 0) *rstd_out = rstd;
}
__device__ __forceinline__ void rmsnorm_row_bf16(const float* __restrict__ xrow, const float* __restrict__ w, bf16_t* __restrict__ orow, int lane) {
    const f32x4* xr = (const f32x4*)xrow + lane;
    f32x4 v[4]; float s = 0.f;
#pragma unroll
    for (int j = 0; j < 4; ++j) { v[j] = xr[64 * j]; s += v[j].x * v[j].x + v[j].y * v[j].y + v[j].z * v[j].z + v[j].w * v[j].w; }
    const float rstd = 1.0f / sqrtf(wave_sum(s) * (1.f / D) + EPS);
    unsigned long long* o8 = (unsigned long long*)orow + lane;
#pragma unroll
    for (int j = 0; j < 4; ++j) { const f32x4 ww = ((const f32x4*)w)[64 * j + lane];
        const unsigned lo = f2bf(v[j].x * rstd * ww.x) | (f2bf(v[j].y * rstd * ww.y) << 16), hi = f2bf(v[j].z * rstd * ww.z) | (f2bf(v[j].w * rstd * ww.w) << 16);
        o8[64 * j] = (unsigned long long)lo | ((unsigned long long)hi << 32); }
}

__device__ __forceinline__ void final_row(float* __restrict__ out, const bf16_t* __restrict__ XB, const unsigned char* __restrict__ YP, const LAS int* tb, const int* slot, const float* __restrict__ lgate, const float* __restrict__ w, int t, int lane) {
    int rows[4]; float gk[4];
#pragma unroll
    for (int k = 0; k < 4; ++k) { const int sl = slot[t * 4 + k]; rows[k] = tb[sl >> 16] + (sl & 0xffff); gk[k] = lgate[(size_t)(sl >> 16) * TC + (sl & 0xffff)] * (1.0f / FP8_SY); }
    typedef unsigned u32x2_ __attribute__((ext_vector_type(2)));
    u32x2_ xa[4]; unsigned q[4][4];
#pragma unroll
    for (int e = 0; e < 4; ++e) xa[e] = *(const u32x2_*)(XB + (size_t)t * D + e * 256 + 4 * lane);
#pragma unroll
    for (int k = 0; k < 4; ++k)
#pragma unroll
        for (int e = 0; e < 4; ++e) q[k][e] = *(const unsigned*)(YP + (size_t)rows[k] * D + e * 256 + 4 * lane);
    float v[16];
#pragma unroll
    for (int e = 0; e < 4; ++e) { v[4 * e] = __uint_as_float(xa[e].x << 16); v[4 * e + 1] = __uint_as_float(xa[e].x & 0xffff0000u); v[4 * e + 2] = __uint_as_float(xa[e].y << 16); v[4 * e + 3] = __uint_as_float(xa[e].y & 0xffff0000u); }
#pragma unroll
    for (int k = 0; k < 4; ++k)
#pragma unroll
        for (int e = 0; e < 4; ++e) { v[4 * e] += gk[k] * __builtin_amdgcn_cvt_f32_fp8(q[k][e], 0); v[4 * e + 1] += gk[k] * __builtin_amdgcn_cvt_f32_fp8(q[k][e], 1); v[4 * e + 2] += gk[k] * __builtin_amdgcn_cvt_f32_fp8(q[k][e], 2); v[4 * e + 3] += gk[k] * __builtin_amdgcn_cvt_f32_fp8(q[k][e], 3); }
    float s = 0.f;
#pragma unroll
    for (int e = 0; e < 16; ++e) s += v[e] * v[e];
    const float rstd = 1.0f / sqrtf(wave_sum(s) * (1.f / D) + EPS);
    float* op = out + (size_t)t * D + 4 * lane; const float* wp = w + 4 * lane;
#pragma unroll
    for (int e = 0; e < 4; ++e) { const f32x4 ww = *(const f32x4*)(wp + e * 256); *(f32x4*)(op + e * 256) = (f32x4){v[4 * e] * rstd * ww.x, v[4 * e + 1] * rstd * ww.y, v[4 * e + 2] * rstd * ww.z, v[4 * e + 3] * rstd * ww.w}; }
}

typedef const MArgs __attribute__((address_space(4)))* KArgP;
__device__ __forceinline__ KArgP kargs() { KArgP p = (KArgP)__builtin_amdgcn_kernarg_segment_ptr(); asm volatile("" : "+s"(p)); return p; }
#define WSP(T_, off) ((T_*)(ws + (off)))
__global__ __launch_bounds__(NTHREADS, 2) void mega_fwd(MArgs a_unused) {
    extern __shared__ __attribute__((aligned(16))) unsigned char lds_raw[];
    LAS unsigned char* lds = (LAS unsigned char*)lds_raw;
    __builtin_amdgcn_s_setreg(1 | (23 << 6), 1);
    { float big_ = 1000.0f; asm volatile("" : "+v"(big_)); const unsigned t_ = __builtin_amdgcn_cvt_pk_fp8_f32(big_, -big_, 0u, false) & 0xffffu;
      if (t_ != 0xFE7Eu) return; }
    const int G = gridDim.x, bid = blockIdx.x, gsz = G * NTHREADS, ngw = G * NWAVES;
    if (threadIdx.x < 16) ((LAS unsigned*)(lds + XB_LDS))[threadIdx.x] = 0u;
    __syncthreads();
    (void)xcd_barrier_post((unsigned*)(kargs()->ws + WS_BAR), (volatile LAS unsigned*)(lds + XB_LDS));
#define GRID_SYNC() do { XcdBarrier xb_; xb_.bar = (unsigned*)(kargs()->ws + WS_BAR); xb_.x = xb_xcc_id(); xb_.st = (volatile LAS unsigned*)(lds + XB_LDS); xcd_barrier(xb_); } while (0)
#define PHASE_IDX() const int tid = otid(), lane = tid & 63, wid = __builtin_amdgcn_readfirstlane(tid >> 6), gtid = bid * NTHREADS + tid, gw = bid * NWAVES + wid; (void)lane; (void)gtid; (void)gw

    {
        PHASE_IDX(); KArgP a = kargs(); unsigned char* ws = a->ws; int* cnt = WSP(int, WS_CTL); float* rope = WSP(float, WS_ROPE); bf16_t* Win_t = WSP(bf16_t, WS_WIN); bf16_t* Wo_t = WSP(bf16_t, WS_WO); bf16_t* Wd_t = WSP(bf16_t, WS_WD); bf16_t* Wgu_t = WSP(bf16_t, WS_WGU); bf16_t* XN = WSP(bf16_t, WS_XN);
        if (gtid < NCHUNK * 32) cnt[gtid] = 0;
        LAS float* scr = (LAS float*)(lds + wid * 8448);
        constexpr int I_IN = (D / 64) * (INW / 32), I_WO = (512 / 64) * (D / 32), I_GU = (D / 64) * (2048 / 32), I_DN = (FF / 64) * (D / 32);
        constexpr int NITEMS = I_IN + I_WO + NE * I_GU + NE * I_DN;
        for (int it = gw; it < NITEMS; it += ngw) {
            int r = it;
            if (r < I_IN) { p0_transpose_item<2>(a->w_in, INW, Win_t, D, scr, r, lane, a->attn_norm_w); continue; } r -= I_IN;
            if (r < I_WO) { p0_transpose_item<3>(a->w_out, D, Wo_t, D, scr, r, lane, nullptr); continue; } r -= I_WO;
            if (r < NE * I_GU) { const int e = r / I_GU; p0_transpose_item_fp8<1>(a->w_gu + (size_t)e * D * 2048, 2048, (unsigned char*)Wgu_t + (size_t)e * 2048 * D, D, scr, r % I_GU, lane, a->ffn_norm_w, FP8_SW); continue; } r -= NE * I_GU;
            { const int e = r / I_DN; p0_transpose_item_fp8<2>(a->w_down + (size_t)e * FF * D, D, (unsigned char*)Wd_t + (size_t)e * D * FF, FF, scr, r % I_DN, lane, nullptr, FP8_SW); }
        }
        for (int wi = gw; wi < 128 * 16; wi += ngw) {
            const int q = wi >> 4, n = (wi & 15) * 64 + lane, g = q >> 5, c0 = g * 128 + (q & 31) * 4; float acc[4] = {0.f, 0.f, 0.f, 0.f};
            const float* wo = a->w_out + (size_t)(512 + g * 128) * 1024 + n; const float* pw = a->pool_w + (size_t)c0 * 128; const float* ps = a->pool_scale + g * 128;
#pragma unroll 16
            for (int d = 0; d < 128; ++d) { const float wv = wo[(size_t)d * 1024] * ps[d];
#pragma unroll
                for (int j = 0; j < 4; ++j) acc[j] += pw[j * 128 + d] * wv; }
#pragma unroll
            for (int j = 0; j < 4; ++j) Wo_t[(size_t)((n & ~255) | rho256(n & 255)) * 1024 + 512 + c0 + j] = (bf16_t)f2bf(acc[j]);
        }
        for (int idx = gtid; idx < T * 8; idx += gsz) {
            const int t = idx >> 3, j = idx & 7;
            const double inv = exp(-(double)(2 * j) / 16.0 * log(500000.0)); const double ang = (double)a->positions[t] * inv;
            rope[(size_t)t * 16 + j] = (float)cos(ang); rope[(size_t)t * 16 + 8 + j] = (float)sin(ang);
        }
        rtr::build_tables(WSP(unsigned char, WS_RTAB), a->ffn_norm_w, a->router_w, gtid, gsz);
        for (int row = gw; row < T; row += ngw) xbf_row(a->x + (size_t)row * D, XN + (size_t)row * D, WSP(float, WS_RSTD) + row, lane);
    }
    GRID_SYNC();
    { PHASE_IDX(); KArgP a = kargs(); unsigned char* ws = a->ws; bf16_t* Win_t = WSP(bf16_t, WS_WIN); bf16_t* XN = WSP(bf16_t, WS_XN); bf16_t* PROJ = WSP(bf16_t, WS_PROJ); const float* rope = WSP(float, WS_ROPE);
      pg8::DensePlan S; S.init(T, INW, G, bid); pg8::EpiBf16 E{PROJ, INW, rope, 4, WSP(float, WS_RSTD)}; pg8::gemm_phase<2048, false>(lds, XN, Win_t, S, E); }
    GRID_SYNC();
    {
        PHASE_IDX(); KArgP a = kargs(); unsigned char* ws = a->ws; bf16_t* PROJ = WSP(bf16_t, WS_PROJ); bf16_t* CAT = WSP(bf16_t, WS_CAT);
        const float lam = expf(wave_sum(a->lq1[lane] * a->lk1[lane])) - expf(wave_sum(a->lq2[lane] * a->lk2[lane])) + 0.2f;
        dattn::phase((char*)lds_raw, PROJ, CAT, lam, a->subln_w, G, bid);
        for (int item = gtid; item < (T / 32) * 64; item += gsz) {
            const int chunk = item & 63, tb = item >> 6, c0 = chunk * 8, w = 2 << (c0 >> 7), t0 = tb * 32, s0 = t0 % SEQ;
            const bf16_t* up = PROJ + (size_t)t0 * INW + 1536 + c0; bf16_t* op = CAT + (size_t)t0 * D + 512 + c0;
            float sum[8];
#pragma unroll
            for (int e = 0; e < 8; ++e) sum[e] = 0.f;
            if (s0 > 0) for (int i = 1; i < w; ++i) { const u32x4 v = *(const u32x4*)(up - (size_t)i * INW);
#pragma unroll
                for (int e = 0; e < 4; ++e) { sum[2 * e] += __uint_as_float(v[e] << 16); sum[2 * e + 1] += __uint_as_float(v[e] & 0xffff0000u); } }
            for (int tb8 = 0; tb8 < 32; tb8 += 8) {
                u32x4 vin[8], vout[8];
#pragma unroll
                for (int i = 0; i < 8; ++i) vin[i] = *(const u32x4*)(up + (size_t)(tb8 + i) * INW);
#pragma unroll
                for (int i = 0; i < 8; ++i) { const int tt = tb8 + i; const bool has = s0 + tt + 1 >= w; vout[i] = *(const u32x4*)(up + (size_t)(has ? tt - w + 1 : tt) * INW); }
                asm volatile("" ::: "memory");
#pragma unroll
                for (int i = 0; i < 8; ++i) { const int tt = tb8 + i; float f[8];
#pragma unroll
                    for (int e = 0; e < 4; ++e) { f[2 * e] = __uint_as_float(vin[i][e] << 16); f[2 * e + 1] = __uint_as_float(vin[i][e] & 0xffff0000u); }
                    const int s = s0 + tt; const float rn = 1.0f / (float)((s + 1 < w) ? s + 1 : w);
                    u32x4 o;
#pragma unroll
                    for (int e = 0; e < 4; ++e) { sum[2 * e] += f[2 * e]; sum[2 * e + 1] += f[2 * e + 1]; o[e] = pg8::cvt_pk_bf16(sum[2 * e] * rn - f[2 * e], sum[2 * e + 1] * rn - f[2 * e + 1]); }
                    *(u32x4*)(op + (size_t)tt * D) = o;
                    const float hm = (s + 1 >= w) ? 1.f : 0.f;
#pragma unroll
                    for (int e = 0; e < 4; ++e) { sum[2 * e] -= hm * __uint_as_float(vout[i][e] << 16); sum[2 * e + 1] -= hm * __uint_as_float(vout[i][e] & 0xffff0000u); } }
            }
        }
    }
    GRID_SYNC();
    { PHASE_IDX(); KArgP a = kargs(); unsigned char* ws = a->ws; bf16_t* Wo_t = WSP(bf16_t, WS_WO); bf16_t* CAT = WSP(bf16_t, WS_CAT);
      pg8::DensePlan S; S.init(T, D, G, bid); pg8::EpiResBf16 E{WSP(bf16_t, WS_XB), WSP(bf16_t, WS_XN), D}; pg8::gemm_phase<2048, false>(lds, CAT, Wo_t, S, E); }
    GRID_SYNC();
    { PHASE_IDX(); KArgP a = kargs(); unsigned char* ws = a->ws;
      rtr::phase(lds, WSP(bf16_t, WS_XB), WSP(unsigned char, WS_RTAB), a->router_b, WSP(int, WS_CTL), WSP(int, WS_LTOK), WSP(float, WS_LGATE), WSP(int, WS_SLOT), WSP(unsigned char, WS_XN), G, bid); }
    GRID_SYNC();
    for (int ch = 0; ch < NCHUNK; ++ch) {
        PHASE_IDX(); KArgP a = kargs(); unsigned char* ws = a->ws; int* cnt = WSP(int, WS_CTL); int* ltok = WSP(int, WS_LTOK); float* lgate = WSP(float, WS_LGATE); int* slot = WSP(int, WS_SLOT); bf16_t* Wd_t = WSP(bf16_t, WS_WD); bf16_t* Wgu_t = WSP(bf16_t, WS_WGU); bf16_t* XN = WSP(bf16_t, WS_XN); bf16_t* HM = WSP(bf16_t, WS_HM); bf16_t* YP = WSP(bf16_t, WS_YP); float* out = a->out;
        const int* cc = cnt + ch * 32; const int* lt = ltok + (size_t)ch * 32 * TC; const float* lg = lgate + (size_t)ch * 32 * TC;
        { pg8::MoePlan<true> S = pg8::moe_plan_setup<true>(lds + pg8::STAGE_BYTES, cc, lt, 8, G, bid); pg8::EpiGLU E{HM, a->b_gu, 8}; pg8::gemm_phase<1024, true>(lds, XN, Wgu_t, S, E); }
        GRID_SYNC();
        { pg8::MoePlan<false> S = pg8::moe_plan_setup<false>(lds + pg8::STAGE_BYTES, cc, lt, 4, G, bid); pg8::EpiDown E{YP, a->b_down, 4}; pg8::gemm_phase<1024, true>(lds, HM, Wd_t, S, E); }
        GRID_SYNC();
        { LAS int* tb = (LAS int*)(lds + pg8::STAGE_BYTES);
          if (tid < 64) { int v = (lane < 32) ? (__hip_atomic_load(cc + (lane & 31), __ATOMIC_RELAXED, __HIP_MEMORY_SCOPE_AGENT) + TM - 1) / TM : 0, incl = v;
#pragma unroll
              for (int o = 1; o < 32; o <<= 1) { const int up = __shfl_up(incl, o); if (lane >= o) incl += up; }
              if (lane < 32) tb[lane] = (incl - v) * TM; }
          __syncthreads();
          for (int t = ch * TC + gw; t < (ch + 1) * TC; t += ngw) final_row(out, WSP(bf16_t, WS_XB), (const unsigned char*)YP, tb, slot, lg, a->final_w, t, lane);
          __syncthreads(); }
    }
}

extern "C" void kernel_launch(void* const* d_in, const int* in_sizes, int n_in, void* d_out, int out_size, void* d_ws, size_t ws_size, hipStream_t stream) {
    if (n_in != 20 || in_sizes[0] != T * D || out_size != T * D || ws_size < WS_END) { fprintf(stderr, "kernel_launch: unexpected shapes / workspace (%d, %d, %d, %zu)\n", n_in, n_in > 0 ? in_sizes[0] : -1, out_size, ws_size); return; }
    static int grid_blocks = 0;
    if (!grid_blocks) {
        int dev = 0, cus = 0, per_cu = 0;
        (void)hipGetDevice(&dev); (void)hipDeviceGetAttribute(&cus, hipDeviceAttributeMultiprocessorCount, dev);
        (void)hipFuncSetAttribute((const void*)mega_fwd, hipFuncAttributeMaxDynamicSharedMemorySize, MK_LDS);
        (void)hipOccupancyMaxActiveBlocksPerMultiprocessor(&per_cu, (const void*)mega_fwd, NTHREADS, MK_LDS);
        if (per_cu < 1) { fprintf(stderr, "kernel_launch: occupancy query says %d blocks per CU\n", per_cu); per_cu = 1; }
        grid_blocks = cus * 1;
        if (grid_blocks % 8 != 0) grid_blocks -= grid_blocks % 8;
    }
    (void)hipMemsetAsync((char*)d_ws + WS_BAR, 0, XCD_BAR_WORDS * 4, stream);
    MArgs a{};
    a.x = (const float*)d_in[0]; a.positions = (const int*)d_in[1]; a.attn_norm_w = (const float*)d_in[2]; a.w_in = (const float*)d_in[3];
    a.lq1 = (const float*)d_in[4]; a.lk1 = (const float*)d_in[5]; a.lq2 = (const float*)d_in[6]; a.lk2 = (const float*)d_in[7];
    a.subln_w = (const float*)d_in[8]; a.pool_w = (const float*)d_in[9]; a.pool_scale = (const float*)d_in[10]; a.w_out = (const float*)d_in[11];
    a.ffn_norm_w = (const float*)d_in[12]; a.router_w = (const float*)d_in[13]; a.router_b = (const float*)d_in[14];
    a.w_gu = (const float*)d_in[15]; a.b_gu = (const float*)d_in[16]; a.w_down = (const float*)d_in[17]; a.b_down = (const float*)d_in[18]; a.final_w = (const float*)d_in[19];
    a.out = (float*)d_out; a.ws = (unsigned char*)d_ws;
    void* args[] = {&a};
    hipError_t e = hipLaunchCooperativeKernel((const void*)mega_fwd, dim3(grid_blocks), dim3(NTHREADS), args, MK_LDS, stream);
    if (e != hipSuccess) fprintf(stderr, "cooperative launch failed: %s (grid %d)\n", hipGetErrorString(e), grid_blocks);
}
```
